# Optimizing an MI355X kernel written in HIP

```python
import math
import jax
import jax.numpy as jnp
from jax import lax
import numpy as np

D_MODEL = 2048
BATCH = 4
SEQ = 4096
DEPTH = 2

CTX_LEN = 256
GRID_W = 64
N_MOD = 9
D_FF = 5632
MACARON_WEIGHT = 0.5
GLA_HEADS = 4
GLA_DK = 64
GLA_DV = 128
GLA_RANK = 16
GLA_TAU = 16.0
GLA_CHUNK = 64
DN_HEADS = 4
DN_DK = 128
DN_DV = 128
DN_CONV = 3
DN_CHUNK = 64
ATT_HEADS = 8
ATT_KV_HEADS = 2
ATT_HD = 128
Q_BLOCK = 128
ROPE_THETA = 10000.0
GLA_QK_W = GLA_HEADS * GLA_DK
GLA_V_W = GLA_HEADS * GLA_DV
DN_QK_W = DN_HEADS * DN_DK
DN_V_W = DN_HEADS * DN_DV
ATT_Q_W = ATT_HEADS * ATT_HD
ATT_KV_W = ATT_KV_HEADS * ATT_HD
MIX_WIDTH = GLA_V_W + DN_V_W + ATT_Q_W
IN_WIDTHS = (GLA_QK_W, GLA_QK_W, GLA_V_W, GLA_V_W, DN_QK_W, DN_QK_W, DN_V_W, DN_V_W, ATT_Q_W, ATT_KV_W, ATT_KV_W)
IN_WIDTH = sum(IN_WIDTHS)
DEEPNORM_ALPHA = (2 * DEPTH) ** 0.25
DEEPNORM_BETA = (8 * DEPTH) ** -0.25
NORM_EPS = 1e-6

kernel_name = 'hymba_gla_gdn_gqa_macaron_deepnorm_dit'


def _layernorm(x, g, b):
    xf = x.astype(jnp.float32)
    mu = jnp.mean(xf, axis=-1, keepdims=True)
    xc = xf - mu
    var = jnp.mean(xc * xc, axis=-1, keepdims=True)
    return (xc * lax.rsqrt(var + NORM_EPS) * g + b).astype(x.dtype)


def _rmsnorm(x, g):
    xf = x.astype(jnp.float32)
    return (xf * lax.rsqrt(jnp.mean(xf * xf, axis=-1, keepdims=True) + NORM_EPS) * g).astype(x.dtype)


def _l2norm(x):
    xf = x.astype(jnp.float32)
    return (xf * lax.rsqrt(jnp.sum(xf * xf, axis=-1, keepdims=True) + NORM_EPS)).astype(x.dtype)


def _modulate(x, shift, scale):
    return x * (1.0 + scale) + shift


def _post_norm(x, y, gate, g, b):
    return _layernorm(DEEPNORM_ALPHA * x + gate * y, g, b)


def _swiglu(h, wg, wu, wd):
    return (jax.nn.silu(h @ wg) * (h @ wu)) @ wd


def _ffn_sublayer(x, shift, scale, gate, wg, wu, wd, g, b):
    h = _modulate(x, shift, scale)
    return _post_norm(x, MACARON_WEIGHT * _swiglu(h, wg, wu, wd), gate, g, b)


def _seg_reverse(z, n_ctx):
    return jnp.concatenate([jnp.flip(z[:, :n_ctx], axis=1), jnp.flip(z[:, n_ctx:], axis=1)], axis=1)


def _directional(fn, arrays, n_ctx, backward):
    if backward:
        out = fn(*[_seg_reverse(a, n_ctx) for a in arrays])
        return _seg_reverse(out, n_ctx)
    return fn(*arrays)


def _to_chunks(z, c):
    b, t, h, d = z.shape
    return z.reshape(b, t // c, c, h, d).transpose(1, 0, 3, 2, 4)


def _from_chunks(z):
    n, b, h, c, d = z.shape
    return z.transpose(1, 0, 3, 2, 4).reshape(b, n * c, h, d)


def _gla_chunked(q, k, v, log_a):
    bsz, _, nh, dk = q.shape
    dv = v.shape[-1]
    f32 = jnp.float32
    qc, kc, vc, gc = (_to_chunks(t.astype(f32), GLA_CHUNK) for t in (q, k, v, log_a))
    bcum = jnp.cumsum(gc, axis=-2)
    blast = bcum[..., -1:, :]
    q_in = qc * jnp.exp(bcum)
    k_in = kc * jnp.exp(-bcum)
    k_end = kc * jnp.exp(blast - bcum)
    idx = jnp.arange(GLA_CHUNK)
    lower = idx[:, None] >= idx[None, :]
    attn = jnp.where(lower, jnp.einsum('nbhid,nbhjd->nbhij', q_in, k_in), 0.0)
    o_intra = jnp.einsum('nbhij,nbhjv->nbhiv', attn, vc)

    def step(state, inp):
        qi, ke, vi, bl = inp
        o = jnp.einsum('bhid,bhdv->bhiv', qi, state)
        state = state * jnp.exp(bl)[..., 0, :, None] + jnp.einsum('bhjd,bhjv->bhdv', ke, vi)
        return state, o

    s0 = jnp.zeros((bsz, nh, dk, dv), f32)
    _, o_inter = lax.scan(step, s0, (q_in, k_end, vc, blast))
    return _from_chunks(o_intra + o_inter).astype(v.dtype)


def _unit_lower_inverse(a):
    c = a.shape[-1]
    n = -a
    t = jnp.eye(c, dtype=a.dtype) + n
    p = n
    for _ in range(int(math.log2(c)) - 1):
        p = p @ p
        t = t + t @ p
    return t


def _gated_delta_chunked(q, k, v, beta, g):
    bsz, _, nh, dk = q.shape
    dv = v.shape[-1]
    f32 = jnp.float32
    qc, kc, vc = (_to_chunks(t.astype(f32), DN_CHUNK) for t in (q, k, v))
    bc = _to_chunks(beta[..., None].astype(f32), DN_CHUNK)
    gcum = jnp.cumsum(_to_chunks(g[..., None].astype(f32), DN_CHUNK), axis=-2)
    glast = gcum[..., -1:, :]
    diff = gcum - jnp.swapaxes(gcum, -1, -2)
    idx = jnp.arange(DN_CHUNK)
    dec_strict = jnp.exp(jnp.where(idx[:, None] > idx[None, :], diff, -jnp.inf))
    dec_incl = jnp.exp(jnp.where(idx[:, None] >= idx[None, :], diff, -jnp.inf))
    kb = kc * bc
    tinv = _unit_lower_inverse(jnp.einsum('nbhid,nbhjd->nbhij', kb, kc) * dec_strict)
    u = tinv @ (vc * bc)
    w = tinv @ (kb * jnp.exp(gcum))
    attn = jnp.einsum('nbhid,nbhjd->nbhij', qc, kc) * dec_incl
    q_dec = qc * jnp.exp(gcum)
    k_end = kc * jnp.exp(glast - gcum)

    def step(state, inp):
        ui, wi, ai, qi, ki, gl = inp
        v_new = ui - wi @ state
        o = qi @ state + ai @ v_new
        state = state * jnp.exp(gl) + jnp.einsum('bhjd,bhjv->bhdv', ki, v_new)
        return state, o

    s0 = jnp.zeros((bsz, nh, dk, dv), f32)
    _, o = lax.scan(step, s0, (u, w, attn, q_dec, k_end, glast))
    return _from_chunks(o).astype(v.dtype)


def _centred_dwconv(z, w):
    k = w.shape[0]
    return lax.conv_general_dilated(z, w[:, None, :].astype(z.dtype), window_strides=(1,),
                                    padding=[(k // 2, k // 2)],
                                    dimension_numbers=('NWC', 'WIO', 'NWC'),
                                    feature_group_count=z.shape[-1])


def _axial_rope_tables(n_lat):
    rows = n_lat // GRID_W
    pr = jnp.broadcast_to(jnp.arange(rows, dtype=jnp.float32)[:, None], (rows, GRID_W)).reshape(-1)
    pc = jnp.broadcast_to(jnp.arange(GRID_W, dtype=jnp.float32)[None, :], (rows, GRID_W)).reshape(-1)
    axis_dim = ATT_HD // 2
    inv = ROPE_THETA ** (-jnp.arange(0, axis_dim, 2, dtype=jnp.float32) / axis_dim)
    ar = pr[:, None] * inv
    ac = pc[:, None] * inv
    return (jnp.cos(ar), jnp.sin(ar), jnp.cos(ac), jnp.sin(ac))


def _apply_axial_rope(x, tabs):
    cr, sr, cc, sc = (t[:, None, :].astype(x.dtype) for t in tabs)
    r1, r2, c1, c2 = jnp.split(x, 4, axis=-1)
    return jnp.concatenate([r1 * cr - r2 * sr, r2 * cr + r1 * sr,
                            c1 * cc - c2 * sc, c2 * cc + c1 * sc], axis=-1)


def _gqa_attend(q, k, v):
    bsz, nq, nh, hd = q.shape
    kvh = k.shape[2]
    qg = q.reshape(bsz, nq, kvh, nh // kvh, hd)
    s = jnp.einsum('bqkgd,bskd->bkgqs', qg, k, preferred_element_type=jnp.float32) * (hd ** -0.5)
    p = jax.nn.softmax(s, axis=-1).astype(v.dtype)
    o = jnp.einsum('bkgqs,bskd->bqkgd', p, v)
    return o.reshape(bsz, nq, nh * hd)


def _gqa_blocked(q, k, v):
    bsz, nq, nh, hd = q.shape
    qb = q.reshape(bsz, nq // Q_BLOCK, Q_BLOCK, nh, hd).transpose(1, 0, 2, 3, 4)
    ob = lax.map(lambda qi: _gqa_attend(qi, k, v), qb)
    return ob.transpose(1, 0, 2, 3).reshape(bsz, nq, nh * hd)


def _mixer(hc, hl, w_in, gla_wa1, gla_wa2, gla_ba, gla_norm_g, dn_conv, dn_wab, dn_a_log,
           dn_dt_bias, dn_norm_g, q_norm_g, k_norm_g, w_out, need_ctx):
    bsz, n_ctx, _ = hc.shape
    n_lat = hl.shape[1]
    t = n_ctx + n_lat
    h = jnp.concatenate([hc, hl], axis=1)
    offs = np.cumsum(IN_WIDTHS)[:-1].tolist()
    (g_q, g_k, g_v, g_r, d_q, d_k, d_v, d_gate, a_q, a_k, a_v) = jnp.split(h @ w_in, offs, axis=-1)

    gq = g_q.reshape(bsz, t, GLA_HEADS, GLA_DK) * (GLA_DK ** -0.5)
    gk = g_k.reshape(bsz, t, GLA_HEADS, GLA_DK)
    gv = g_v.reshape(bsz, t, GLA_HEADS, GLA_DV)
    gla_dirs = []
    for d in range(2):
        logit = ((h @ gla_wa1[d]) @ gla_wa2[d] + gla_ba[d]).astype(jnp.float32)
        log_a = (jax.nn.log_sigmoid(logit) / GLA_TAU).reshape(bsz, t, GLA_HEADS, GLA_DK)
        gla_dirs.append(_directional(_gla_chunked, (gq, gk, gv, log_a), n_ctx, d == 1))
    gla_o = _rmsnorm(gla_dirs[0] + gla_dirs[1], gla_norm_g) * jax.nn.silu(g_r.reshape(bsz, t, GLA_HEADS, GLA_DV))
    gla_o = gla_o.reshape(bsz, t, GLA_V_W)

    qkv = jnp.concatenate([d_q, d_k, d_v], axis=-1)
    qkv = jax.nn.silu(jnp.concatenate([_centred_dwconv(qkv[:, :n_ctx], dn_conv),
                                       _centred_dwconv(qkv[:, n_ctx:], dn_conv)], axis=1))
    dq, dk, dv = jnp.split(qkv, [DN_QK_W, 2 * DN_QK_W], axis=-1)
    dq = _l2norm(dq.reshape(bsz, t, DN_HEADS, DN_DK)) * (DN_DK ** -0.5)
    dk = _l2norm(dk.reshape(bsz, t, DN_HEADS, DN_DK))
    dv = dv.reshape(bsz, t, DN_HEADS, DN_DV)
    dn_dirs = []
    for d in range(2):
        a_in, b_in = jnp.split((h @ dn_wab[d]).astype(jnp.float32), 2, axis=-1)
        g = -jnp.exp(dn_a_log[d].astype(jnp.float32)) * jax.nn.softplus(a_in + dn_dt_bias[d].astype(jnp.float32))
        beta = jax.nn.sigmoid(b_in)
        dn_dirs.append(_directional(_gated_delta_chunked, (dq, dk, dv, beta, g), n_ctx, d == 1))
    dn_o = _rmsnorm(dn_dirs[0] + dn_dirs[1], dn_norm_g) * jax.nn.silu(d_gate.reshape(bsz, t, DN_HEADS, DN_DV))
    dn_o = dn_o.reshape(bsz, t, DN_V_W)

    aq = _rmsnorm(a_q.reshape(bsz, t, ATT_HEADS, ATT_HD), q_norm_g)
    ak = _rmsnorm(a_k.reshape(bsz, t, ATT_KV_HEADS, ATT_HD), k_norm_g)
    av = a_v.reshape(bsz, t, ATT_KV_HEADS, ATT_HD)
    rope = _axial_rope_tables(n_lat)
    q_lat = _apply_axial_rope(aq[:, n_ctx:], rope)
    k_all = jnp.concatenate([ak[:, :n_ctx], _apply_axial_rope(ak[:, n_ctx:], rope)], axis=1)
    att_lat = _gqa_blocked(q_lat, k_all, av)
    y_lat = jnp.concatenate([gla_o[:, n_ctx:], dn_o[:, n_ctx:], att_lat], axis=-1) @ w_out
    if not need_ctx:
        return None, y_lat
    att_ctx = _gqa_attend(aq[:, :n_ctx], ak[:, :n_ctx], av[:, :n_ctx])
    y_ctx = jnp.concatenate([gla_o[:, :n_ctx], dn_o[:, :n_ctx], att_ctx], axis=-1) @ w_out
    return y_ctx, y_lat


def setup_inputs(seed: int = 0) -> dict:
    key = jax.random.key(seed)
    ks = jax.random.split(key, 24)
    f32 = jnp.float32

    def nrm(k, shape, scale):
        return jax.random.normal(k, shape, f32) * scale

    nl = DEPTH
    dt = jnp.exp(jax.random.uniform(ks[19], (nl, 2, DN_HEADS), f32, math.log(1e-3), math.log(1e-1)))
    return {
        'x': nrm(ks[0], (BATCH, SEQ, D_MODEL), 1.0),
        'c': nrm(ks[1], (BATCH, D_MODEL), 1.0),
        'ctx': nrm(ks[2], (BATCH, CTX_LEN, D_MODEL), 1.0),
        'c_ctx': nrm(ks[3], (D_MODEL,), 1.0),
        'w_ada': nrm(ks[4], (nl, D_MODEL, N_MOD * D_MODEL), 0.5 * D_MODEL ** -0.5),
        'b_ada': nrm(ks[5], (nl, N_MOD * D_MODEL), 0.02),
        'ln_g': 1.0 + nrm(ks[6], (nl, 3, D_MODEL), 0.02),
        'ln_b': nrm(ks[7], (nl, 3, D_MODEL), 0.02),
        'w_ffn_gate': nrm(ks[8], (nl, 2, D_MODEL, D_FF), D_MODEL ** -0.5),
        'w_ffn_up': nrm(ks[9], (nl, 2, D_MODEL, D_FF), D_MODEL ** -0.5),
        'w_ffn_down': nrm(ks[10], (nl, 2, D_FF, D_MODEL), DEEPNORM_BETA * D_FF ** -0.5),
        'w_in': nrm(ks[11], (nl, D_MODEL, IN_WIDTH), D_MODEL ** -0.5),
        'gla_wa1': nrm(ks[12], (nl, 2, D_MODEL, GLA_RANK), D_MODEL ** -0.5),
        'gla_wa2': nrm(ks[13], (nl, 2, GLA_RANK, GLA_QK_W), GLA_RANK ** -0.5),
        'gla_ba': nrm(ks[14], (nl, 2, GLA_QK_W), 0.1),
        'gla_norm_g': 1.0 + nrm(ks[15], (nl, GLA_DV), 0.02),
        'dn_conv': nrm(ks[16], (nl, DN_CONV, 2 * DN_QK_W + DN_V_W), DN_CONV ** -0.5),
        'dn_wab': nrm(ks[17], (nl, 2, D_MODEL, 2 * DN_HEADS), D_MODEL ** -0.5),
        'dn_a_log': jnp.log(jax.random.uniform(ks[18], (nl, 2, DN_HEADS), f32, 1.0, 16.0)),
        'dn_dt_bias': dt + jnp.log(-jnp.expm1(-dt)),
        'dn_norm_g': 1.0 + nrm(ks[20], (nl, DN_DV), 0.02),
        'q_norm_g': 1.0 + nrm(ks[21], (nl, ATT_HD), 0.02),
        'k_norm_g': 1.0 + nrm(ks[22], (nl, ATT_HD), 0.02),
        'w_out': nrm(ks[23], (nl, MIX_WIDTH, D_MODEL), DEEPNORM_BETA * MIX_WIDTH ** -0.5),
    }


def reference(x, c, ctx, c_ctx, w_ada, b_ada, ln_g, ln_b, w_ffn_gate, w_ffn_up, w_ffn_down, w_in,
              gla_wa1, gla_wa2, gla_ba, gla_norm_g, dn_conv, dn_wab, dn_a_log, dn_dt_bias, dn_norm_g,
              q_norm_g, k_norm_g, w_out):
    bsz = x.shape[0]
    s_c = jax.nn.silu(c)
    s_cc = jax.nn.silu(c_ctx)
    xl, xc = x, ctx
    for layer in range(DEPTH):
        last = layer == DEPTH - 1
        mod_l = (s_c @ w_ada[layer] + b_ada[layer]).reshape(bsz, N_MOD, 1, D_MODEL)
        mod_c = (s_cc @ w_ada[layer] + b_ada[layer]).reshape(N_MOD, D_MODEL)
        xc = _ffn_sublayer(xc, mod_c[0], mod_c[1], mod_c[2], w_ffn_gate[layer, 0], w_ffn_up[layer, 0],
                           w_ffn_down[layer, 0], ln_g[layer, 0], ln_b[layer, 0])
        xl = _ffn_sublayer(xl, mod_l[:, 0], mod_l[:, 1], mod_l[:, 2], w_ffn_gate[layer, 0], w_ffn_up[layer, 0],
                           w_ffn_down[layer, 0], ln_g[layer, 0], ln_b[layer, 0])
        yc, yl = _mixer(_modulate(xc, mod_c[3], mod_c[4]), _modulate(xl, mod_l[:, 3], mod_l[:, 4]),
                        w_in[layer], gla_wa1[layer], gla_wa2[layer], gla_ba[layer], gla_norm_g[layer],
                        dn_conv[layer], dn_wab[layer], dn_a_log[layer], dn_dt_bias[layer], dn_norm_g[layer],
                        q_norm_g[layer], k_norm_g[layer], w_out[layer], not last)
        xl = _post_norm(xl, yl, mod_l[:, 5], ln_g[layer, 1], ln_b[layer, 1])
        xl = _ffn_sublayer(xl, mod_l[:, 6], mod_l[:, 7], mod_l[:, 8], w_ffn_gate[layer, 1], w_ffn_up[layer, 1],
                           w_ffn_down[layer, 1], ln_g[layer, 2], ln_b[layer, 2])
        if not last:
            xc = _post_norm(xc, yc, mod_c[5], ln_g[layer, 1], ln_b[layer, 1])
            xc = _ffn_sublayer(xc, mod_c[6], mod_c[7], mod_c[8], w_ffn_gate[layer, 1], w_ffn_up[layer, 1],
                               w_ffn_down[layer, 1], ln_g[layer, 2], ln_b[layer, 2])
    return xl
```

```cpp
#include <hip/hip_runtime.h>
#include <cstdio>
#include <cstdint>
#include <cmath>
#define GAS1 __attribute__((address_space(1)))
typedef __attribute__((address_space(1))) unsigned char* gptr_t;
__device__ __forceinline__ gptr_t lptr(unsigned char* p) { gptr_t g = (gptr_t)p; asm volatile("" : "+s"(g)); return g; }
__device__ __forceinline__ int ltid_from(int wv) { int l; asm volatile("v_mbcnt_lo_u32_b32 %0, -1, 0\n\tv_mbcnt_hi_u32_b32 %0, -1, %0" : "=v"(l)); return wv * 64 + l; }
#define ltid() ltid_from(wv_)

namespace pg8 {
#define PG8_LAS __attribute__((address_space(3)))
typedef unsigned short bf16_t;
typedef short bf16x8 __attribute__((ext_vector_type(8)));
typedef float f32x4 __attribute__((ext_vector_type(4)));
typedef unsigned u32x4 __attribute__((ext_vector_type(4)));
constexpr int BM = 256, BK = 64, HALF = 128, HTB = HALF * BK * 2  , STAGE_BYTES = 8 * HTB, NXCD = 8, WGM = 8;

__host__ __device__ __forceinline__ int lds_byte(int r, int c) { const int st = (r >> 4) * 2 + (c >> 5), rr = r & 15, cc = c & 31, ob = rr * 64 + cc * 2; return st * 1024 + (ob ^ (((ob >> 9) & 1) << 5)); }
__host__ __device__ __forceinline__ void stage_rc(int b, int& R, int& C) { const int st = b / 1024, sb = b % 1024, swz = sb ^ (((sb >> 9) & 1) << 5); R = (st >> 1) * 16 + swz / 64; C = (st & 1) * 32 + (swz % 64) / 2; }
__host__ __device__ __forceinline__ int perm32(int rho) { const int n = rho >> 4, i = rho & 15; return 8 * (i >> 2) + 4 * n + (i & 3); }

struct Unit { int pm, pn, kt0, nkt, part; };
struct Gemm { const bf16_t* A; const bf16_t* Bt; int M, N, K; };

struct StaticOrder {
    int nM, nN, nwg, G, c;
    __host__ __device__ void init(int M, int N, int G_, int c_) { nM = M / BM; nN = N / BM; nwg = nM * nN; G = G_; c = c_; }
    __host__ __device__ bool next(int i, Unit& u) const {
        const long L = (long)i * G + c; if (L >= nwg) return false;
        int wgid = (int)L; { const int q = nwg / NXCD, r = nwg % NXCD, xcd = wgid % NXCD, off = wgid / NXCD; wgid = (xcd < r ? xcd * (q + 1) : r * (q + 1) + (xcd - r) * q) + off; }
        const int nig = WGM * nN, gid = wgid / nig, fm = gid * WGM, gsz = (nM - fm) < WGM ? (nM - fm) : WGM;
        u.pm = fm + ((wgid % nig) % gsz); u.pn = (wgid % nig) / gsz; u.kt0 = 0; u.nkt = 0; u.part = 0; return true;
    }
    __device__ __forceinline__ void a_ready(const Unit&) const {}
    __device__ __forceinline__ void done(const Unit&) const {}
};

__device__ __forceinline__ unsigned cvt_pk_bf16(float lo, float hi) { unsigned r; asm volatile("v_cvt_pk_bf16_f32 %0, %1, %2" : "=v"(r) : "v"(lo), "v"(hi)); return r; }

struct EpiStoreBf16 {
    static constexpr bool PERM = true, AFTER_DRAIN = false;
    bf16_t* O; int ldc;
    __device__ __forceinline__ void operator()(const f32x4 (&acc)[2][2][4][2], const Unit& u, int wr, int wc, int fr, int fq) const {
        const int row0 = u.pm * BM + wr * 64 + fr, col0 = u.pn * BM + wc * 32 + 8 * fq;
#pragma unroll
        for (int ai = 0; ai < 2; ++ai)
#pragma unroll
            for (int m = 0; m < 4; ++m) { bf16_t* rowp = O + (size_t)(row0 + ai * HALF + m * 16) * ldc + col0;
#pragma unroll
                for (int bj = 0; bj < 2; ++bj) { const f32x4 v0 = acc[ai][bj][m][0], v1 = acc[ai][bj][m][1];
                    u32x4 w; w.x = cvt_pk_bf16(v0[0], v0[1]); w.y = cvt_pk_bf16(v0[2], v0[3]); w.z = cvt_pk_bf16(v1[0], v1[1]); w.w = cvt_pk_bf16(v1[2], v1[3]);
                    *(u32x4*)(rowp + bj * HALF) = w; } }
    }
};
__device__ __forceinline__ float silu_fast(float g) { return g * __builtin_amdgcn_rcpf(1.0f + __builtin_amdgcn_exp2f(-1.4426950408889634f * g)); }
struct EpiSwiglu {
    static constexpr bool PERM = true, AFTER_DRAIN = false;
    bf16_t* O; int ldc;
    __device__ __forceinline__ void operator()(const f32x4 (&acc)[2][2][4][2], const Unit& u, int wr, int wc, int fr, int fq) const {
        const int row0 = u.pm * BM + wr * 64 + fr, col0 = u.pn * HALF + wc * 32 + 8 * fq;
#pragma unroll
        for (int ai = 0; ai < 2; ++ai)
#pragma unroll
            for (int m = 0; m < 4; ++m) { bf16_t* rowp = O + (size_t)(row0 + ai * HALF + m * 16) * ldc + col0;
                const f32x4 g0 = acc[ai][0][m][0], g1 = acc[ai][0][m][1], u0 = acc[ai][1][m][0], u1 = acc[ai][1][m][1];
                float r[8];
#pragma unroll
                for (int i = 0; i < 4; ++i) { r[i] = silu_fast(g0[i]) * u0[i]; r[4 + i] = silu_fast(g1[i]) * u1[i]; }
                u32x4 w; w.x = cvt_pk_bf16(r[0], r[1]); w.y = cvt_pk_bf16(r[2], r[3]); w.z = cvt_pk_bf16(r[4], r[5]); w.w = cvt_pk_bf16(r[6], r[7]);
                *(u32x4*)rowp = w; }
    }
};
struct EpiDelta {
    static constexpr bool PERM = true, AFTER_DRAIN = false;
    bf16_t* D; bf16_t* PART; const float* modl; int gidx; float coef; int nkt_full;
    __device__ __forceinline__ void operator()(const f32x4 (&acc)[2][2][4][2], const Unit& u, int wr, int wc, int fr, int fq) const {
        const int mi = (u.pm % 17 == 0) ? 4 : (u.pm / 17);
        const float* gp = modl + (size_t)mi * 18432 + gidx * 2048;
        const int col0 = u.pn * BM + wc * 32 + 8 * fq;
        const bool part = u.nkt != nkt_full;
#pragma unroll
        for (int bj = 0; bj < 2; ++bj) {
            const f32x4 g0 = *(const f32x4*)(gp + col0 + bj * HALF) * coef, g1 = *(const f32x4*)(gp + col0 + bj * HALF + 4) * coef;
#pragma unroll
            for (int ai = 0; ai < 2; ++ai)
#pragma unroll
                for (int m = 0; m < 4; ++m) { const int rt = ai * HALF + wr * 64 + m * 16 + fr;
                    const f32x4 d0 = g0 * acc[ai][bj][m][0], d1 = g1 * acc[ai][bj][m][1];
                    u32x4 w; w.x = cvt_pk_bf16(d0[0], d0[1]); w.y = cvt_pk_bf16(d0[2], d0[3]); w.z = cvt_pk_bf16(d1[0], d1[1]); w.w = cvt_pk_bf16(d1[2], d1[3]);
                    if (part) *(u32x4*)(PART + ((size_t)u.part * 1024 + (size_t)(u.pm / 17) * 256 + rt) * 2048 + col0 + bj * HALF) = w;
                    else *(u32x4*)(D + (size_t)(u.pm * BM + rt) * 2048 + col0 + bj * HALF) = w; }
        }
    }
};

template <class Epi, class Sched, bool ALIGN_EPI = false, bool SP2 = false>
__device__ __forceinline__ void gemm_phase(PG8_LAS unsigned char* lds, const Gemm g, const Sched& S, const Epi& E, int wv_) {
    const int tid = ltid(), wid = __builtin_amdgcn_readfirstlane(tid >> 6), lane = tid & 63, wr = wid >> 2, wc = wid & 3, fr = lane & 15, fq = lane >> 4;
    const int K = g.K;
    unsigned voffA[2], voffB[2];
#pragma unroll
    for (int i = 0; i < 2; ++i) { int R, C; stage_rc(tid * 16 + i * 8192, R, C); const int Rb = Epi::PERM ? ((R & ~31) + perm32(R & 31)) : R;
        voffA[i] = (unsigned)(R * K + C) * 2u; voffB[i] = (unsigned)(Rb * K + C) * 2u; }
    const size_t kstep = (size_t)(BK * 2);
    const size_t hstep = (size_t)HALF * K * 2;
    const size_t tstep = 2 * hstep;
    const unsigned ldsw = (unsigned)wid * 1024u;
    const int aoff = lds_byte(wr * 64 + fr, fq * 8), boff = lds_byte(wc * 32 + fr, fq * 8);
#define PG8_SA(b, h) (((b) * 2 + (h)) * HTB)
#define PG8_SB(b, h) ((4 + (b) * 2 + (h)) * HTB)
#define PG8_STAGE(bufoff, gbase, voff) do { _Pragma("unroll") for (int _i = 0; _i < 2; ++_i) \
        __builtin_amdgcn_global_load_lds((const unsigned*)((const char*)(gbase) + (voff)[_i]), (PG8_LAS unsigned*)(lds + (bufoff) + ldsw + _i * 8192), 16, 0, 0); } while (0)
#define PG8_LDA(dst, b, h) do { _Pragma("unroll") for (int m = 0; m < 4; ++m) _Pragma("unroll") for (int k = 0; k < 2; ++k) dst[m][k] = *(const PG8_LAS bf16x8*)(lds + PG8_SA(b, h) + aoff + m * 2048 + k * 1024); } while (0)
#define PG8_LDB(dst, b, h) do { _Pragma("unroll") for (int n = 0; n < 2; ++n) _Pragma("unroll") for (int k = 0; k < 2; ++k) dst[n][k] = *(const PG8_LAS bf16x8*)(lds + PG8_SB(b, h) + boff + n * 2048 + k * 1024); } while (0)
#define PG8_MMA(ai, bj, At, Bt) do { __builtin_amdgcn_s_setprio(1); _Pragma("unroll") for (int m = 0; m < 4; ++m) _Pragma("unroll") for (int n = 0; n < 2; ++n) _Pragma("unroll") for (int k = 0; k < 2; ++k) \
        acc[ai][bj][m][n] = __builtin_amdgcn_mfma_f32_16x16x32_bf16(Bt[n][k], At[m][k], acc[ai][bj][m][n], 0, 0, 0); __builtin_amdgcn_s_setprio(0); } while (0)
#define PG8_WAIT_V(n) asm volatile("s_waitcnt vmcnt(" #n ")" ::: "memory")
#define PG8_WAIT_L(n) asm volatile("s_waitcnt lgkmcnt(" #n ")" ::: "memory")
#define PG8_BAR __builtin_amdgcn_s_barrier()
#define PG8_SCHED __builtin_amdgcn_sched_barrier(0)
    Unit cur, nxt; int ui = 0;
    if (!S.next(0, cur)) return;
    f32x4 acc[2][2][4][2];
#pragma unroll
    for (int a = 0; a < 2; ++a)
#pragma unroll
        for (int b = 0; b < 2; ++b)
#pragma unroll
            for (int m = 0; m < 4; ++m)
#pragma unroll
                for (int n = 0; n < 2; ++n) acc[a][b][m][n] = (f32x4){0.f, 0.f, 0.f, 0.f};
    bf16x8 At[4][2], B0[2][2], B1[2][2];
    const char* cA = (const char*)g.A + (size_t)cur.pm * tstep + (size_t)cur.kt0 * kstep; const char* cB = (const char*)g.Bt + (size_t)cur.pn * tstep + (size_t)cur.kt0 * kstep;
    S.a_ready(cur);
    if constexpr (SP2) {
        PG8_STAGE(PG8_SB(0, 0), cB, voffB); PG8_STAGE(PG8_SB(0, 1), cB + hstep, voffB); PG8_STAGE(PG8_SA(0, 0), cA, voffA); PG8_STAGE(PG8_SA(0, 1), cA + hstep, voffA);
        if (wr == 1) PG8_BAR;
        PG8_WAIT_V(2); PG8_BAR;
        PG8_STAGE(PG8_SB(1, 0), cB + kstep, voffB); PG8_STAGE(PG8_SA(1, 0), cA + kstep, voffA); PG8_STAGE(PG8_SB(1, 1), cB + hstep + kstep, voffB);
        PG8_WAIT_V(6); PG8_BAR;
    } else {
        PG8_STAGE(PG8_SB(0, 0), cB, voffB); PG8_STAGE(PG8_SA(0, 0), cA, voffA); PG8_STAGE(PG8_SB(0, 1), cB + hstep, voffB); PG8_STAGE(PG8_SA(0, 1), cA + hstep, voffA);
        if (wr == 1) PG8_BAR;
        PG8_WAIT_V(4); PG8_BAR;
        PG8_STAGE(PG8_SB(1, 0), cB + kstep, voffB); PG8_STAGE(PG8_SA(1, 0), cA + kstep, voffA); PG8_STAGE(PG8_SB(1, 1), cB + hstep + kstep, voffB);
        PG8_WAIT_V(6); PG8_BAR;
    }
    for (;;) {
        const bool has_next = S.next(ui + 1, nxt);
        const char* nA = has_next ? (const char*)g.A + (size_t)nxt.pm * tstep + (size_t)nxt.kt0 * kstep : cA; const char* nB = has_next ? (const char*)g.Bt + (size_t)nxt.pn * tstep + (size_t)nxt.kt0 * kstep : cB;
        const int nt = cur.nkt;
        for (int t = 0; t < nt; t += 2) {
            const bool last = (t == nt - 2);
            const char* a1 = cA + (size_t)(t + 1) * kstep;
            const char* a2 = last ? nA : cA + (size_t)(t + 2) * kstep; const char* b2 = last ? nB : cB + (size_t)(t + 2) * kstep;
            const char* a3 = a2 + kstep; const char* b3 = b2 + kstep;
            if (last && has_next) S.a_ready(nxt);
            if constexpr (SP2) {
            PG8_LDB(B0, 0, 0); PG8_LDB(B1, 0, 1); PG8_SCHED; PG8_LDA(At, 0, 0); PG8_STAGE(PG8_SA(1, 1), a1 + hstep, voffA);
            PG8_WAIT_V(8); PG8_WAIT_L(0); PG8_BAR; PG8_MMA(0, 0, At, B0); PG8_MMA(0, 1, At, B1); PG8_BAR; PG8_SCHED;
            PG8_LDA(At, 0, 1); PG8_STAGE(PG8_SB(0, 0), b2, voffB); PG8_STAGE(PG8_SB(0, 1), b2 + hstep, voffB); PG8_STAGE(PG8_SA(0, 0), a2, voffA);
            PG8_WAIT_V(8); PG8_WAIT_L(0); PG8_BAR; PG8_MMA(1, 0, At, B0); PG8_MMA(1, 1, At, B1); PG8_BAR; PG8_SCHED;
            PG8_LDB(B0, 1, 0); PG8_LDB(B1, 1, 1); PG8_SCHED; PG8_LDA(At, 1, 0); PG8_STAGE(PG8_SA(0, 1), a2 + hstep, voffA);
            PG8_WAIT_V(8); PG8_WAIT_L(0); PG8_BAR; PG8_MMA(0, 0, At, B0); PG8_MMA(0, 1, At, B1); PG8_BAR; PG8_SCHED;
            PG8_LDA(At, 1, 1); PG8_STAGE(PG8_SB(1, 0), b3, voffB); PG8_STAGE(PG8_SB(1, 1), b3 + hstep, voffB); PG8_STAGE(PG8_SA(1, 0), a3, voffA);
            PG8_WAIT_V(8); PG8_WAIT_L(0); PG8_BAR; PG8_MMA(1, 0, At, B0); PG8_MMA(1, 1, At, B1); PG8_BAR; PG8_SCHED;
            } else {
            PG8_LDB(B0, 0, 0); PG8_SCHED; PG8_LDA(At, 0, 0); PG8_STAGE(PG8_SA(1, 1), a1 + hstep, voffA);
            PG8_WAIT_L(8); PG8_BAR; PG8_WAIT_L(0); PG8_MMA(0, 0, At, B0); PG8_BAR; PG8_SCHED;
            PG8_LDB(B1, 0, 1); PG8_STAGE(PG8_SB(0, 0), b2, voffB);
            PG8_BAR; PG8_WAIT_L(0); PG8_MMA(0, 1, At, B1); PG8_BAR;
            PG8_LDA(At, 0, 1); PG8_STAGE(PG8_SA(0, 0), a2, voffA);
            PG8_BAR; PG8_WAIT_L(0); PG8_MMA(1, 0, At, B0); PG8_BAR; PG8_SCHED;
            PG8_STAGE(PG8_SB(0, 1), b2 + hstep, voffB);
            PG8_WAIT_V(6); PG8_BAR; PG8_MMA(1, 1, At, B1); PG8_BAR;
            PG8_LDB(B0, 1, 0); PG8_SCHED; PG8_LDA(At, 1, 0); PG8_STAGE(PG8_SA(0, 1), a2 + hstep, voffA);
            PG8_WAIT_L(8); PG8_BAR; PG8_WAIT_L(0); PG8_MMA(0, 0, At, B0); PG8_BAR; PG8_SCHED;
            PG8_LDB(B1, 1, 1); PG8_STAGE(PG8_SB(1, 0), b3, voffB);
            PG8_BAR; PG8_WAIT_L(0); PG8_MMA(0, 1, At, B1); PG8_BAR;
            PG8_LDA(At, 1, 1); PG8_STAGE(PG8_SA(1, 0), a3, voffA);
            PG8_BAR; PG8_WAIT_L(0); PG8_MMA(1, 0, At, B0); PG8_BAR; PG8_SCHED;
            PG8_STAGE(PG8_SB(1, 1), b3 + hstep, voffB);
            PG8_WAIT_V(6); PG8_BAR; PG8_MMA(1, 1, At, B1); PG8_BAR;
            }
        }
        if constexpr (ALIGN_EPI) { if (wr == 0) PG8_BAR; }
        if constexpr (!Epi::AFTER_DRAIN) { E(acc, cur, wr, wc, fr, fq); S.done(cur); }
        if (!has_next) break;
#pragma unroll
        for (int a = 0; a < 2; ++a)
#pragma unroll
            for (int b = 0; b < 2; ++b)
#pragma unroll
                for (int m = 0; m < 4; ++m)
#pragma unroll
                    for (int n = 0; n < 2; ++n) acc[a][b][m][n] = (f32x4){0.f, 0.f, 0.f, 0.f};
        cur = nxt; cA = nA; cB = nB; ++ui;
        if constexpr (ALIGN_EPI) { if (wr == 1) PG8_BAR; }
    }
    PG8_WAIT_V(0);
    if constexpr (!ALIGN_EPI) { if (wr == 0) PG8_BAR; }
    PG8_BAR;
    if constexpr (Epi::AFTER_DRAIN) { E.fused(acc, cur, wr, wc, fr, fq, lds, wid, lane); S.done(cur); }
#undef PG8_SA
#undef PG8_SB
#undef PG8_STAGE
#undef PG8_LDA
#undef PG8_LDB
#undef PG8_MMA
#undef PG8_WAIT_V
#undef PG8_WAIT_L
#undef PG8_BAR
#undef PG8_SCHED
}
}

#ifndef PG8_SP2
#define PG8_SP2 true
#endif
#ifndef PG8_ALIGN
#define PG8_ALIGN true
#endif

namespace att {
using bf16 = unsigned short;
constexpr int   D = 128, NW = 8, QBLK = 32, KVBLK = 64;
constexpr float SCALE = 0.088388347648318440f;
constexpr float THR = 8.f;
constexpr int SDEPTH = 2;
constexpr int LDQ = 1024, LDK = 512, LDO = 2048;
constexpr size_t SHM_V = KVBLK * D * 2, SHM_K = KVBLK * D * 2, SHM_ATTN = 2 * SHM_V + 2 * SHM_K + NW * 64 * 4;
__device__ __forceinline__ unsigned short f2bf_rne(float f) { unsigned u = __builtin_bit_cast(unsigned, f); return (unsigned short)((u + 0x7fffu + ((u >> 16) & 1u)) >> 16); }
using bf16x8 = __attribute__((ext_vector_type(8))) short;
using s16x4  = __attribute__((ext_vector_type(4))) short;
using f32x16 = __attribute__((ext_vector_type(16))) float;
using f32x8  = __attribute__((ext_vector_type(8))) float;
using u32x4  = __attribute__((ext_vector_type(4))) unsigned;
#define KSWZ(row, colB) ((row) * 256 + ((colB) ^ (((row) & 7) << 4)))
#define SBAR() __builtin_amdgcn_sched_barrier(0)
__device__ __forceinline__ int crow(int r, int hi) { return (r & 3) + 8 * (r >> 2) + 4 * hi; }
__device__ __forceinline__ unsigned cvtpk(float lo, float hi) {
  unsigned r; asm volatile("v_cvt_pk_bf16_f32 %0, %1, %2" : "=v"(r) : "v"(lo), "v"(hi)); return r;
}
template <typename TIn> struct Stage;
template <> struct Stage<bf16>  { using T = bf16x8;
  __device__ static __forceinline__ T ld8(const bf16* p) { return *reinterpret_cast<const bf16x8*>(p); }
  __device__ static __forceinline__ bf16x8 tobf(T x) { return x; } };
template <> struct Stage<float> { using T = f32x8;
  __device__ static __forceinline__ T ld8(const float* p) { return *reinterpret_cast<const f32x8*>(p); }
  __device__ static __forceinline__ bf16x8 tobf(T x) {
    u32x4 w = {cvtpk(x[0], x[1]), cvtpk(x[2], x[3]), cvtpk(x[4], x[5]), cvtpk(x[6], x[7])}; return *reinterpret_cast<bf16x8*>(&w); } };

__device__ __forceinline__ void partialSM(f32x16& p0, f32x16& p1, float& m_reg, float& mn, float& alpha) {
  constexpr float C = SCALE * 1.4426950408889634f;
  float pmax = p0[0]; for (int r = 1; r < 16; ++r) pmax = fmaxf(pmax, p0[r]); for (int r = 0; r < 16; ++r) pmax = fmaxf(pmax, p1[r]);
  { auto rr = __builtin_amdgcn_permlane32_swap(__float_as_uint(pmax), __float_as_uint(pmax), false, false);
    pmax = fmaxf(__uint_as_float(rr[0]), __uint_as_float(rr[1])); }
  if (__builtin_expect(__all(pmax - m_reg <= THR / SCALE), 1)) { mn = m_reg; alpha = 1.f; }
  else { mn = fmaxf(m_reg, pmax); alpha = __builtin_amdgcn_exp2f((m_reg - mn) * C); m_reg = mn; }
  float mnC = -mn * C;
  for (int r = 0; r < 16; ++r) p0[r] = fmaf(p0[r], C, mnC); for (int r = 0; r < 16; ++r) p1[r] = fmaf(p1[r], C, mnC);
  for (int r = 0; r < 16; ++r) p0[r] = __builtin_amdgcn_exp2f(p0[r]);
}
__device__ __forceinline__ void finishSM(f32x16& p0, f32x16& p1, float alpha, float& l_reg, bf16x8& pa0, bf16x8& pa1, bf16x8& pa2, bf16x8& pa3) {
  for (int r = 0; r < 16; ++r) p1[r] = __builtin_amdgcn_exp2f(p1[r]);
  float ps = 0; for (int r = 0; r < 16; ++r) ps += p0[r]; for (int r = 0; r < 16; ++r) ps += p1[r];
  { auto rr = __builtin_amdgcn_permlane32_swap(__float_as_uint(ps), __float_as_uint(ps), false, false);
    ps = __uint_as_float(rr[0]) + __uint_as_float(rr[1]); }
  l_reg = l_reg * alpha + ps;
#define PK4(P, BASE, OUT) do { unsigned a0 = cvtpk(P[BASE + 0], P[BASE + 1]), a1 = cvtpk(P[BASE + 2], P[BASE + 3]);   \
    unsigned b0 = cvtpk(P[BASE + 4], P[BASE + 5]), b1 = cvtpk(P[BASE + 6], P[BASE + 7]);                              \
    auto r0 = __builtin_amdgcn_permlane32_swap(a0, b0, false, false); auto r1 = __builtin_amdgcn_permlane32_swap(a1, b1, false, false); \
    u32x4 w = {r0[0], r1[0], r0[1], r1[1]}; OUT = *reinterpret_cast<bf16x8*>(&w); } while (0)
  PK4(p0, 0, pa0); PK4(p0, 8, pa1); PK4(p1, 0, pa2); PK4(p1, 8, pa3);
#undef PK4
}
__device__ __forceinline__ void qkt(f32x16& p0, f32x16& p1, const bf16* Ks, const bf16x8* qr, int r32, int hi) {
  p0 = f32x16{}; p1 = f32x16{};
  for (int d0 = 0; d0 < 8; ++d0) { int cb = (d0 * 16 + hi * 8) * 2;
    bf16x8 b0 = *reinterpret_cast<const bf16x8*>((const char*)Ks + KSWZ(r32, cb));
    bf16x8 b1 = *reinterpret_cast<const bf16x8*>((const char*)Ks + KSWZ(32 + r32, cb));
    p0 = __builtin_amdgcn_mfma_f32_32x32x16_bf16(b0, qr[d0], p0, 0, 0, 0);
    p1 = __builtin_amdgcn_mfma_f32_32x32x16_bf16(b1, qr[d0], p1, 0, 0, 0); }
}
__device__ __forceinline__ int v_st(int k, int c) { const int kk = (k & ~0xC) | ((k & 4) << 1) | ((k & 8) >> 1); return ((kk >> 3) * 4 + (c >> 5)) * 512 + ((kk & 7) * 32 + (c & 31)) * 2; }
__device__ __forceinline__ int v_rd_base(int lane) { return ((lane & 3) << 3) | (((lane >> 2) & 3) << 6) | (((lane >> 4) & 1) << 5) | (((lane >> 5) & 1) << 8); }
constexpr int v_rd_off(int d0, int ks, int half) { return d0 * 512 + ks * 4096 + half * 2048; }
template <int OFF> __device__ __forceinline__ s16x4 tr_read(int vb) {
  s16x4 r; asm volatile("ds_read_b64_tr_b16 %0, %1 offset:%2" : "=&v"(r) : "v"(vb), "i"(OFF) : "memory"); return r;
}
template <int D0> __device__ __forceinline__ void pv_one(f32x16& od, int vb, bf16x8 pa0, bf16x8 pa1, bf16x8 pa2, bf16x8 pa3) {
  const s16x4 l0 = tr_read<v_rd_off(D0, 0, 0)>(vb), h0 = tr_read<v_rd_off(D0, 0, 1)>(vb), l1 = tr_read<v_rd_off(D0, 1, 0)>(vb), h1 = tr_read<v_rd_off(D0, 1, 1)>(vb);
  const s16x4 l2 = tr_read<v_rd_off(D0, 2, 0)>(vb), h2 = tr_read<v_rd_off(D0, 2, 1)>(vb), l3 = tr_read<v_rd_off(D0, 3, 0)>(vb), h3 = tr_read<v_rd_off(D0, 3, 1)>(vb);
  asm volatile("s_waitcnt lgkmcnt(0)" ::: "memory"); SBAR();
#define PK(L, H) (bf16x8){L[0], L[1], L[2], L[3], H[0], H[1], H[2], H[3]}
  od = __builtin_amdgcn_mfma_f32_32x32x16_bf16(pa0, PK(l0, h0), od, 0, 0, 0);
  od = __builtin_amdgcn_mfma_f32_32x32x16_bf16(pa1, PK(l1, h1), od, 0, 0, 0);
  od = __builtin_amdgcn_mfma_f32_32x32x16_bf16(pa2, PK(l2, h2), od, 0, 0, 0);
  od = __builtin_amdgcn_mfma_f32_32x32x16_bf16(pa3, PK(l3, h3), od, 0, 0, 0);
#undef PK
}
__device__ __forceinline__ void pv_d0(f32x16* o, int vb, bf16x8 pa0, bf16x8 pa1, bf16x8 pa2, bf16x8 pa3) {
  pv_one<0>(o[0], vb, pa0, pa1, pa2, pa3); pv_one<1>(o[1], vb, pa0, pa1, pa2, pa3); pv_one<2>(o[2], vb, pa0, pa1, pa2, pa3); pv_one<3>(o[3], vb, pa0, pa1, pa2, pa3);
}

template <typename TQ>
__device__ __forceinline__ void attn_dense_body(const TQ* __restrict__ Qb, const bf16* __restrict__ Kh, const bf16* __restrict__ Vh,
                                                bf16* __restrict__ Ob, int seq, char* lds, int wv_) {
  using St = Stage<bf16>; using SQ = Stage<TQ>;
  const int tid = ltid(), wid = tid >> 6, lane = tid & 63, r32 = lane & 31, hi = lane >> 5;
  bf16* V_lds = (bf16*)lds; bf16* K_lds = (bf16*)(lds + 2 * SHM_V);
  float* ws = (float*)(lds + 2 * SHM_V + 2 * SHM_K) + wid * 64; float* li_l = ws; float* al_l = ws + 32;
  float m_reg = -1e30f, l_reg = 0; f32x16 o[4] = {}; bf16x8 qr[8];
  const TQ* Qw = Qb + (long)(wid * QBLK + r32) * LDQ + hi * 8;
#pragma unroll
  for (int d0 = 0; d0 < 8; ++d0) qr[d0] = SQ::tobf(SQ::ld8(Qw + d0 * 16));
  const int sr = tid >> 4, sc = (tid & 15) * 8, vst0 = v_st(sr, sc), vst1 = v_st(32 + sr, sc);
  const int vb0 = (int)(uintptr_t)V_lds + v_rd_base(lane);
  struct { typename St::T vs0, vs1, ks0, ks1; } sr_[SDEPTH];
#define SLOAD(i, k0) do { sr_[i].vs0 = St::ld8(&Vh[(long)((k0) + sr) * LDK + sc]); sr_[i].vs1 = St::ld8(&Vh[(long)((k0) + 32 + sr) * LDK + sc]); \
    sr_[i].ks0 = St::ld8(&Kh[(long)((k0) + sr) * LDK + sc]); sr_[i].ks1 = St::ld8(&Kh[(long)((k0) + 32 + sr) * LDK + sc]); } while (0)
#define SWRITE(b, i) do { *(bf16x8*)((char*)V_lds + (b) * SHM_V + vst0) = St::tobf(sr_[i].vs0);          \
    *(bf16x8*)((char*)V_lds + (b) * SHM_V + vst1) = St::tobf(sr_[i].vs1); int kc = sc * 2;               \
    *(bf16x8*)((char*)K_lds + (b) * SHM_K + KSWZ(sr, kc)) = St::tobf(sr_[i].ks0);                       \
    *(bf16x8*)((char*)K_lds + (b) * SHM_K + KSWZ(32 + sr, kc)) = St::tobf(sr_[i].ks1); } while (0)
#define SWAIT() do { if constexpr (SDEPTH == 2) asm volatile("s_waitcnt vmcnt(4)" ::: "memory"); else asm volatile("s_waitcnt vmcnt(0)" ::: "memory"); } while (0)
#define RESC(a) do { if (__any((a) < 1.f)) { if (hi == 0) al_l[r32] = (a); asm volatile("s_waitcnt lgkmcnt(0)" ::: "memory"); \
    for (int d = 0; d < 4; ++d) for (int r = 0; r < 16; ++r) o[d][r] *= al_l[crow(r, hi)]; } } while (0)
  f32x16 pA0, pA1, pB0, pB1; float mnA, mnB, alA, alB; bf16x8 pa0, pa1, pa2, pa3; const int NT = seq / KVBLK;
  constexpr int SE = 0, SO = SDEPTH - 1;
  SLOAD(SE, 0); asm volatile("s_waitcnt vmcnt(0)" ::: "memory"); SWRITE(0, SE); __syncthreads();
  qkt(pA0, pA1, K_lds, qr, r32, hi); partialSM(pA0, pA1, m_reg, mnA, alA);
  SLOAD(SO, KVBLK); if constexpr (SDEPTH == 2) { if (2 < NT) SLOAD(SE, 2 * KVBLK); }
  SWAIT(); SWRITE(1, SO); __syncthreads();
  for (int j = 1; j + 1 < NT; j += 2) {
    SBAR(); qkt(pB0, pB1, (bf16*)((char*)K_lds + SHM_K), qr, r32, hi);
    finishSM(pA0, pA1, alA, l_reg, pa0, pa1, pa2, pa3); SBAR();
    SLOAD(SO, (j + SDEPTH) * KVBLK); SBAR();
    pv_d0(o, vb0, pa0, pa1, pa2, pa3); partialSM(pB0, pB1, m_reg, mnB, alB);
    __syncthreads(); SWAIT(); SWRITE(0, SE);
    RESC(alB); __syncthreads();
    SBAR(); qkt(pA0, pA1, K_lds, qr, r32, hi);
    finishSM(pB0, pB1, alB, l_reg, pa0, pa1, pa2, pa3); SBAR();
    if (SDEPTH == 1 || j + 3 < NT) SLOAD(SE, (j + 1 + SDEPTH) * KVBLK); SBAR();
    pv_d0(o, vb0 + (int)SHM_V, pa0, pa1, pa2, pa3); partialSM(pA0, pA1, m_reg, mnA, alA);
    __syncthreads(); SWAIT(); SWRITE(1, SO);
    RESC(alA); __syncthreads();
  }
  SBAR(); qkt(pB0, pB1, (bf16*)((char*)K_lds + SHM_K), qr, r32, hi);
  finishSM(pA0, pA1, alA, l_reg, pa0, pa1, pa2, pa3); SBAR();
  pv_d0(o, vb0, pa0, pa1, pa2, pa3); partialSM(pB0, pB1, m_reg, mnB, alB);
  __syncthreads(); RESC(alB);
  finishSM(pB0, pB1, alB, l_reg, pa0, pa1, pa2, pa3); SBAR();
  pv_d0(o, vb0 + (int)SHM_V, pa0, pa1, pa2, pa3);
  if (hi == 0) li_l[r32] = l_reg; asm volatile("s_waitcnt lgkmcnt(0)" ::: "memory");
  float rli[16];
#pragma unroll
  for (int r = 0; r < 16; ++r) rli[r] = __builtin_amdgcn_rcpf(li_l[crow(r, hi)]);
  bf16* Ow = Ob + (long)(wid * QBLK) * LDO;
#pragma unroll
  for (int r = 0; r < 16; ++r) { int orow = crow(r, hi);
    for (int d0 = 0; d0 < 4; ++d0) Ow[(long)orow * LDO + d0 * 32 + r32] = f2bf_rne(o[d0][r] * rli[r]); }
#undef SLOAD
#undef SWRITE
#undef SWAIT
#undef RESC
}
}

typedef unsigned short bf16;
typedef float f32x4 __attribute__((ext_vector_type(4)));
typedef unsigned u32x4 __attribute__((ext_vector_type(4)));
typedef unsigned u32x2 __attribute__((ext_vector_type(2)));
typedef _Float16 h16x4 __attribute__((ext_vector_type(4)));
#define DI __device__ __forceinline__

constexpr int DM = 2048, NBATCH = 4, SEQL = 4096, CTXL = 256, TT = SEQL + CTXL  , MROWS = NBATCH * TT  ;
constexpr int FF = 5632, NLAYER = 2, NMODV = 9 * DM  ;
constexpr int ZW = 5376;
constexpr int ZGQ = 0, ZGK = 256, ZGV = 512, ZGR = 1024, ZDQ = 1536, ZDK = 2048, ZDV = 2560, ZDG = 3072, ZAQ = 3584, ZAK = 4608, ZAV = 4864, ZWA1 = 5120, ZWAB = 5152;
constexpr float LN_EPS = 1e-6f;
constexpr float DN_ALPHA = 1.4142135623730951f;
constexpr int NTHR = 512, NWAVE = 8;

constexpr size_t MiB = 1u << 20;
constexpr size_t WS_CTL = 0, CTL_ZERO_BYTES = 1 * MiB;
constexpr size_t WS_MOD = 1 * MiB;
constexpr size_t WS_ROPE = 2 * MiB;
constexpr size_t WS_WGU = 4 * MiB;
constexpr size_t WGU_ELEMS = (size_t)2 * FF * DM;
constexpr size_t WS_WD = 180 * MiB;
constexpr size_t WD_ELEMS = (size_t)DM * FF;
constexpr size_t WS_WIN = 268 * MiB;
constexpr size_t WIN_ELEMS = (size_t)ZW * DM;
constexpr size_t WS_WOUT = 310 * MiB;
constexpr size_t WOUT_ELEMS = (size_t)DM * DM;
constexpr size_t WS_XS = 326 * MiB;
constexpr size_t WS_H = 462 * MiB;
constexpr size_t WS_ACT = 530 * MiB;
constexpr size_t WS_LA = 717 * MiB;
constexpr size_t WS_DQ = 751 * MiB, WS_DK = 768 * MiB, WS_DV = 785 * MiB;
constexpr size_t WS_DBG = 802 * MiB;
constexpr size_t WS_AQ = 804 * MiB;
constexpr size_t WS_AKV = 838 * MiB;
constexpr size_t WS_GLAO = 855 * MiB;
constexpr size_t WS_DNO = 923 * MiB;
constexpr size_t WS_END = 991 * MiB;
constexpr size_t WS_DELTA = WS_GLAO;
constexpr size_t WS_PART = 1060 * MiB;
static_assert(WS_WGU + 4 * WGU_ELEMS * 2 <= WS_WD && WS_WD + 4 * WD_ELEMS * 2 <= WS_WIN && WS_WIN + 2 * WIN_ELEMS * 2 <= WS_WOUT && WS_WOUT + 2 * WOUT_ELEMS * 2 <= WS_XS, "ws map (weights)");
static_assert(WS_XS + (size_t)MROWS * DM * 4 <= WS_H && WS_H + (size_t)MROWS * DM * 2 <= WS_ACT && WS_ACT + (size_t)MROWS * FF * 2 <= WS_LA, "ws map (stream)");
static_assert(WS_LA + (size_t)2 * MROWS * 256 * 4 <= WS_DQ && WS_DQ + (size_t)MROWS * 512 * 2 <= WS_DK && WS_DV + (size_t)MROWS * 512 * 2 <= WS_DBG && WS_DBG + (size_t)4 * MROWS * 4 * 4 <= WS_AQ, "ws map (mixer 1)");
static_assert(WS_AQ + (size_t)MROWS * 1024 * 2 <= WS_AKV && WS_AKV + (size_t)MROWS * 512 * 2 <= WS_GLAO && WS_GLAO + (size_t)2 * MROWS * 512 * 4 <= WS_DNO && WS_DNO + (size_t)2 * MROWS * 512 * 4 <= WS_END, "ws map (mixer 2)");

struct Params {
    const float *x, *c, *ctx, *c_ctx, *w_ada, *b_ada, *ln_g, *ln_b, *w_gate, *w_up, *w_down, *w_in, *gla_wa1, *gla_wa2, *gla_ba, *gla_norm_g,
                *dn_conv, *dn_wab, *dn_a_log, *dn_dt_bias, *dn_norm_g, *q_norm_g, *k_norm_g, *w_out;
    float* out; unsigned char* ws;
};

#define GIN(p) ((const float*)(const GAS1 float*)(p))
typedef const __attribute__((address_space(4))) Params* KP;
typedef float f32x2_t __attribute__((ext_vector_type(2)));
typedef __bf16 bf16x2_t __attribute__((ext_vector_type(2)));
DI unsigned pk2(float lo, float hi) { const f32x2_t v = {lo, hi}; const bf16x2_t b = __builtin_convertvector(v, bf16x2_t); return __builtin_bit_cast(unsigned, b); }
DI unsigned f2bf(float f) { return pk2(f, 0.f) & 0xffffu; }
DI float bf2f(unsigned short b) { return __builtin_bit_cast(float, (unsigned)b << 16); }
DI float bflo(unsigned w) { return __builtin_bit_cast(float, w << 16); }
DI float bfhi(unsigned w) { return __builtin_bit_cast(float, w & 0xffff0000u); }
template <int MASK> DI float shx(float v) {
    static_assert(MASK >= 1 && MASK <= 32, "xor mask");
    if constexpr (MASK < 32) return __builtin_bit_cast(float, __builtin_amdgcn_ds_swizzle(__builtin_bit_cast(int, v), 0x1F | (MASK << 10)));
    else { const unsigned u = __builtin_bit_cast(unsigned, v); auto r = __builtin_amdgcn_permlane32_swap(u, u, false, false);
           const unsigned mine = __builtin_bit_cast(unsigned, v); return __builtin_bit_cast(float, r[0] == mine ? r[1] : r[0]); }
}
DI float wave_sum(float v) {
    v += shx<1>(v); v += shx<2>(v); v += shx<4>(v); v += shx<8>(v); v += shx<16>(v);
    return __builtin_bit_cast(float, __builtin_amdgcn_readlane(__builtin_bit_cast(int, v), 0)) + __builtin_bit_cast(float, __builtin_amdgcn_readlane(__builtin_bit_cast(int, v), 32));
    return v;
}
DI float silu_f(float v) { return v * __builtin_amdgcn_rcpf(1.0f + __builtin_amdgcn_exp2f(-1.4426950408889634f * v)); }
DI float log1pexp_neg_abs(float x) { return 0.6931471805599453f * __builtin_amdgcn_logf(1.0f + __builtin_amdgcn_exp2f(-1.4426950408889634f * fabsf(x))); }
DI float softplus_f(float x) { return fmaxf(x, 0.f) + log1pexp_neg_abs(x); }
DI float logsigmoid_f(float x) { return fminf(x, 0.f) - log1pexp_neg_abs(x); }
DI float rsqrt_f(float x) { return __builtin_amdgcn_rsqf(x); }

DI void phase_mod(KP P, char* lds, int bid, int nb, int wv_) {
    const gptr_t ws_ = lptr(P->ws);
    const int tid = ltid(), lane = tid & 63, ks = tid >> 6;
    float* s = (float*)lds;
    float* red = s + 5 * 2048;
    if (bid < 144) {
        for (int i = tid; i < 5 * 2048; i += NTHR) { const int j = i >> 11, k = i & 2047; const float v = j < 4 ? GIN(P->c)[j * 2048 + k] : GIN(P->c_ctx)[k]; s[i] = silu_f(v); }
        __syncthreads();
    }
    float* MOD = (float*)(ws_ + WS_MOD);
    for (int u = bid; u < 144; u += nb) {
        const int l = u / 72, n0 = (u % 72) * 256;
        const float* w = GIN(P->w_ada) + ((size_t)l * 2048 + ks * 256) * NMODV + n0 + 4 * lane;
        f32x4 a[5];
#pragma unroll
        for (int j = 0; j < 5; ++j) a[j] = (f32x4){0.f, 0.f, 0.f, 0.f};
#pragma unroll 1
        for (int k0 = 0; k0 < 256; k0 += 8) {
            f32x4 wv[8];
#pragma unroll
            for (int q = 0; q < 8; ++q) wv[q] = __builtin_nontemporal_load((const f32x4*)(w + (size_t)(k0 + q) * NMODV));
#pragma unroll
            for (int q = 0; q < 8; ++q) { const int kk = ks * 256 + k0 + q;
#pragma unroll
                for (int j = 0; j < 5; ++j) a[j] += wv[q] * s[j * 2048 + kk]; }
        }
#pragma unroll
        for (int j = 0; j < 5; ++j) *(f32x4*)(red + (ks * 5 + j) * 256 + 4 * lane) = a[j];
        __syncthreads();
        if (tid < 320) { const int j = tid >> 6; f32x4 sum = *(const f32x4*)(GIN(P->b_ada) + (size_t)l * NMODV + n0 + 4 * lane);
#pragma unroll
            for (int q = 0; q < 8; ++q) sum += *(const f32x4*)(red + (q * 5 + j) * 256 + 4 * lane);
            *(f32x4*)(MOD + ((size_t)l * 5 + j) * NMODV + n0 + 4 * lane) = sum; }
        __syncthreads();
    }
    if (bid == nb - 1) {
        float* R = (float*)(ws_ + WS_ROPE);
        for (int e = tid; e < 64 * 32; e += NTHR) { const int pos = e >> 5, i = e & 31; const float inv = powf(10000.0f, -(float)(2 * i) / 64.0f); const float ang = (float)pos * inv;
            R[2 * e] = cosf(ang); R[2 * e + 1] = sinf(ang); }
    }
}

struct WTile { const float* src; bf16* dst; int N, K, k0, n0; bool plain; };
DI float win_elem(KP P, int l, int k, int n) {
    if (n < 5120) return GIN(P->w_in)[((size_t)l * DM + k) * 5120 + n];
    if (n < 5136) return GIN(P->gla_wa1)[((size_t)(l * 2 + 0) * DM + k) * 16 + n - 5120];
    if (n < 5152) return GIN(P->gla_wa1)[((size_t)(l * 2 + 1) * DM + k) * 16 + n - 5136];
    if (n < 5160) return GIN(P->dn_wab)[((size_t)(l * 2 + 0) * DM + k) * 8 + n - 5152];
    if (n < 5168) return GIN(P->dn_wab)[((size_t)(l * 2 + 1) * DM + k) * 8 + n - 5160];
    return 0.f;
}
DI void phase_wcvt(KP P, char* lds, int bid, int nb, int wv_) {
    const gptr_t ws_ = lptr(P->ws);
    const int tid = ltid();
    float* scr = (float*)lds;
    constexpr int T_GU = 32 * 88, T_D = 88 * 16, T_IN = 32 * 42, T_OUT = 32 * 16;
    constexpr int NT = 4 * T_GU + 4 * T_D + 2 * T_IN + 2 * T_OUT;
    int lgen = 0;
#define WT_DESC(it, T) do { int r = (it); \
        if (r < 4 * T_GU) { const int m = r / T_GU, tile = r % T_GU, kb = tile / 88, j = tile % 88; \
            T.src = ((j & 1) ? GIN(P->w_up) : GIN(P->w_gate)) + (size_t)m * DM * FF + (size_t)(kb * 64) * FF + (j >> 1) * 128; T.N = FF; T.K = DM; T.k0 = kb * 64; T.n0 = j * 128; \
            T.dst = (bf16*)(ws_ + WS_WGU) + (size_t)m * WGU_ELEMS; T.plain = true; } \
        else if ((r -= 4 * T_GU) < 4 * T_D) { const int m = r / T_D, tile = r % T_D, kb = tile / 16, j = tile % 16; \
            T.src = GIN(P->w_down) + (size_t)m * FF * DM + (size_t)(kb * 64) * DM + j * 128; T.N = DM; T.K = FF; T.k0 = kb * 64; T.n0 = j * 128; \
            T.dst = (bf16*)(ws_ + WS_WD) + (size_t)m * WD_ELEMS; T.plain = true; } \
        else if ((r -= 4 * T_D) < 2 * T_IN) { const int l = r / T_IN, tile = r % T_IN, kb = tile / 42, j = tile % 42; \
            T.src = GIN(P->w_in) + (size_t)l * DM * 5120 + (size_t)(kb * 64) * 5120 + j * 128; T.N = 5120; T.K = DM; T.k0 = kb * 64; T.n0 = j * 128; \
            T.dst = (bf16*)(ws_ + WS_WIN) + (size_t)l * WIN_ELEMS; T.plain = j < 40; lgen = l; } \
        else { r -= 2 * T_IN; const int l = r / T_OUT, tile = r % T_OUT, kb = tile / 16, j = tile % 16; \
            T.src = GIN(P->w_out) + (size_t)l * DM * DM + (size_t)(kb * 64) * DM + j * 128; T.N = DM; T.K = DM; T.k0 = kb * 64; T.n0 = j * 128; \
            T.dst = (bf16*)(ws_ + WS_WOUT) + (size_t)l * WOUT_ELEMS; T.plain = true; } } while (0)
    WTile cur; f32x4 pre[4];
    int it = bid;
    if (it < NT) { WT_DESC(it, cur);
        if (cur.plain) {
#pragma unroll
            for (int i = 0; i < 4; ++i) { const int q = tid + 512 * i; pre[i] = __builtin_nontemporal_load((const f32x4*)(cur.src + (size_t)(q >> 5) * cur.N + (q & 31) * 4)); } } }
    for (; it < NT; it += nb) {
        const int lg = lgen;
        if (cur.plain) {
#pragma unroll
            for (int i = 0; i < 4; ++i) { const int q = tid + 512 * i; *(f32x4*)(scr + (q >> 5) * 132 + (q & 31) * 4) = pre[i]; }
        } else {
#pragma unroll 4
            for (int i = 0; i < 16; ++i) { const int kk = i * 4 + (tid >> 7), nn = tid & 127; scr[kk * 132 + nn] = win_elem(P, lg, cur.k0 + kk, cur.n0 + nn); }
        }
        const WTile done = cur;
        if (it + nb < NT) { WT_DESC(it + nb, cur);
            if (cur.plain) {
#pragma unroll
                for (int i = 0; i < 4; ++i) { const int q = tid + 512 * i; pre[i] = __builtin_nontemporal_load((const f32x4*)(cur.src + (size_t)(q >> 5) * cur.N + (q & 31) * 4)); } } }
        __syncthreads();
#pragma unroll
        for (int i = 0; i < 2; ++i) { const int q = tid + 512 * i, nn = q >> 3, kc = q & 7; const float* sp = scr + (kc * 8) * 132 + nn;
            u32x4 o; o.x = pk2(sp[0], sp[132]); o.y = pk2(sp[2 * 132], sp[3 * 132]); o.z = pk2(sp[4 * 132], sp[5 * 132]); o.w = pk2(sp[6 * 132], sp[7 * 132]);
            *(u32x4*)(done.dst + (size_t)(done.n0 + nn) * done.K + done.k0 + kc * 8) = o; }
        __syncthreads();
    }
#undef WT_DESC
}


DI void phase_init(KP P, char* lds, int bid, int wv_) {
    const gptr_t ws_ = lptr(P->ws);
    const int lane = ltid() & 63, wave = ltid() >> 6;
    _Float16* XS = (_Float16*)(ws_ + WS_XS); bf16* H = (bf16*)(ws_ + WS_H); const float* MOD = (const float*)(ws_ + WS_MOD);
    float* L = (float*)lds;
    { const int tid = ltid(); f32x4 sv[10];
#pragma unroll
      for (int m = 0; m < 5; ++m) { const float* sh = MOD + (size_t)m * NMODV; sv[2 * m] = *(const f32x4*)(sh + 4 * tid); sv[2 * m + 1] = *(const f32x4*)(sh + DM + 4 * tid); }
#pragma unroll
      for (int m = 0; m < 10; ++m) *(f32x4*)(L + m * DM + 4 * tid) = sv[m]; }
    __syncthreads();
    auto put = [&](const f32x4 (&v)[8], size_t r, int mi) {
#pragma unroll
        for (int j = 0; j < 8; ++j) __builtin_nontemporal_store(__builtin_convertvector(v[j] * DN_ALPHA, h16x4), (h16x4*)(XS + r * DM + 4 * lane + 256 * j));
        const float* sh = L + 2 * mi * DM + 4 * lane; const float* sc = sh + DM;
#pragma unroll
        for (int j = 0; j < 8; ++j) { const f32x4 a = *(const f32x4*)(sh + 256 * j), c = *(const f32x4*)(sc + 256 * j);
            const f32x4 h = v[j] * (c + 1.0f) + a; u32x2 w; w.x = pk2(h.x, h.y); w.y = pk2(h.z, h.w);
            *(u32x2*)(H + r * DM + 4 * lane + 256 * j) = w; }
    };
    auto fetch = [&](int k, f32x4 (&v)[8]) { const int q = k * 2048 + bid * NWAVE + wave; const float* s = GIN(P->x) + (size_t)q * DM + 4 * lane;
#pragma unroll
        for (int j = 0; j < 8; ++j) v[j] = __builtin_nontemporal_load((const f32x4*)(s + 256 * j)); };
    auto rowof = [&](int k) -> size_t { const int q = k * 2048 + bid * NWAVE + wave; return (size_t)(q >> 12) * TT + CTXL + (q & 4095); };
    f32x4 va[8], vb[8];
    fetch(0, va);
#pragma unroll
    for (int k = 0; k < 8; k += 2) {
        fetch(k + 1, vb);
        put(va, rowof(k), k >> 1);
        if (k + 2 < 8) fetch(k + 2, va);
        put(vb, rowof(k + 1), k >> 1);
    }
    if (wave < 4) { const int c = bid * 4 + wave; const float* s = GIN(P->ctx) + (size_t)c * DM + 4 * lane;
#pragma unroll
        for (int j = 0; j < 8; ++j) va[j] = __builtin_nontemporal_load((const f32x4*)(s + 256 * j));
        put(va, (size_t)(c >> 8) * TT + (c & 255), 4); }
}

template <bool FINAL> DI void phase_ln(KP P, char* lds, int l_ln, int which, int l_mod, int shift_idx, bool skip_ctx, int nparts, int bid, int wv_) {
    const gptr_t ws_ = lptr(P->ws);
    const int lane = ltid() & 63, wave = ltid() >> 6;
    _Float16* XS = (_Float16*)(ws_ + WS_XS); bf16* H = (bf16*)(ws_ + WS_H); const float* MOD = (const float*)(ws_ + WS_MOD);
    const bf16* DEL = (const bf16*)(ws_ + WS_DELTA);
    float* L = (float*)lds;
    { const int tid = ltid();
      const float* g = GIN(P->ln_g) + (size_t)(l_ln * 3 + which) * DM; const float* bb = GIN(P->ln_b) + (size_t)(l_ln * 3 + which) * DM;
      constexpr int NV = FINAL ? 2 : 12; f32x4 sv[NV];
      sv[0] = *(const f32x4*)(g + 4 * tid); sv[1] = *(const f32x4*)(bb + 4 * tid);
      if constexpr (!FINAL) {
#pragma unroll
          for (int m = 0; m < 5; ++m) { const float* sh = MOD + ((size_t)l_mod * 5 + m) * NMODV + (size_t)shift_idx * DM;
              sv[2 + 2 * m] = *(const f32x4*)(sh + 4 * tid); sv[3 + 2 * m] = *(const f32x4*)(sh + DM + 4 * tid); } }
#pragma unroll
      for (int m = 0; m < NV; ++m) *(f32x4*)(L + m * DM + 4 * tid) = sv[m]; }
    auto finish = [&](f32x4 (&v)[8], size_t r, int mi, int b, int t) {
        float s = 0.f;
#pragma unroll
        for (int j = 0; j < 8; ++j) s += (v[j].x + v[j].y) + (v[j].z + v[j].w);
        const float mean = wave_sum(s) * (1.0f / DM); float s2 = 0.f;
#pragma unroll
        for (int j = 0; j < 8; ++j) { v[j] = v[j] - mean; s2 += (v[j].x * v[j].x + v[j].y * v[j].y) + (v[j].z * v[j].z + v[j].w * v[j].w); }
        const float rstd = rsqrt_f(wave_sum(s2) * (1.0f / DM) + LN_EPS);
#pragma unroll
        for (int j = 0; j < 8; ++j) { const f32x4 gg = *(const f32x4*)(L + 4 * lane + 256 * j), bv = *(const f32x4*)(L + DM + 4 * lane + 256 * j); v[j] = v[j] * rstd * gg + bv; }
        if constexpr (FINAL) { float* o = P->out + ((size_t)b * SEQL + (t - CTXL)) * DM + 4 * lane;
#pragma unroll
            for (int j = 0; j < 8; ++j) __builtin_nontemporal_store(v[j], (f32x4*)(o + 256 * j));
            return; }
#pragma unroll
        for (int j = 0; j < 8; ++j) __builtin_nontemporal_store(__builtin_convertvector(v[j] * DN_ALPHA, h16x4), (h16x4*)(XS + r * DM + 4 * lane + 256 * j));
        if constexpr (!FINAL) {
            const float* sh = L + (2 + 2 * mi) * DM + 4 * lane; const float* sc = sh + DM;
#pragma unroll
            for (int j = 0; j < 8; ++j) { const f32x4 a = *(const f32x4*)(sh + 256 * j), c = *(const f32x4*)(sc + 256 * j);
                const f32x4 h = v[j] * (c + 1.0f) + a; u32x2 w; w.x = pk2(h.x, h.y); w.y = pk2(h.z, h.w);
                *(u32x2*)(H + r * DM + 4 * lane + 256 * j) = w; }
        }
    };
    h16x4 xa[8], xb[8]; u32x2 da[8], db[8];
    auto rowof = [&](int k) -> size_t { const int q = k * 2048 + bid * NWAVE + wave; return (size_t)(q >> 12) * TT + CTXL + (q & 4095); };
    auto prefetch = [&](int k, h16x4 (&xr)[8], u32x2 (&dr)[8]) { const size_t r = rowof(k);
#pragma unroll
        for (int j = 0; j < 8; ++j) { xr[j] = __builtin_nontemporal_load((const h16x4*)(XS + r * DM + 4 * lane + 256 * j)); dr[j] = *(const u32x2*)(DEL + r * DM + 4 * lane + 256 * j); } };
    auto consume = [&](f32x4 (&v)[8], const h16x4 (&xr)[8], const u32x2 (&dr)[8]) {
#pragma unroll
        for (int j = 0; j < 8; ++j) v[j] = __builtin_convertvector(xr[j], f32x4) + (f32x4){bflo(dr[j].x), bfhi(dr[j].x), bflo(dr[j].y), bfhi(dr[j].y)}; };
    auto fin_lat = [&](f32x4 (&v)[8], int k) { const int q = k * 2048 + bid * NWAVE + wave; const int b = q >> 12, t = CTXL + (q & 4095); finish(v, (size_t)b * TT + t, b, b, t); };
    prefetch(0, xa, da); prefetch(1, xb, db);
    __syncthreads();
    if (!(FINAL || skip_ctx) && wave < 4) {
        const int c = bid * 4 + wave, b = c >> 8, t = c & 255; const size_t r = (size_t)b * TT + t;
        f32x4 v[8]; h16x4 xc[8];
#pragma unroll
        for (int j = 0; j < 8; ++j) xc[j] = __builtin_nontemporal_load((const h16x4*)(XS + r * DM + 4 * lane + 256 * j));
        if (nparts == 0) { u32x2 w[8];
#pragma unroll
            for (int j = 0; j < 8; ++j) w[j] = *(const u32x2*)(DEL + r * DM + 4 * lane + 256 * j);
#pragma unroll
            for (int j = 0; j < 8; ++j) v[j] = __builtin_convertvector(xc[j], f32x4) + (f32x4){bflo(w[j].x), bfhi(w[j].x), bflo(w[j].y), bfhi(w[j].y)};
        } else {
            const bf16* ps = (const bf16*)(ws_ + WS_PART) + (size_t)c * DM + 4 * lane;
#pragma unroll
            for (int p0 = 0; p0 < 8; p0 += 4) { u32x2 w[4][8];
#pragma unroll
                for (int p = 0; p < 4; ++p)
#pragma unroll
                    for (int j = 0; j < 8; ++j) w[p][j] = *(const u32x2*)(ps + (size_t)(p0 + p) * 1024 * DM + 256 * j);
                if (p0 == 0) {
#pragma unroll
                    for (int j = 0; j < 8; ++j) v[j] = __builtin_convertvector(xc[j], f32x4); }
#pragma unroll
                for (int p = 0; p < 4; ++p)
#pragma unroll
                    for (int j = 0; j < 8; ++j) v[j] += (f32x4){bflo(w[p][j].x), bfhi(w[p][j].x), bflo(w[p][j].y), bfhi(w[p][j].y)}; } }
        finish(v, r, 4, b, t);
    }
    f32x4 v[8];
    consume(v, xa, da);
#pragma unroll 1
    for (int k = 0; k < 6; k += 2) {
        prefetch(k + 2, xa, da);
        fin_lat(v, k);
        consume(v, xb, db);
        prefetch(k + 3, xb, db);
        fin_lat(v, k + 1);
        consume(v, xa, da);
    }
    fin_lat(v, 6);
    consume(v, xb, db);
    fin_lat(v, 7);
}

DI void phase_prep(KP P, int l, int bid, int nb, int wv_) {
    const gptr_t ws_ = lptr(P->ws);
    const int lane = ltid() & 63, wave = ltid() >> 6;
    const bf16* __restrict__ Z = (const bf16*)(ws_ + WS_ACT);
    float* __restrict__ LA = (float*)(ws_ + WS_LA); bf16* __restrict__ DQ = (bf16*)(ws_ + WS_DQ); bf16* __restrict__ DK = (bf16*)(ws_ + WS_DK); bf16* __restrict__ DV = (bf16*)(ws_ + WS_DV);
    float* __restrict__ DBETA = (float*)(ws_ + WS_DBG); float* __restrict__ DG = DBETA + (size_t)2 * MROWS * 4;
    bf16* __restrict__ AQ = (bf16*)(ws_ + WS_AQ); bf16* __restrict__ AKV = (bf16*)(ws_ + WS_AKV); const float* __restrict__ ROPE = (const float*)(ws_ + WS_ROPE);
    const int rbeg = bid * NWAVE + wave, rstep = nb * NWAVE;
#pragma unroll 1
    for (int d = 0; d < 2; ++d) {
        f32x4 w2r[16];
        const float* w2 = GIN(P->gla_wa2) + (size_t)(l * 2 + d) * 16 * 256 + 4 * lane;
#pragma unroll
        for (int e = 0; e < 16; ++e) w2r[e] = *(const f32x4*)(w2 + e * 256);
        const f32x4 bar = *(const f32x4*)(GIN(P->gla_ba) + (size_t)(l * 2 + d) * 256 + 4 * lane);
#pragma unroll 2
        for (int r = rbeg; ; r += rstep) { if (r >= MROWS) break;
            const bf16* z = Z + (size_t)r * ZW + ZWA1 + 16 * d;
            const u32x4 za = *(const u32x4*)z, zb = *(const u32x4*)(z + 8);
            const float z1[16] = {bflo(za.x), bfhi(za.x), bflo(za.y), bfhi(za.y), bflo(za.z), bfhi(za.z), bflo(za.w), bfhi(za.w),
                                  bflo(zb.x), bfhi(zb.x), bflo(zb.y), bfhi(zb.y), bflo(zb.z), bfhi(zb.z), bflo(zb.w), bfhi(zb.w)};
            f32x4 acc = bar;
#pragma unroll
            for (int e = 0; e < 16; ++e) acc += w2r[e] * z1[e];
            f32x4 o; o.x = logsigmoid_f(acc.x) * 0.0625f; o.y = logsigmoid_f(acc.y) * 0.0625f; o.z = logsigmoid_f(acc.z) * 0.0625f; o.w = logsigmoid_f(acc.w) * 0.0625f;
            *(f32x4*)(LA + ((size_t)d * MROWS + r) * 256 + 4 * lane) = o;
        }
    }
    {
        float cw[3][3][8];
#pragma unroll
        for (int part = 0; part < 3; ++part)
#pragma unroll
            for (int tap = 0; tap < 3; ++tap) { const float* cp = GIN(P->dn_conv) + (size_t)l * 3 * 1536 + tap * 1536 + part * 512 + lane * 8;
                const f32x4 c0 = *(const f32x4*)cp, c1 = *(const f32x4*)(cp + 4);
                cw[part][tap][0] = c0.x; cw[part][tap][1] = c0.y; cw[part][tap][2] = c0.z; cw[part][tap][3] = c0.w; cw[part][tap][4] = c1.x; cw[part][tap][5] = c1.y; cw[part][tap][6] = c1.z; cw[part][tap][7] = c1.w; }
        const float nal = lane < 8 ? -__expf(GIN(P->dn_a_log)[(l * 2 + (lane >> 2)) * 4 + (lane & 3)]) : 0.f, dtb = lane < 8 ? GIN(P->dn_dt_bias)[(l * 2 + (lane >> 2)) * 4 + (lane & 3)] : 0.f;
#pragma unroll 2
        for (int r = rbeg; ; r += rstep) { if (r >= MROWS) break;
            const int t = r % TT; const bool isctx = t < CTXL;
            const bf16* z = Z + (size_t)r * ZW;
            const bool has_prev = isctx ? (t > 0) : (t > CTXL), has_next = isctx ? (t < CTXL - 1) : (t < TT - 1);
            u32x4 zc[3], zp[3], zn[3];
#pragma unroll
            for (int part = 0; part < 3; ++part) { const int ch = part * 512 + lane * 8;
                zc[part] = *(const u32x4*)(z + ZDQ + ch); zp[part] = (u32x4){0u, 0u, 0u, 0u}; zn[part] = (u32x4){0u, 0u, 0u, 0u};
                if (has_prev) zp[part] = *(const u32x4*)(z - ZW + ZDQ + ch);
                if (has_next) zn[part] = *(const u32x4*)(z + ZW + ZDQ + ch); }
            unsigned short zab = 0; if (lane < 8) zab = z[ZWAB + 8 * (lane >> 2) + (lane & 3)];
            unsigned short zbb = 0; if (lane < 8) zbb = z[ZWAB + 8 * (lane >> 2) + 4 + (lane & 3)];
#pragma unroll
            for (int part = 0; part < 3; ++part) {
                float v[8]; float ss = 0.f;
#pragma unroll
                for (int e = 0; e < 4; ++e) {
                    const unsigned wp = e == 0 ? zp[part].x : e == 1 ? zp[part].y : e == 2 ? zp[part].z : zp[part].w, wc = e == 0 ? zc[part].x : e == 1 ? zc[part].y : e == 2 ? zc[part].z : zc[part].w,
                                   wn = e == 0 ? zn[part].x : e == 1 ? zn[part].y : e == 2 ? zn[part].z : zn[part].w;
                    const float a0 = bflo(wp) * cw[part][0][2 * e] + bflo(wc) * cw[part][1][2 * e] + bflo(wn) * cw[part][2][2 * e];
                    const float a1 = bfhi(wp) * cw[part][0][2 * e + 1] + bfhi(wc) * cw[part][1][2 * e + 1] + bfhi(wn) * cw[part][2][2 * e + 1];
                    v[2 * e] = silu_f(a0); v[2 * e + 1] = silu_f(a1); ss += v[2 * e] * v[2 * e] + v[2 * e + 1] * v[2 * e + 1];
                }
                float scale = 1.f;
                if (part < 2) { ss += shx<1>(ss); ss += shx<2>(ss); ss += shx<4>(ss); ss += shx<8>(ss);
                    scale = rsqrt_f(ss + LN_EPS); if (part == 0) scale *= 0.08838834764831845f; }
                u32x4 o; o.x = pk2(v[0] * scale, v[1] * scale); o.y = pk2(v[2] * scale, v[3] * scale); o.z = pk2(v[4] * scale, v[5] * scale); o.w = pk2(v[6] * scale, v[7] * scale);
                bf16* dst = part == 0 ? DQ : part == 1 ? DK : DV;
                *(u32x4*)(dst + (size_t)r * 512 + lane * 8) = o;
            }
            if (lane < 8) { const int d = lane >> 2, hh = lane & 3;
                const float g = nal * softplus_f(bf2f(zab) + dtb);
                const float beta = 1.0f / (1.0f + __expf(-bf2f(zbb)));
                DG[((size_t)d * MROWS + r) * 4 + hh] = g; DBETA[((size_t)d * MROWS + r) * 4 + hh] = beta; }
        }
    }
    {
        const int l8 = lane & 7, quarter = l8 >> 1, i0 = (l8 & 1) * 16;
        const int l32 = lane & 31, kq = l32 >> 3, ki0 = (l32 & 7) * 4;
        float gq[16], gk[4];
#pragma unroll
        for (int e = 0; e < 16; ++e) gq[e] = GIN(P->q_norm_g)[(size_t)l * 128 + l8 * 16 + e];
#pragma unroll
        for (int e = 0; e < 4; ++e) gk[e] = GIN(P->k_norm_g)[(size_t)l * 128 + l32 * 4 + e];
#pragma unroll 2
        for (int r = rbeg; ; r += rstep) { if (r >= MROWS) break;
            const int t = r % TT; const bool isctx = t < CTXL;
            const bf16* z = Z + (size_t)r * ZW;
            const int lt = t - CTXL, prow = lt >> 6, pcol = lt & 63;
            const u32x4 qa = *(const u32x4*)(z + ZAQ + lane * 16), qb = *(const u32x4*)(z + ZAQ + lane * 16 + 8);
            const u32x2 ka = *(const u32x2*)(z + ZAK + lane * 4), va = *(const u32x2*)(z + ZAV + lane * 4);
            float v[16] = {bflo(qa.x), bfhi(qa.x), bflo(qa.y), bfhi(qa.y), bflo(qa.z), bfhi(qa.z), bflo(qa.w), bfhi(qa.w),
                           bflo(qb.x), bfhi(qb.x), bflo(qb.y), bfhi(qb.y), bflo(qb.z), bfhi(qb.z), bflo(qb.w), bfhi(qb.w)};
            float ss = 0.f;
#pragma unroll
            for (int e = 0; e < 16; ++e) ss += v[e] * v[e];
            ss += shx<1>(ss); ss += shx<2>(ss); ss += shx<4>(ss);
            const float rs = rsqrt_f(ss * (1.0f / 128.0f) + LN_EPS);
#pragma unroll
            for (int e = 0; e < 16; ++e) v[e] = v[e] * rs * gq[e];
            const int pos = quarter < 2 ? prow : pcol; const float* rp = ROPE + ((size_t)(isctx ? 0 : pos) * 32 + i0) * 2;
            unsigned ow[8];
#pragma unroll
            for (int e = 0; e < 16; e += 2) {
                const float p0 = shx<2>(v[e]), p1 = shx<2>(v[e + 1]);
                float o0 = v[e], o1 = v[e + 1];
                if (!isctx) { const float c0 = rp[2 * e], s0 = rp[2 * e + 1], c1 = rp[2 * e + 2], s1 = rp[2 * e + 3];
                    if ((quarter & 1) == 0) { o0 = v[e] * c0 - p0 * s0; o1 = v[e + 1] * c1 - p1 * s1; } else { o0 = v[e] * c0 + p0 * s0; o1 = v[e + 1] * c1 + p1 * s1; } }
                ow[e >> 1] = pk2(o0, o1);
            }
            u32x4 o0 = {ow[0], ow[1], ow[2], ow[3]}, o1 = {ow[4], ow[5], ow[6], ow[7]};
            *(u32x4*)(AQ + (size_t)r * 1024 + lane * 16) = o0; *(u32x4*)(AQ + (size_t)r * 1024 + lane * 16 + 8) = o1;
            float kv[4] = {bflo(ka.x), bfhi(ka.x), bflo(ka.y), bfhi(ka.y)};
            float ks = kv[0] * kv[0] + kv[1] * kv[1] + kv[2] * kv[2] + kv[3] * kv[3];
            ks += shx<1>(ks); ks += shx<2>(ks); ks += shx<4>(ks); ks += shx<8>(ks); ks += shx<16>(ks);
            const float krs = rsqrt_f(ks * (1.0f / 128.0f) + LN_EPS);
#pragma unroll
            for (int e = 0; e < 4; ++e) kv[e] = kv[e] * krs * gk[e];
            const int kpos = kq < 2 ? prow : pcol; const float* krp = ROPE + ((size_t)(isctx ? 0 : kpos) * 32 + ki0) * 2;
            float ko[4];
#pragma unroll
            for (int e = 0; e < 4; ++e) { const float pp = shx<8>(kv[e]); ko[e] = kv[e];
                if (!isctx) { const float cc = krp[2 * e], sn = krp[2 * e + 1]; ko[e] = (kq & 1) == 0 ? kv[e] * cc - pp * sn : kv[e] * cc + pp * sn; } }
            u32x2 kw; kw.x = pk2(ko[0], ko[1]); kw.y = pk2(ko[2], ko[3]);
            *(u32x2*)(AKV + (size_t)r * 512 + lane * 4) = kw;
            *(u32x2*)(AKV + (size_t)r * 512 + 256 + lane * 4) = va;
        }
    }
}

DI int scan_tok(int dir, int p) { return dir == 0 ? p : (p < CTXL ? CTXL - 1 - p : TT + CTXL - 1 - p); }

typedef short bf16x8v __attribute__((ext_vector_type(8)));
typedef short v4i16_t __attribute__((ext_vector_type(4)));
#define LDSP __attribute__((address_space(3)))
#define MFMA16(a, b, c) __builtin_amdgcn_mfma_f32_16x16x32_bf16((a), (b), (c), 0, 0, 0)
DI bf16x8v ld_row(const LDSP char* tile, int stride, int row0, int col0, int lane) {
    return *(const LDSP bf16x8v*)(tile + (row0 + (lane & 15)) * stride + (col0 + 8 * (lane >> 4)) * 2);
}
DI bf16x8v ld_tr(const LDSP char* tile, int stride, int k0, int n0, int lane) {
    const int g = lane >> 4, i = lane & 15;
    const LDSP char* a = tile + (k0 + 8 * g + (i >> 2)) * stride + (n0 + 4 * (i & 3)) * 2;
    const v4i16_t lo = __builtin_amdgcn_ds_read_tr16_b64_v4i16((LDSP v4i16_t*)a);
    const v4i16_t hi = __builtin_amdgcn_ds_read_tr16_b64_v4i16((LDSP v4i16_t*)(a + 4 * stride));
    return (bf16x8v){lo[0], lo[1], lo[2], lo[3], hi[0], hi[1], hi[2], hi[3]};
}
constexpr int NCHUNK = TT / 64;
constexpr int GL_VS = 272, GL_DS = 144;
DI int chunk_of(int dir, int j) { return dir == 0 ? j : (j < 4 ? 3 - j : 71 - j); }
constexpr size_t WS_GKV = WS_GLAO;
constexpr size_t WS_GST = 991 * MiB;
constexpr size_t WS_GDEC = 1025 * MiB;
constexpr size_t WS_GOS = 1026 * MiB;
constexpr size_t WS_END2 = 1124 * MiB;

DI void gla_bcum(const float* LA, size_t row0, int h, int dir, int qt, int d, LDSP float* tot  , float (&c)[16], float& offs, float& blast) {
    float s = 0.f;
#pragma unroll
    for (int tt = 0; tt < 16; ++tt) { const int i = 16 * qt + tt, t = dir ? 63 - i : i;
        s += LA[((size_t)dir * MROWS + row0 + t) * 256 + h * 64 + d]; c[tt] = s; }
    tot[(dir * 4 + qt) * 64 + d] = s;
    __syncthreads();
    offs = 0.f; blast = 0.f;
#pragma unroll
    for (int q2 = 0; q2 < 4; ++q2) { const float v = tot[(dir * 4 + q2) * 64 + d]; if (q2 < qt) offs += v; blast += v; }
}

DI void phase_gla_local(KP P, char* lds_, int bid, int nb, int wv_) {
    const gptr_t ws_ = lptr(P->ws);
    const int tid = ltid(), lane = tid & 63, wave = tid >> 6;
    LDSP char* L = (LDSP char*)lds_;
    LDSP char* Vt = L;
    LDSP char* KE = L + 64 * GL_VS;
    LDSP float* tot = (LDSP float*)(L + 64 * GL_VS + 2 * 64 * GL_DS);
    const bf16* Z = (const bf16*)(ws_ + WS_ACT); const float* LA = (const float*)(ws_ + WS_LA);
    float* KVT = (float*)(ws_ + WS_GKV); float* DEC = (float*)(ws_ + WS_GDEC);
    for (int u = bid; u < NBATCH * 4 * NCHUNK; u += nb) {
        const int j = u % NCHUNK, h = (u / NCHUNK) & 3, b = u / (4 * NCHUNK);
        const size_t row0 = (size_t)b * TT + (size_t)j * 64;
        const int dir = tid >> 8, qt = (tid >> 6) & 3, d = tid & 63;
        u32x4 vreg[2]; unsigned short kraw[16]; float lar[16];
#pragma unroll
        for (int i = 0; i < 2; ++i) { const int q = tid + 512 * i, t = q >> 4, ch = q & 15; vreg[i] = *(const u32x4*)(Z + (row0 + t) * ZW + ZGV + h * 128 + ch * 8); }
#pragma unroll
        for (int tt = 0; tt < 16; ++tt) { const int i = 16 * qt + tt, t = dir ? 63 - i : i; kraw[tt] = Z[(row0 + t) * ZW + ZGK + h * 64 + d]; lar[tt] = LA[((size_t)dir * MROWS + row0 + t) * 256 + h * 64 + d]; }
        __builtin_amdgcn_sched_barrier(0);
#pragma unroll
        for (int i = 0; i < 2; ++i) { const int q = tid + 512 * i, t = q >> 4, ch = q & 15; *(LDSP u32x4*)(Vt + t * GL_VS + ch * 16) = vreg[i]; }
        float c[16], offs = 0.f, blast = 0.f;
        { float sacc = 0.f;
#pragma unroll
          for (int tt = 0; tt < 16; ++tt) { sacc += lar[tt]; c[tt] = sacc; }
          tot[(dir * 4 + qt) * 64 + d] = sacc;
          __syncthreads();
#pragma unroll
          for (int q2 = 0; q2 < 4; ++q2) { const float v = tot[(dir * 4 + q2) * 64 + d]; if (q2 < qt) offs += v; blast += v; } }
#pragma unroll
        for (int tt = 0; tt < 16; ++tt) { const int i = 16 * qt + tt, t = dir ? 63 - i : i;
            *(LDSP unsigned short*)(KE + (dir * 64 + t) * GL_DS + d * 2) = (unsigned short)f2bf(bf2f(kraw[tt]) * __expf(blast - (offs + c[tt]))); }
        const int n = chunk_of(dir, j); const size_t cidx = ((size_t)((b * 4 + h) * 2 + dir)) * NCHUNK + n;
        if (qt == 0) DEC[cidx * 64 + d] = __expf(blast);
        __syncthreads();
        const int wd = wave >> 2;
        f32x4 acc[2][4];
#pragma unroll
        for (int a = 0; a < 2; ++a)
#pragma unroll
            for (int n4 = 0; n4 < 4; ++n4) acc[a][n4] = (f32x4){0.f, 0.f, 0.f, 0.f};
#pragma unroll
        for (int s = 0; s < 2; ++s) {
            bf16x8v af[2], bfr[4];
#pragma unroll
            for (int a = 0; a < 2; ++a) af[a] = ld_tr(Vt, GL_VS, 32 * s, 16 * ((wave & 3) * 2 + a), lane);
#pragma unroll
            for (int n4 = 0; n4 < 4; ++n4) bfr[n4] = ld_tr(KE + wd * 64 * GL_DS, GL_DS, 32 * s, 16 * n4, lane);
#pragma unroll
            for (int a = 0; a < 2; ++a)
#pragma unroll
                for (int n4 = 0; n4 < 4; ++n4) acc[a][n4] = MFMA16(af[a], bfr[n4], acc[a][n4]);
        }
        const size_t cw = ((size_t)((b * 4 + h) * 2 + wd)) * NCHUNK + chunk_of(wd, j);
        float* out = KVT + cw * 8192;
#pragma unroll
        for (int a = 0; a < 2; ++a)
#pragma unroll
            for (int n4 = 0; n4 < 4; ++n4)
#pragma unroll
                for (int r = 0; r < 4; ++r) out[(size_t)(16 * ((wave & 3) * 2 + a) + 4 * (lane >> 4) + r) * 64 + 16 * n4 + (lane & 15)] = acc[a][n4][r];
        __syncthreads();
    }
}

DI void phase_gla_scan(KP P, int bid, int nb, int wv_) {
    const gptr_t ws_ = lptr(P->ws);
    const int tid = ltid();
    const float* KVT = (const float*)(ws_ + WS_GKV); const float* DEC = (const float*)(ws_ + WS_GDEC); bf16* ST = (bf16*)(ws_ + WS_GST);
    const int nitem = ((32 * 16 - bid + nb - 1) / nb) * 4;
    float ka[17], da[17], kb[17], db[17];
    auto issue = [&](int it, float (&kv)[17], float (&dc)[17]) { const int u = bid + (it >> 2) * nb, n0 = (it & 3) * 17; const int sc = u >> 4, e = (u & 15) * 512 + tid, d = e & 63;
        const float* kvp = KVT + (size_t)sc * NCHUNK * 8192 + e; const float* dcp = DEC + (size_t)sc * NCHUNK * 64 + d;
#pragma unroll
        for (int q = 0; q < 17; ++q) { kv[q] = kvp[(size_t)(n0 + q) * 8192]; dc[q] = dcp[(n0 + q) * 64]; } };
    float S = 0.f;
    auto run = [&](int it, const float (&kv)[17], const float (&dc)[17]) { const int u = bid + (it >> 2) * nb, n0 = (it & 3) * 17; const int sc = u >> 4, e = (u & 15) * 512 + tid;
        bf16* st = ST + (size_t)sc * NCHUNK * 8192 + e;
        if ((it & 3) == 0) S = 0.f;
#pragma unroll
        for (int q = 0; q < 17; ++q) { st[(size_t)(n0 + q) * 8192] = (bf16)f2bf(S); S = S * dc[q] + kv[q]; } };
    if (nitem <= 0) return;
    issue(0, ka, da);
#pragma unroll 1
    for (int it = 0; it < nitem; it += 2) {
        issue(it + 1, kb, db);
        run(it, ka, da);
        if (it + 2 < nitem) issue(it + 2, ka, da);
        run(it + 1, kb, db);
    }
}

DI void gla_out_unit(KP P, char* lds_, int u, int l, int wv_) {
    const gptr_t ws_ = lptr(P->ws);
    const int tid = ltid(), lane = tid & 63, wave = tid >> 6;
    LDSP char* L = (LDSP char*)lds_;
    LDSP char* Vt = L;
    LDSP char* QI = Vt + 64 * GL_VS;
    LDSP char* KI = QI + 2 * 64 * GL_DS;
    LDSP char* STt = KI + 2 * 64 * GL_DS;
    LDSP char* PT = STt + 2 * 128 * GL_DS;
    LDSP float* tot = (LDSP float*)(PT + 2 * 64 * GL_DS);
    LDSP float* nred = tot + 512;
    const bf16* Z = (const bf16*)(ws_ + WS_ACT); const float* LA = (const float*)(ws_ + WS_LA);
    const bf16* ST = (const bf16*)(ws_ + WS_GST); bf16* MIX = (bf16*)(ws_ + WS_H);
    {
        const int j = u % NCHUNK, h = (u / NCHUNK) & 3, b = u / (4 * NCHUNK);
        const size_t row0 = (size_t)b * TT + (size_t)j * 64;
        const int dir = tid >> 8, qt = (tid >> 6) & 3, d = tid & 63;
        u32x4 vreg[2], streg[4]; float lar[16]; unsigned short qraw[16], kraw[16];
#pragma unroll
        for (int i = 0; i < 2; ++i) { const int q = tid + 512 * i, t = q >> 4, ch = q & 15; vreg[i] = *(const u32x4*)(Z + (row0 + t) * ZW + ZGV + h * 128 + ch * 8); }
#pragma unroll
        for (int i = 0; i < 4; ++i) { const int q = tid + 512 * i, dd = q >> 10, rem = q & 1023, v = rem >> 3, ch = rem & 7;
            const size_t cidx = ((size_t)((b * 4 + h) * 2 + dd)) * NCHUNK + chunk_of(dd, j);
            streg[i] = *(const u32x4*)(ST + cidx * 8192 + v * 64 + ch * 8); }
#pragma unroll
        for (int tt = 0; tt < 16; ++tt) { const int i = 16 * qt + tt, t = dir ? 63 - i : i;
            lar[tt] = LA[((size_t)dir * MROWS + row0 + t) * 256 + h * 64 + d];
            qraw[tt] = Z[(row0 + t) * ZW + ZGQ + h * 64 + d]; kraw[tt] = Z[(row0 + t) * ZW + ZGK + h * 64 + d]; }
        unsigned short gtr[4][4]; float gnr[4];
#pragma unroll
        for (int n4 = 0; n4 < 4; ++n4) { const int v = 16 * ((wave >> 2) * 4 + n4) + (lane & 15); gnr[n4] = GIN(P->gla_norm_g)[(size_t)l * 128 + v];
#pragma unroll
            for (int r = 0; r < 4; ++r) gtr[n4][r] = Z[(row0 + 16 * (wave & 3) + 4 * (lane >> 4) + r) * ZW + ZGR + h * 128 + v]; }
        __builtin_amdgcn_sched_barrier(0);
#pragma unroll
        for (int i = 0; i < 2; ++i) { const int q = tid + 512 * i, t = q >> 4, ch = q & 15; *(LDSP u32x4*)(Vt + t * GL_VS + ch * 16) = vreg[i]; }
#pragma unroll
        for (int i = 0; i < 4; ++i) { const int q = tid + 512 * i, dd = q >> 10, rem = q & 1023, v = rem >> 3, ch = rem & 7; *(LDSP u32x4*)(STt + (dd * 128 + v) * GL_DS + ch * 16) = streg[i]; }
        float c[16], offs = 0.f, blast = 0.f;
        { float sacc = 0.f;
#pragma unroll
          for (int tt = 0; tt < 16; ++tt) { sacc += lar[tt]; c[tt] = sacc; }
          tot[(dir * 4 + qt) * 64 + d] = sacc;
          __syncthreads();
#pragma unroll
          for (int q2 = 0; q2 < 4; ++q2) { const float v = tot[(dir * 4 + q2) * 64 + d]; if (q2 < qt) offs += v; blast += v; } }
#pragma unroll
        for (int tt = 0; tt < 16; ++tt) { const int i = 16 * qt + tt, t = dir ? 63 - i : i; const float bc = offs + c[tt];
            *(LDSP unsigned short*)(QI + (dir * 64 + t) * GL_DS + d * 2) = (unsigned short)f2bf(bf2f(qraw[tt]) * 0.125f * __expf(bc));
            *(LDSP unsigned short*)(KI + (dir * 64 + t) * GL_DS + d * 2) = (unsigned short)f2bf(bf2f(kraw[tt]) * __expf(-bc)); }
        __syncthreads();
        {
            const int wd = wave >> 2, mt = wave & 3, g = lane >> 4, i16 = lane & 15;
            f32x4 pacc[4];
#pragma unroll
            for (int n4 = 0; n4 < 4; ++n4) pacc[n4] = (f32x4){0.f, 0.f, 0.f, 0.f};
#pragma unroll
            for (int s = 0; s < 2; ++s) {
                const bf16x8v af = ld_row(QI + wd * 64 * GL_DS, GL_DS, 16 * mt, 32 * s, lane);
#pragma unroll
                for (int n4 = 0; n4 < 4; ++n4) pacc[n4] = MFMA16(af, ld_row(KI + wd * 64 * GL_DS, GL_DS, 16 * n4, 32 * s, lane), pacc[n4]);
            }
#pragma unroll
            for (int n4 = 0; n4 < 4; ++n4) { const int tp = 16 * n4 + i16; float pv[4];
#pragma unroll
                for (int r = 0; r < 4; ++r) { const int t = 16 * mt + 4 * g + r; const bool keep = wd == 0 ? (tp <= t) : (tp >= t); pv[r] = keep ? pacc[n4][r] : 0.f; }
                u32x2 w; w.x = pk2(pv[0], pv[1]); w.y = pk2(pv[2], pv[3]);
                *(LDSP u32x2*)(PT + (wd * 64 + tp) * GL_DS + (16 * mt + 4 * g) * 2) = w; }
        }
        __syncthreads();
        {
            const int mt = wave & 3, nh = wave >> 2;
            f32x4 oacc[4];
#pragma unroll
            for (int n4 = 0; n4 < 4; ++n4) oacc[n4] = (f32x4){0.f, 0.f, 0.f, 0.f};
#pragma unroll
            for (int dd = 0; dd < 2; ++dd)
#pragma unroll
                for (int s = 0; s < 2; ++s) {
                    const bf16x8v ap = ld_tr(PT + dd * 64 * GL_DS, GL_DS, 32 * s, 16 * mt, lane);
                    const bf16x8v aq = ld_row(QI + dd * 64 * GL_DS, GL_DS, 16 * mt, 32 * s, lane);
#pragma unroll
                    for (int n4 = 0; n4 < 4; ++n4) { const int nt = nh * 4 + n4;
                        oacc[n4] = MFMA16(ap, ld_tr(Vt, GL_VS, 32 * s, 16 * nt, lane), oacc[n4]);
                        oacc[n4] = MFMA16(aq, ld_row(STt + dd * 128 * GL_DS, GL_DS, 16 * nt, 32 * s, lane), oacc[n4]); }
                }
            const int g = lane >> 4, i16 = lane & 15;
            float ps[4];
#pragma unroll
            for (int r = 0; r < 4; ++r) { float q = 0.f;
#pragma unroll
                for (int n4 = 0; n4 < 4; ++n4) q += oacc[n4][r] * oacc[n4][r];
                q += shx<1>(q); q += shx<2>(q); q += shx<4>(q); q += shx<8>(q); ps[r] = q; }
            if (i16 == 0) {
#pragma unroll
                for (int r = 0; r < 4; ++r) nred[nh * 64 + 16 * mt + 4 * g + r] = ps[r]; }
            __syncthreads();
            float rs[4];
#pragma unroll
            for (int r = 0; r < 4; ++r) { const int t = 16 * mt + 4 * g + r; rs[r] = rsqrt_f((nred[t] + nred[64 + t]) * (1.0f / 128.0f) + LN_EPS); }
#pragma unroll
            for (int n4 = 0; n4 < 4; ++n4) { const int v = 16 * (nh * 4 + n4) + i16; const float gn = gnr[n4];
#pragma unroll
                for (int r = 0; r < 4; ++r) { const size_t row = row0 + 16 * mt + 4 * g + r;
                    const float gt = bf2f(gtr[n4][r]);
                    MIX[row * 2048 + h * 128 + v] = (bf16)f2bf(oacc[n4][r] * rs[r] * gn * silu_f(gt)); } }
        }
        __syncthreads();
    }
}


constexpr size_t DN_REC = 41984;
constexpr size_t DO_REC = 0, DO_U = 88 * MiB;
constexpr int RO_W = 0, RO_A = 16384, RO_K = 24576, RO_G = 40960;
constexpr int NDNC = NBATCH * 4 * 2 * NCHUNK;
static_assert(DO_REC + (size_t)NDNC * DN_REC <= DO_U && DO_U + (size_t)NDNC * 16384 <= (size_t)NBATCH * SEQL * DM * 4, "DN chunk buffers fit d_out");
constexpr int DN_TS = 272;
constexpr int DN_AS = 272;
constexpr int DN_PS = 144;
DI unsigned pk2t(float lo, float hi) { return pk2(lo, hi); }

DI void phase_dn_local(KP P, char* lds_, int bid, int nb, int wv_) {
    const gptr_t ws_ = lptr(P->ws);
    const gptr_t dob = lptr((unsigned char*)P->out);
    const int tid = ltid(), lane = tid & 63, wave = tid >> 6, g = lane >> 4, i16 = lane & 15;
    LDSP char* L = (LDSP char*)lds_;
    LDSP char* Kt = L;
    LDSP char* Qt = Kt + 64 * DN_TS;
    LDSP char* Vt = Qt + 64 * DN_TS;
    LDSP char* As = Vt + 64 * DN_TS;
    LDSP char* TB = As + 64 * DN_AS;
    LDSP char* TG = TB + 64 * DN_PS;
    LDSP float* gcl = (LDSP float*)(TG + 64 * DN_PS);
    LDSP float* btl = gcl + 64;
    LDSP char* Ts = (LDSP char*)(btl + 64);
    LDSP char* Xw = Ts + 64 * DN_AS;
    const bf16* DQ = (const bf16*)(ws_ + WS_DQ); const bf16* DK = (const bf16*)(ws_ + WS_DK); const bf16* DV = (const bf16*)(ws_ + WS_DV);
    const float* DBETA = (const float*)(ws_ + WS_DBG); const float* DG = DBETA + (size_t)2 * MROWS * 4;
    for (int u = (bid + 128) & 255; u < NDNC; u += nb) {
        const int dir = u & 1, j = (u >> 1) % NCHUNK, h = ((u >> 1) / NCHUNK) & 3, b = (u >> 1) / (4 * NCHUNK);
        const size_t row0 = (size_t)b * TT + (size_t)j * 64;
        const size_t c = ((size_t)((b * 4 + h) * 2 + dir)) * NCHUNK + chunk_of(dir, j);
        u32x4 tr6[6]; float gs0 = 0.f, bt0 = 0.f;
#pragma unroll
        for (int i = 0; i < 6; ++i) { const int q = tid + 512 * i, which = q >> 10, rem = q & 1023, t = rem >> 4, ch = rem & 15;
            const bf16* src = (which == 0 ? DK : which == 1 ? DQ : DV) + (row0 + t) * 512 + h * 128 + ch * 8;
            tr6[i] = *(const u32x4*)src; }
        if (wave == 0) { const int t = dir ? 63 - lane : lane; gs0 = DG[((size_t)dir * MROWS + row0 + t) * 4 + h]; bt0 = DBETA[((size_t)dir * MROWS + row0 + t) * 4 + h]; }
        __builtin_amdgcn_sched_barrier(0);
#pragma unroll
        for (int i = 0; i < 6; ++i) { const int q = tid + 512 * i, which = q >> 10, rem = q & 1023, t = rem >> 4, ch = rem & 15;
            *(LDSP u32x4*)(L + which * 64 * DN_TS + t * DN_TS + ch * 16) = tr6[i]; }
        if (wave == 0) {
            const int t = dir ? 63 - lane : lane;
            float gs = gs0;
#pragma unroll
            for (int o = 1; o < 64; o <<= 1) { const float up = __builtin_bit_cast(float, __builtin_amdgcn_ds_bpermute((int)(((unsigned)(lane - o) & 63u) << 2), __builtin_bit_cast(int, gs))); if (lane >= o) gs += up; }
            const float glast = __builtin_bit_cast(float, __builtin_amdgcn_readlane(__builtin_bit_cast(int, gs), 63));
            gcl[t] = gs; btl[t] = bt0;
            float* G = (float*)(dob + DO_REC + c * DN_REC + RO_G);
            G[t] = __expf(gs); G[64 + t] = __expf(glast - gs); if (lane == 0) G[128] = __expf(glast);
        }
        __syncthreads();
        if (wave < 4) {
            const int mt = wave;
            f32x4 acc[4];
#pragma unroll
            for (int n4 = 0; n4 < 4; ++n4) acc[n4] = (f32x4){0.f, 0.f, 0.f, 0.f};
#pragma unroll
            for (int s = 0; s < 4; ++s) { const bf16x8v af = ld_row(Kt, DN_TS, 16 * mt, 32 * s, lane);
#pragma unroll
                for (int n4 = 0; n4 < 4; ++n4) acc[n4] = MFMA16(af, ld_row(Kt, DN_TS, 16 * n4, 32 * s, lane), acc[n4]); }
#pragma unroll
            for (int n4 = 0; n4 < 4; ++n4) { const int tp = 16 * n4 + i16; const float gtp = gcl[tp];
#pragma unroll
                for (int r = 0; r < 4; ++r) { const int t = 16 * mt + 4 * g + r; const bool strict = dir == 0 ? (tp < t) : (tp > t);
                    const float val = strict ? btl[t] * acc[n4][r] * __expf(gcl[t] - gtp) : 0.f;
                    const int si = dir ? 63 - t : t, sj = dir ? 63 - tp : tp;
                    *(LDSP float*)(As + si * DN_AS + sj * 4) = val; } }
        } else {
            const int tt = wave - 4;
            f32x4 acc[4];
#pragma unroll
            for (int n4 = 0; n4 < 4; ++n4) acc[n4] = (f32x4){0.f, 0.f, 0.f, 0.f};
#pragma unroll
            for (int s = 0; s < 4; ++s) { const bf16x8v bq = ld_row(Qt, DN_TS, 16 * tt, 32 * s, lane);
#pragma unroll
                for (int n4 = 0; n4 < 4; ++n4) acc[n4] = MFMA16(ld_row(Kt, DN_TS, 16 * n4, 32 * s, lane), bq, acc[n4]); }
            const int t = 16 * tt + i16; const float gt = gcl[t];
            unsigned pk[4][2];
#pragma unroll
            for (int n4 = 0; n4 < 4; ++n4) { float v4[4];
#pragma unroll
                for (int r = 0; r < 4; ++r) { const int tp = 16 * n4 + 4 * g + r; const bool incl = dir == 0 ? (tp <= t) : (tp >= t);
                    v4[r] = incl ? acc[n4][r] * __expf(gt - gcl[tp]) : 0.f; }
                pk[n4][0] = pk2(v4[0], v4[1]); pk[n4][1] = pk2(v4[2], v4[3]); }
            u32x4* AF = (u32x4*)(dob + DO_REC + c * DN_REC + RO_A);
#pragma unroll
            for (int s = 0; s < 2; ++s) { u32x4 w; w.x = pk[2 * s][0]; w.y = pk[2 * s][1]; w.z = pk[2 * s + 1][0]; w.w = pk[2 * s + 1][1]; AF[(tt * 2 + s) * 64 + lane] = w; }
        }
        __syncthreads();
        {
            for (int e = tid; e < 6 * 256; e += 512) { const int blk = e >> 8, r = (e >> 4) & 15, cc = e & 15;
                const int bi = blk < 3 ? 0 : (blk < 5 ? 1 : 2), bj = blk < 3 ? blk + 1 : (blk < 5 ? blk - 1 : 3);
                *(LDSP float*)(Ts + (16 * bi + r) * DN_AS + (16 * bj + cc) * 4) = 0.f; }
            if (wave == 0) {
                const int blk = lane >> 4, cc = lane & 15;
                float T[16];
#pragma unroll
                for (int i = 0; i < 16; ++i) {
                    float a0 = (i == cc) ? 1.f : 0.f, a1 = 0.f;
#pragma unroll
                    for (int i4 = 0; i4 < (i + 3) / 4; ++i4) { const f32x4 av = *(const LDSP f32x4*)(As + (16 * blk + i) * DN_AS + (16 * blk + 4 * i4) * 4);
#pragma unroll
                        for (int e = 0; e < 4; ++e) if (4 * i4 + e < i) { if (e & 1) a1 -= av[e] * T[4 * i4 + e]; else a0 -= av[e] * T[4 * i4 + e]; } }
                    T[i] = a0 + a1;
                }
#pragma unroll
                for (int i = 0; i < 16; ++i) *(LDSP float*)(Ts + (16 * blk + i) * DN_AS + (16 * blk + cc) * 4) = T[i];
            } else {
                u32x4* KF = (u32x4*)(dob + DO_REC + c * DN_REC + RO_K);
                for (int f = wave - 1; f < 16; f += 7) { const int md = f >> 1, s = f & 1;
                    const LDSP char* a = Kt + (32 * s + 4 * g + (i16 >> 2)) * DN_TS + (16 * md + 4 * (i16 & 3)) * 2;
                    const v4i16_t lo = __builtin_amdgcn_ds_read_tr16_b64_v4i16((LDSP v4i16_t*)a);
                    const v4i16_t hi = __builtin_amdgcn_ds_read_tr16_b64_v4i16((LDSP v4i16_t*)(a + 16 * DN_TS));
                    const bf16x8v fr = (bf16x8v){lo[0], lo[1], lo[2], lo[3], hi[0], hi[1], hi[2], hi[3]};
                    *(bf16x8v*)(KF + f * 64 + lane) = fr; }
            }
            __syncthreads();
#pragma unroll
            for (int dlev = 1; dlev < 4; ++dlev) {
                if (wave < 4 - dlev) {
                    const int bi = wave + dlev, bj = wave;
                    f32x4 x = (f32x4){0.f, 0.f, 0.f, 0.f};
                    for (int bk = bj; bk < bi; ++bk) {
                        const f32x4 av = *(const LDSP f32x4*)(As + (16 * bi + i16) * DN_AS + (16 * bk + 4 * g) * 4);
#pragma unroll
                        for (int sp = 0; sp < 4; ++sp) { const float bv = *(const LDSP float*)(Ts + (16 * bk + 4 * g + sp) * DN_AS + (16 * bj + i16) * 4);
                            x = __builtin_amdgcn_mfma_f32_16x16x4f32(av[sp], bv, x, 0, 0, 0); }
                    }
                    LDSP float* Xs = (LDSP float*)(Xw + wave * 1280);
#pragma unroll
                    for (int r = 0; r < 4; ++r) Xs[(4 * g + r) * 20 + i16] = x[r];
                    asm volatile("s_waitcnt lgkmcnt(0)" ::: "memory");
                    const f32x4 tv = *(const LDSP f32x4*)(Ts + (16 * bi + i16) * DN_AS + (16 * bi + 4 * g) * 4);
                    f32x4 y = (f32x4){0.f, 0.f, 0.f, 0.f};
#pragma unroll
                    for (int sp = 0; sp < 4; ++sp) y = __builtin_amdgcn_mfma_f32_16x16x4f32(tv[sp], Xs[(4 * g + sp) * 20 + i16], y, 0, 0, 0);
#pragma unroll
                    for (int r = 0; r < 4; ++r) *(LDSP float*)(Ts + (16 * bi + 4 * g + r) * DN_AS + (16 * bj + i16) * 4) = -y[r];
                }
                __syncthreads();
            }
            {
                const int i = tid >> 3, c0 = (tid & 7) * 8, tr = dir ? 63 - i : i;
                const f32x4 t0 = *(const LDSP f32x4*)(Ts + i * DN_AS + c0 * 4), t1 = *(const LDSP f32x4*)(Ts + i * DN_AS + c0 * 4 + 16);
                const float tv[8] = {t0[0], t0[1], t0[2], t0[3], t1[0], t1[1], t1[2], t1[3]};
                float vb[8], vg[8];
#pragma unroll
                for (int e = 0; e < 8; ++e) { const int tc = dir ? 63 - (c0 + e) : c0 + e; const float bc = btl[tc]; vb[e] = tv[e] * bc; vg[e] = vb[e] * __expf(gcl[tc]); }
                u32x4 wb, wg;
                if (dir == 0) { wb = (u32x4){pk2(vb[0], vb[1]), pk2(vb[2], vb[3]), pk2(vb[4], vb[5]), pk2(vb[6], vb[7])}; wg = (u32x4){pk2(vg[0], vg[1]), pk2(vg[2], vg[3]), pk2(vg[4], vg[5]), pk2(vg[6], vg[7])}; }
                else          { wb = (u32x4){pk2(vb[7], vb[6]), pk2(vb[5], vb[4]), pk2(vb[3], vb[2]), pk2(vb[1], vb[0])}; wg = (u32x4){pk2(vg[7], vg[6]), pk2(vg[5], vg[4]), pk2(vg[3], vg[2]), pk2(vg[1], vg[0])}; }
                const int tcol = dir ? 63 - (c0 + 7) : c0;
                *(LDSP u32x4*)(TB + tr * DN_PS + tcol * 2) = wb; *(LDSP u32x4*)(TG + tr * DN_PS + tcol * 2) = wg;
            }
        }
        __syncthreads();
        {
            const int mt = wave & 3, nh = wave >> 2;
            f32x4 ua[4], wa[4];
#pragma unroll
            for (int n4 = 0; n4 < 4; ++n4) { ua[n4] = (f32x4){0.f, 0.f, 0.f, 0.f}; wa[n4] = (f32x4){0.f, 0.f, 0.f, 0.f}; }
#pragma unroll
            for (int s = 0; s < 2; ++s) {
                const bf16x8v tb = ld_row(TB, DN_PS, 16 * mt, 32 * s, lane);
                const bf16x8v tg = ld_row(TG, DN_PS, 16 * mt, 32 * s, lane);
#pragma unroll
                for (int n4 = 0; n4 < 4; ++n4) { const int nt = nh * 4 + n4;
                    ua[n4] = MFMA16(tb, ld_tr(Vt, DN_TS, 32 * s, 16 * nt, lane), ua[n4]);
                    wa[n4] = MFMA16(ld_tr(Kt, DN_TS, 32 * s, 16 * nt, lane), tg, wa[n4]); }
            }
            u32x2* UF = (u32x2*)(dob + DO_U) + c * 2048;
#pragma unroll
            for (int n4 = 0; n4 < 4; ++n4) { u32x2 w; w.x = pk2(ua[n4][0], ua[n4][1]); w.y = pk2(ua[n4][2], ua[n4][3]); UF[((nh * 4 + n4) * 4 + mt) * 64 + lane] = w; }
            u32x4* WF = (u32x4*)(dob + DO_REC + c * DN_REC + RO_W);
#pragma unroll
            for (int s2 = 0; s2 < 2; ++s2) { u32x4 w; w.x = pk2(-wa[2 * s2][0], -wa[2 * s2][1]); w.y = pk2(-wa[2 * s2][2], -wa[2 * s2][3]);
                w.z = pk2(-wa[2 * s2 + 1][0], -wa[2 * s2 + 1][1]); w.w = pk2(-wa[2 * s2 + 1][2], -wa[2 * s2 + 1][3]);
                WF[(mt * 4 + nh * 2 + s2) * 64 + lane] = w; }
        }
        __syncthreads();
    }
}

constexpr int DNS_Q = 41984, DNS_U = 58368, DNS_BUF = 62464;
DI void phase_dn_scan(KP P, char* lds_, int bid, int nb, int wv_) {
    const gptr_t ws_ = lptr(P->ws);
    const gptr_t dob = lptr((unsigned char*)P->out);
    const int tid = ltid(), lane = tid & 63, wave = tid >> 6, g = lane >> 4, i16 = lane & 15;
    LDSP char* L = (LDSP char*)lds_;
    const bf16* DQ = (const bf16*)(ws_ + WS_DQ); float* DO = (float*)(ws_ + WS_DNO);
    for (int uu = bid; uu < 128; uu += nb) {
        const int u = uu >> 2, sp = uu & 3, vs = 2 * sp + (wave & 1);
        const int dir = u & 1, h = (u >> 1) & 3, b = u >> 3;
        const size_t c0 = (size_t)u * NCHUNK;
        if (wave >= 2) {
            const int lt = tid - 128;
            u32x4 sr[3][7], sq[3][3], sU[3];
#define DNL_LOAD(stage, n) do { const size_t c = c0 + (n); const int jn = dir == 0 ? (n) : ((n) < 4 ? 3 - (n) : 71 - (n)); const size_t rw = (size_t)b * TT + (size_t)jn * 64; \
                const u32x4* Rg = (const u32x4*)(dob + DO_REC + c * DN_REC) + lt; \
                _Pragma("unroll") for (int k_ = 0; k_ < 7; ++k_) if (k_ < 6 || lt < 320) sr[stage][k_] = Rg[384 * k_]; \
                _Pragma("unroll") for (int k_ = 0; k_ < 3; ++k_) if (k_ < 2 || lt < 256) { const int id = lt + 384 * k_, f_ = id >> 6, ln_ = id & 63, mt_ = f_ >> 2, s_ = f_ & 3; \
                    const bf16* qp_ = DQ + (rw + 16 * mt_ + (ln_ & 15)) * 512 + h * 128 + 32 * s_ + 4 * (ln_ >> 4); const u32x2 lo_ = *(const u32x2*)qp_, hi_ = *(const u32x2*)(qp_ + 16); \
                    sq[stage][k_] = (u32x4){lo_.x, lo_.y, hi_.x, hi_.y}; } \
                if (lt < 256) sU[stage] = *((const u32x4*)(dob + DO_U + c * 16384 + (size_t)sp * 4096) + lt); } while (0)
#define DNL_STORE(stage, bufp) do { LDSP u32x4* B_ = (LDSP u32x4*)(bufp) + lt; \
                _Pragma("unroll") for (int k_ = 0; k_ < 7; ++k_) if (k_ < 6 || lt < 320) B_[384 * k_] = sr[stage][k_]; \
                _Pragma("unroll") for (int k_ = 0; k_ < 3; ++k_) if (k_ < 2 || lt < 256) B_[DNS_Q / 16 + 384 * k_] = sq[stage][k_]; \
                if (lt < 256) B_[DNS_U / 16] = sU[stage]; } while (0)
            DNL_LOAD(0, 0); DNL_LOAD(1, 1); DNL_LOAD(2, 2);
            DNL_STORE(0, L);
            DNL_LOAD(0, 3);
            __syncthreads();
#pragma unroll 1
            for (int n0 = 0; n0 < 69; n0 += 3) {
#pragma unroll
                for (int k = 0; k < 3; ++k) { const int n = n0 + k;
                    if (n + 1 < NCHUNK) DNL_STORE((k + 1) % 3, L + ((n + 1) & 1) * DNS_BUF);
                    if (n + 4 < NCHUNK) DNL_LOAD((k + 1) % 3, n + 4);
                    __syncthreads(); }
            }
#undef DNL_LOAD
#undef DNL_STORE
        } else {
            f32x4 S[8];
#pragma unroll
            for (int m = 0; m < 8; ++m) S[m] = (f32x4){0.f, 0.f, 0.f, 0.f};
            __syncthreads();
#pragma unroll 1
            for (int n = 0; n < 69; ++n) {
              if (n < NCHUNK) {
                const LDSP char* B = L + (n & 1) * DNS_BUF;
                const LDSP bf16x8v* BW = (const LDSP bf16x8v*)(B + RO_W); const LDSP bf16x8v* BQ = (const LDSP bf16x8v*)(B + DNS_Q);
                const LDSP bf16x8v* BA = (const LDSP bf16x8v*)(B + RO_A); const LDSP bf16x8v* BK = (const LDSP bf16x8v*)(B + RO_K);
                const LDSP float* BG = (const LDSP float*)(B + RO_G); const LDSP u32x2* BU = (const LDSP u32x2*)(B + DNS_U + (wave & 1) * 2048);
#define SB() __builtin_amdgcn_sched_barrier(0)
#define LD4(dst, src, off) do { _Pragma("unroll") for (int f_ = 0; f_ < 4; ++f_) dst[f_] = (src)[((off) + f_) * 64 + lane]; } while (0)
                bf16x8v fa[4], fb[4];
                LD4(fa, BW, 0);
                f32x4 vn[4], oa[4];
#pragma unroll
                for (int m = 0; m < 4; ++m) { const u32x2 w = BU[m * 64 + lane]; vn[m] = (f32x4){bflo(w.x), bfhi(w.x), bflo(w.y), bfhi(w.y)}; }
                bf16x8v Sb[4];
#pragma unroll
                for (int s = 0; s < 4; ++s) { u32x4 w; w.x = pk2(S[2 * s][0], S[2 * s][1]); w.y = pk2(S[2 * s][2], S[2 * s][3]); w.z = pk2(S[2 * s + 1][0], S[2 * s + 1][1]); w.w = pk2(S[2 * s + 1][2], S[2 * s + 1][3]);
                    Sb[s] = __builtin_bit_cast(bf16x8v, w); }
#define GRP(acc, buf) do { _Pragma("unroll") for (int s_ = 0; s_ < 4; ++s_) acc = MFMA16(buf[s_], Sb[s_], acc); } while (0)
                SB(); LD4(fb, BW, 4); SB(); GRP(vn[0], fa);
                SB(); LD4(fa, BW, 8); SB(); GRP(vn[1], fb);
                SB(); LD4(fb, BW, 12); SB(); GRP(vn[2], fa);
                SB(); LD4(fa, BQ, 0); SB(); GRP(vn[3], fb);
#pragma unroll
                for (int m = 0; m < 4; ++m) oa[m] = (f32x4){0.f, 0.f, 0.f, 0.f};
                SB(); LD4(fb, BQ, 4); SB(); GRP(oa[0], fa);
                SB(); LD4(fa, BQ, 8); SB(); GRP(oa[1], fb);
                SB(); LD4(fb, BQ, 12);
                f32x4 eb4[4];
#pragma unroll
                for (int m = 0; m < 4; ++m) eb4[m] = *(const LDSP f32x4*)(BG + 64 + 16 * m + 4 * g);
                SB(); GRP(oa[2], fa);
                SB(); LD4(fa, BA, 0); SB(); GRP(oa[3], fb);
#undef GRP
                bf16x8v Vb[2], Vs[2];
#pragma unroll
                for (int s2 = 0; s2 < 2; ++s2) { unsigned wv[4], ws2[4];
#pragma unroll
                    for (int hh = 0; hh < 2; ++hh) { const int m = 2 * s2 + hh; const f32x4 eb = eb4[m];
                        wv[2 * hh] = pk2(vn[m][0], vn[m][1]); wv[2 * hh + 1] = pk2(vn[m][2], vn[m][3]);
                        ws2[2 * hh] = pk2(vn[m][0] * eb[0], vn[m][1] * eb[1]); ws2[2 * hh + 1] = pk2(vn[m][2] * eb[2], vn[m][3] * eb[3]); }
                    Vb[s2] = __builtin_bit_cast(bf16x8v, (u32x4){wv[0], wv[1], wv[2], wv[3]}); Vs[s2] = __builtin_bit_cast(bf16x8v, (u32x4){ws2[0], ws2[1], ws2[2], ws2[3]}); }
                SB(); LD4(fb, BA, 4);
                f32x4 ea4[4];
#pragma unroll
                for (int m = 0; m < 4; ++m) ea4[m] = *(const LDSP f32x4*)(BG + 16 * m + 4 * g);
                const float egl = BG[128];
                SB();
                const int jn = dir == 0 ? n : (n < 4 ? 3 - n : 71 - n); const size_t rw = (size_t)b * TT + (size_t)jn * 64;
#define OGRP(m, buf, o0) do { f32x4 o = oa[m] * ea4[m]; o = MFMA16(buf[o0], Vb[0], o); o = MFMA16(buf[o0 + 1], Vb[1], o); \
                    _Pragma("unroll") for (int r = 0; r < 4; ++r) DO[((size_t)dir * MROWS + rw + 16 * (m) + 4 * g + r) * 512 + h * 128 + 16 * vs + i16] = o[r]; } while (0)
                OGRP(0, fa, 0); OGRP(1, fa, 2);
                SB(); LD4(fa, BK, 0); SB();
                OGRP(2, fb, 0); OGRP(3, fb, 2);
#undef OGRP
#define SGRP(md, buf) do { S[md] = S[md] * egl; S[md] = MFMA16(buf[0], Vs[0], S[md]); S[md] = MFMA16(buf[1], Vs[1], S[md]); \
                    S[md + 1] = S[md + 1] * egl; S[md + 1] = MFMA16(buf[2], Vs[0], S[md + 1]); S[md + 1] = MFMA16(buf[3], Vs[1], S[md + 1]); } while (0)
                SB(); LD4(fb, BK, 4); SB(); SGRP(0, fa);
                SB(); LD4(fa, BK, 8); SB(); SGRP(2, fb);
                SB(); LD4(fb, BK, 12); SB(); SGRP(4, fa);
                SB(); SGRP(6, fb);
#undef SGRP
#undef LD4
#undef SB
              }
              __syncthreads();
            }
        }
        __syncthreads();
    }
}

DI void dn_post_rows(KP P, int l, int rbeg, int rstep, int rend, bool skip_ctx, int wv_) {
    const gptr_t ws_ = lptr(P->ws);
    const int lane = ltid() & 63, wave = ltid() >> 6;
    const bf16* Z = (const bf16*)(ws_ + WS_ACT); bf16* MIX = (bf16*)(ws_ + WS_H);
    const float* gp = GIN(P->dn_norm_g) + (size_t)l * 128 + (lane & 15) * 8;
    const f32x4 g0 = *(const f32x4*)gp, g1 = *(const f32x4*)(gp + 4);
    auto nextr = [&](int r) { while (r < rend && skip_ctx && (r % TT) < CTXL) r += rstep; return r; };
    f32x4 o00, o01, o10, o11; u32x4 gw;
    auto fetch = [&](int r) { const float* O0 = (const float*)(ws_ + WS_DNO) + (size_t)r * 512 + lane * 8; const float* O1 = O0 + (size_t)MROWS * 512;
        o00 = *(const f32x4*)O0; o01 = *(const f32x4*)(O0 + 4); o10 = *(const f32x4*)O1; o11 = *(const f32x4*)(O1 + 4); gw = *(const u32x4*)(Z + (size_t)r * ZW + ZDG + lane * 8); };
    int r = nextr(rbeg + wave);
    if (r >= rend) return;
    fetch(r);
    f32x4 a0 = o00 + o10, a1 = o01 + o11; u32x4 gc = gw;
#pragma unroll 1
    while (true) {
        const int rn = nextr(r + rstep);
        if (rn < rend) fetch(rn);
        const float v[8] = {a0.x, a0.y, a0.z, a0.w, a1.x, a1.y, a1.z, a1.w};
        float ss = 0.f;
#pragma unroll
        for (int e = 0; e < 8; ++e) ss += v[e] * v[e];
        ss += shx<1>(ss); ss += shx<2>(ss); ss += shx<4>(ss); ss += shx<8>(ss);
        const float rs = rsqrt_f(ss * (1.0f / 128.0f) + LN_EPS);
        const float g[8] = {g0.x, g0.y, g0.z, g0.w, g1.x, g1.y, g1.z, g1.w};
        const float gt[8] = {bflo(gc.x), bfhi(gc.x), bflo(gc.y), bfhi(gc.y), bflo(gc.z), bfhi(gc.z), bflo(gc.w), bfhi(gc.w)};
        float o[8];
#pragma unroll
        for (int e = 0; e < 8; ++e) o[e] = v[e] * rs * g[e] * silu_f(gt[e]);
        u32x4 w; w.x = pk2(o[0], o[1]); w.y = pk2(o[2], o[3]); w.z = pk2(o[4], o[5]); w.w = pk2(o[6], o[7]);
        *(u32x4*)(MIX + (size_t)r * 2048 + 512 + lane * 8) = w;
        if (rn >= rend) break;
        a0 = o00 + o10; a1 = o01 + o11; gc = gw; r = rn;
    }
}
DI void phase_mixq(KP P, char* lds, unsigned* qctr, bool with_ctx, int l, bool skip_ctx, int bid, int nb, int wv_) {
    const gptr_t ws_ = lptr(P->ws);
    const bf16* AQ = (const bf16*)(ws_ + WS_AQ); const bf16* AKV = (const bf16*)(ws_ + WS_AKV); bf16* MIX = (bf16*)(ws_ + WS_H);
    LDSP unsigned* slot = (LDSP unsigned*)((LDSP char*)lds + 131072 + 64);
    const int natt = NBATCH * 8 * 16 + (with_ctx ? NBATCH * 8 : 0), ngla = NBATCH * 4 * NCHUNK, ndn = MROWS / 64;
    for (int k = 0; k < 3; ++k) {
        const int u = k < 2 ? bid + 256 * k : (bid >= 224 ? 512 + (bid - 224) : natt);
        if (u >= natt) break;
        int qb, bh;
        if (u < NBATCH * 8 * 16) { qb = 1 + (u & 15); bh = u >> 4; } else { qb = 0; bh = u - NBATCH * 8 * 16; }
        const int hq = bh & 3, kvh = (bh >> 2) & 1, b = bh >> 3, h = kvh * 4 + hq;
        const size_t row0 = (size_t)b * TT + (size_t)qb * 256;
        att::attn_dense_body<att::bf16>(AQ + row0 * 1024 + h * 128, AKV + (size_t)b * TT * 512 + kvh * 128, AKV + (size_t)b * TT * 512 + 256 + kvh * 128,
                                        MIX + row0 * 2048 + 1024 + h * 128, qb == 0 ? CTXL : TT, lds, wv_);
        __syncthreads();
    }
    for (int u = bid; u < ngla; u += nb) gla_out_unit(P, lds, u, l, wv_);
    if (bid >= 64) dn_post_rows(P, l, (bid - 64) * NWAVE, (nb - 64) * NWAVE, MROWS, skip_ctx, wv_);
}

struct RowOrder { pg8::StaticOrder base; int nN, nkt, parts; bool lat_only;
    DI void init(bool lat_only_, int N, int K, int parts_, int G, int c) { lat_only = lat_only_; nN = N / 256; nkt = K / 64; parts = parts_; base.init(NBATCH * SEQL, N, G, c); }
    DI bool next(int i, pg8::Unit& u) const {
        if (base.next(i, u)) { u.pm = 17 * (u.pm >> 4) + 1 + (u.pm & 15); u.kt0 = 0; u.nkt = nkt; return true; }
        if (lat_only) return false;
        const int q = i * base.G + base.c - base.nwg;
        if (q >= NBATCH * nN * parts) return false;
        const int unit = q / parts, part = q - unit * parts;
        u.pm = 17 * (unit / nN); u.pn = unit % nN; u.part = part;
        const int sz = nkt / parts;
        if (sz & 1) { const int base = (part >> 1) * 2 * sz; if (part & 1) { u.kt0 = base + sz + 1; u.nkt = sz - 1; } else { u.kt0 = base; u.nkt = sz + 1; } }
        else { u.nkt = sz; u.kt0 = part * sz; }
        return true; }
    DI void a_ready(const pg8::Unit&) const {}
    DI void done(const pg8::Unit&) const {} };
DI void phase_gemm_gu(KP P, int l, int sub, bool lat, char* lds, int bid, int nb, int wv_) {
    const gptr_t ws_ = lptr(P->ws);
    pg8::Gemm g{(const bf16*)(ws_ + WS_H), (const bf16*)(ws_ + WS_WGU) + (size_t)(l * 2 + sub) * WGU_ELEMS, MROWS, 2 * FF, DM};
    RowOrder S; S.init(lat, 2 * FF, DM, 1, nb, bid);
    pg8::EpiSwiglu E{(bf16*)(ws_ + WS_ACT), FF};
    pg8::gemm_phase<pg8::EpiSwiglu, RowOrder, PG8_ALIGN, PG8_SP2>((PG8_LAS unsigned char*)lds, g, S, E, wv_);
}
DI void phase_gemm_down(KP P, int l, int sub, bool lat, char* lds, int bid, int nb, int wv_) {
    const gptr_t ws_ = lptr(P->ws);
    pg8::Gemm g{(const bf16*)(ws_ + WS_ACT), (const bf16*)(ws_ + WS_WD) + (size_t)(l * 2 + sub) * WD_ELEMS, MROWS, DM, FF};
    RowOrder S; S.init(lat, DM, FF, 8, nb, bid);
    pg8::EpiDelta E{(bf16*)(ws_ + WS_DELTA), (bf16*)(ws_ + WS_PART), (const float*)(ws_ + WS_MOD) + (size_t)l * 5 * NMODV, sub == 0 ? 2 : 8, 0.5f, FF / 64};
    pg8::gemm_phase<pg8::EpiDelta, RowOrder, PG8_ALIGN, PG8_SP2>((PG8_LAS unsigned char*)lds, g, S, E, wv_);
}
DI void phase_gemm_in(KP P, int l, char* lds, int bid, int nb, int wv_) {
    const gptr_t ws_ = lptr(P->ws);
    pg8::Gemm g{(const bf16*)(ws_ + WS_H), (const bf16*)(ws_ + WS_WIN) + (size_t)l * WIN_ELEMS, MROWS, ZW, DM};
    RowOrder S; S.init(false, ZW, DM, 1, nb, bid);
    pg8::EpiStoreBf16 E{(bf16*)(ws_ + WS_ACT), ZW};
    pg8::gemm_phase<pg8::EpiStoreBf16, RowOrder, PG8_ALIGN, PG8_SP2>((PG8_LAS unsigned char*)lds, g, S, E, wv_);
}
DI void phase_gemm_out(KP P, int l, bool lat, char* lds, int bid, int nb, int wv_) {
    const gptr_t ws_ = lptr(P->ws);
    pg8::Gemm g{(const bf16*)(ws_ + WS_H), (const bf16*)(ws_ + WS_WOUT) + (size_t)l * WOUT_ELEMS, MROWS, DM, DM};
    RowOrder S; S.init(lat, DM, DM, 8, nb, bid);
    pg8::EpiDelta E{(bf16*)(ws_ + WS_DELTA), (bf16*)(ws_ + WS_PART), (const float*)(ws_ + WS_MOD) + (size_t)l * 5 * NMODV, 5, 1.0f, DM / 64};
    pg8::gemm_phase<pg8::EpiDelta, RowOrder, PG8_ALIGN, PG8_SP2>((PG8_LAS unsigned char*)lds, g, S, E, wv_);
}

#define LAS __attribute__((address_space(3)))
#define XB_TMO      128
#define XB_XCNT(j)  (256  + 64 * (j))
#define XB_XSUB(j)  (1280 + 64 * (j))
#define XB_XGEN(j)  (2304 + 64 * (j))
#define XB_TOP      3328
#define XB_TOPGEN   3392
#define XCD_BAR_WORDS 3456
#define XB_SPIN_CAP (1u << 18)

__device__ __forceinline__ unsigned xb_ld(unsigned* p)              { return __hip_atomic_load(p, __ATOMIC_RELAXED, __HIP_MEMORY_SCOPE_AGENT); }
__device__ __forceinline__ unsigned xb_add(unsigned* p, unsigned v) { return __hip_atomic_fetch_add(p, v, __ATOMIC_RELAXED, __HIP_MEMORY_SCOPE_AGENT); }
__device__ __forceinline__ unsigned xb_xcc_id() { return (unsigned)__builtin_amdgcn_s_getreg((3 << 11) | 20) & 0xFu; }
#define XB_SPIN(cond, bar) do { unsigned _sp = 0; while (cond) { __builtin_amdgcn_s_sleep(1); \
    if ((++_sp & 255u) == 0u) { if (xb_ld(&(bar)[XB_TMO])) break; if (_sp > XB_SPIN_CAP) { atomicAdd(&(bar)[XB_TMO], 1u); break; } } } } while (0)

struct XcdBarrier {
    unsigned* bar; unsigned x;
    volatile LAS unsigned* st;
};

__device__ __forceinline__ XcdBarrier xcd_barrier_post(unsigned* bar, volatile LAS unsigned* st) {
    XcdBarrier b; b.bar = bar; b.x = xb_xcc_id(); b.st = st;
    if (threadIdx.x == 0) (void)xb_add(&bar[XB_XCNT(b.x)], 1u);
    return b;
}
__device__ __forceinline__ void xcd_barrier_complete(unsigned* bar, unsigned x, unsigned& nloc, unsigned& nx) {
    const unsigned G = gridDim.x * gridDim.y * gridDim.z;
    unsigned sum, cnt, mine, sp = 0u;
    for (;;) {
        sum = 0u; cnt = 0u; mine = 0u;
#pragma unroll
        for (unsigned j = 0; j < 16; ++j) { const unsigned c = xb_ld(&bar[XB_XCNT(j)]); sum += c; cnt += (c > 0u) ? 1u : 0u; mine = (j == x) ? c : mine; }
        if (sum == G) break;
        __builtin_amdgcn_s_sleep(1);
        if ((++sp & 255u) == 0u) { if (xb_ld(&bar[XB_TMO])) break; if (sp > XB_SPIN_CAP) { atomicAdd(&bar[XB_TMO], 1u); break; } }
    }
    nloc = mine > 0u ? mine : 1u; nx = cnt > 0u ? cnt : 1u;
}

__device__ __forceinline__ void xcd_barrier(const XcdBarrier& b) {
    asm volatile("s_waitcnt vmcnt(0)" ::: "memory");
    __syncthreads();
    if (threadIdx.x == 0) {
        unsigned* bar = b.bar;
        __builtin_amdgcn_s_waitcnt(0);
        unsigned nloc = b.st[0], nx = b.st[1];
        if (nloc == 0u) { xcd_barrier_complete(bar, b.x, nloc, nx); b.st[0] = nloc; b.st[1] = nx; }
        const unsigned old = xb_add(&bar[XB_XSUB(b.x)], 1u);
        const unsigned gen = old / nloc;
        if (old + 1u == (gen + 1u) * nloc) {
            __builtin_amdgcn_fence(__ATOMIC_RELEASE, "agent");
            asm volatile("s_waitcnt vmcnt(0)" ::: "memory");
            const unsigned og = xb_add(&bar[XB_TOP], 1u);
            const unsigned tg = og / nx;
            if (og + 1u == (tg + 1u) * nx) xb_add(&bar[XB_TOPGEN], 1u);
            else XB_SPIN(xb_ld(&bar[XB_TOPGEN]) == tg, bar);
            __builtin_amdgcn_fence(__ATOMIC_ACQUIRE, "agent");
            xb_add(&bar[XB_XGEN(b.x)], 1u);
            asm volatile("s_waitcnt vmcnt(0)" ::: "memory");
        } else {
            XB_SPIN(xb_ld(&bar[XB_XGEN(b.x)]) == gen, bar);
            __builtin_amdgcn_fence(__ATOMIC_ACQUIRE, "agent");
            asm volatile("s_waitcnt vmcnt(0)" ::: "memory");
        }
    }
    __syncthreads();
}


constexpr int CW_QATT = 1024;
constexpr int CW_BAR = 4096;
constexpr int RING_BYTES = 131072, MISC_OFF = RING_BYTES + 320;
constexpr int LDS_BYTES = 147456;
static_assert((CW_BAR + XCD_BAR_WORDS) * 4 <= (int)CTL_ZERO_BYTES, "barrier words inside the memset region");

DI void dep_signal(unsigned* ctr, int wv_) {
    asm volatile("s_waitcnt vmcnt(0)" ::: "memory");
    __syncthreads();
    if (ltid() == 0) { __builtin_amdgcn_fence(__ATOMIC_RELEASE, "agent"); asm volatile("s_waitcnt vmcnt(0)" ::: "memory"); (void)xb_add(ctr, 1u); }
}
DI void dep_wait(unsigned* ctr, unsigned need, unsigned* bar, int wv_) {
    if (ltid() == 0) { XB_SPIN(xb_ld(ctr) < need, bar); __builtin_amdgcn_fence(__ATOMIC_ACQUIRE, "agent"); asm volatile("s_waitcnt vmcnt(0)" ::: "memory"); }
    __syncthreads();
}
constexpr int CW_DEP = 1536;
DI void phase_scanmix(KP P, char* lds, unsigned* ctl, int l, bool lastl, int bid, int wv_) {
    const gptr_t ws_ = lptr(P->ws);
    unsigned* done_dn = ctl + CW_DEP + 64 * (2 * l), * done_gla = ctl + CW_DEP + 64 * (2 * l + 1);
    if (bid < 128) { phase_dn_scan(P, lds, bid, 128, wv_); dep_signal(done_dn, wv_); }
    else { phase_gla_scan(P, bid - 128, 128, wv_); dep_signal(done_gla, wv_); }
    __syncthreads();
    const bf16* AQ = (const bf16*)(ws_ + WS_AQ); const bf16* AKV = (const bf16*)(ws_ + WS_AKV); bf16* MIX = (bf16*)(ws_ + WS_H);
    const int natt = NBATCH * 8 * 16 + (lastl ? 0 : NBATCH * 8), ngla = NBATCH * 4 * NCHUNK;
    for (int k = 0; k < 3; ++k) {
        const int u = k < 2 ? bid + 256 * k : (bid >= 224 ? 512 + (bid - 224) : natt);
        if (u >= natt) break;
        int qb, bh;
        if (u < NBATCH * 8 * 16) { qb = 1 + (u & 15); bh = u >> 4; } else { qb = 0; bh = u - NBATCH * 8 * 16; }
        const int hq = bh & 3, kvh = (bh >> 2) & 1, b = bh >> 3, h = kvh * 4 + hq;
        const size_t row0 = (size_t)b * TT + (size_t)qb * 256;
        att::attn_dense_body<att::bf16>(AQ + row0 * 1024 + h * 128, AKV + (size_t)b * TT * 512 + kvh * 128, AKV + (size_t)b * TT * 512 + 256 + kvh * 128,
                                        MIX + row0 * 2048 + 1024 + h * 128, qb == 0 ? CTXL : TT, lds, wv_);
        __syncthreads();
    }
    constexpr int R1 = 0;
    if (bid >= 128) { dep_wait(done_gla, 128u, ctl + CW_BAR, wv_);
        for (int u = bid - 128; u < ngla; u += 128) gla_out_unit(P, lds, u, l, wv_); }
    dep_wait(done_dn, 128u, ctl + CW_BAR, wv_);
    if (bid < 128) dn_post_rows(P, l, bid * NWAVE, 128 * NWAVE, R1, lastl, wv_);
    else dn_post_rows(P, l, R1 + (bid - 128) * NWAVE, 128 * NWAVE, MROWS, lastl, wv_);
}

__global__ void __launch_bounds__(NTHR, 2) mega_fwd(Params Pv) {
    extern __shared__ __attribute__((aligned(16))) char lds[];
    const int tid = threadIdx.x, bid = blockIdx.x; constexpr int nb = 256;
    const int wv0_ = __builtin_amdgcn_readfirstlane(tid >> 6);
    for (int u = tid; u < (LDS_BYTES - RING_BYTES) / 4; u += NTHR) ((unsigned*)(lds + RING_BYTES))[u] = 0u;
    __syncthreads();
    unsigned* ctl = (unsigned*)(Pv.ws + WS_CTL);
    const XcdBarrier bar = xcd_barrier_post(ctl + CW_BAR, (volatile LAS unsigned*)(lds + MISC_OFF + 32));
#define WV() ({ int w_ = wv0_; asm volatile("" : "+s"(w_)); w_; })
#define PKA() ({ KP kp_ = (KP)__builtin_amdgcn_kernarg_segment_ptr(); asm volatile("" : "+s"(kp_)); kp_; })
#define GRID_BAR() do { XcdBarrier b2_ = bar; asm volatile("" : "+s"(b2_.x), "+s"(b2_.bar)); xcd_barrier(b2_); } while (0)

    phase_mod(PKA(), lds, bid, nb, WV());
    phase_wcvt(PKA(), lds, bid, nb, WV());
    GRID_BAR();
    phase_init(PKA(), lds, bid, WV());
    GRID_BAR();

    for (int s = 0; s < 2 * NLAYER; ++s) {
        const int l = s >> 1, sub = s & 1; const bool last = (s == 2 * NLAYER - 1);
        const bool lastl = (l == NLAYER - 1);
        phase_gemm_gu(PKA(), l, sub, last, lds, bid, nb, WV());
        GRID_BAR();
        phase_gemm_down(PKA(), l, sub, last, lds, bid, nb, WV());
        GRID_BAR();
        if (sub == 0) phase_ln<false>(PKA(), lds, l, 0, l, 3, false, 8, bid, WV());
        else if (last) phase_ln<true>(PKA(), lds, l, 2, 0, -1, false, 0, bid, WV());
        else          phase_ln<false>(PKA(), lds, l, 2, l + 1, 0, false, 8, bid, WV());
        if (last) break;
        GRID_BAR();
        if (sub == 0) {
            phase_gemm_in(PKA(), l, lds, bid, nb, WV());
            GRID_BAR();
            phase_prep(PKA(), l, bid, nb, WV());
            GRID_BAR();
            phase_gla_local(PKA(), lds, bid, nb, WV());
            phase_dn_local(PKA(), lds, bid, nb, WV());
            GRID_BAR();
            phase_scanmix(PKA(), lds, ctl, l, lastl, bid, WV());
            GRID_BAR();
            phase_gemm_out(PKA(), l, lastl, lds, bid, nb, WV());
            GRID_BAR();
            phase_ln<false>(PKA(), lds, l, 1, l, 6, lastl, lastl ? 0 : 8, bid, WV());
            GRID_BAR();
        }
    }
#undef GRID_BAR
}

extern "C" void kernel_launch(void* const* d_in, const int* in_sizes, int n_in, void* d_out, int out_size, void* d_ws, size_t ws_size, hipStream_t stream) {
    static int grid = 0;
    if (grid == 0) {
        if (n_in != 24 || ws_size < WS_END2 || out_size != NBATCH * SEQL * DM) { fprintf(stderr, "kernel_launch: unexpected shapes (n_in %d, out %d, ws %zu)\n", n_in, out_size, ws_size); grid = -1; return; }
        int dev = 0, cus = 0, per_cu = 0;
        if (hipGetDevice(&dev) != hipSuccess || hipDeviceGetAttribute(&cus, hipDeviceAttributeMultiprocessorCount, dev) != hipSuccess) { grid = -1; return; }
        if (hipFuncSetAttribute((const void*)mega_fwd, hipFuncAttributeMaxDynamicSharedMemorySize, LDS_BYTES) != hipSuccess) { fprintf(stderr, "kernel_launch: hipFuncSetAttribute failed\n"); grid = -1; return; }
        if (hipOccupancyMaxActiveBlocksPerMultiprocessor(&per_cu, (const void*)mega_fwd, NTHR, LDS_BYTES) != hipSuccess || per_cu < 1) fprintf(stderr, "kernel_launch: occupancy query says %d\n", per_cu);
        (void)hipGetLastError();
        if (cus != 256) { fprintf(stderr, "kernel_launch: built for a 256-CU device (one workgroup per CU), found %d CUs; nothing launched\n", cus); grid = -1; return; }
        grid = cus;
    }
    if (grid < 0) return;
    if (hipMemsetAsync((char*)d_ws + WS_CTL, 0, CTL_ZERO_BYTES, stream) != hipSuccess) return;
    Params P{};
    const float** pp = (const float**)&P;
    for (int i = 0; i < 24; ++i) pp[i] = (const float*)d_in[i];
    P.out = (float*)d_out; P.ws = (unsigned char*)d_ws;
    hipLaunchKernelGGL(mega_fwd, dim3(grid), dim3(NTHR), LDS_BYTES, stream, P);
    const hipError_t le = hipPeekAtLastError();
    if (le != hipSuccess) fprintf(stderr, "kernel_launch: launch failed: %s\n", hipGetErrorName(le));
}
```

```cpp
#include <hip/hip_runtime.h>
#include <cstdio>
#include <cstdint>
#include <cmath>
#define GAS1 __attribute__((address_space(1)))
typedef __attribute__((address_space(1))) unsigned char* gptr_t;
__device__ __forceinline__ gptr_t lptr(unsigned char* p) { gptr_t g = (gptr_t)p; asm volatile("" : "+s"(g)); return g; }
__device__ __forceinline__ int ltid_from(int wv) { int l; asm volatile("v_mbcnt_lo_u32_b32 %0, -1, 0\n\tv_mbcnt_hi_u32_b32 %0, -1, %0" : "=v"(l)); return wv * 64 + l; }
#define ltid() ltid_from(wv_)

namespace pg8 {
#define PG8_LAS __attribute__((address_space(3)))
typedef unsigned short bf16_t;
typedef short bf16x8 __attribute__((ext_vector_type(8)));
typedef float f32x4 __attribute__((ext_vector_type(4)));
typedef unsigned u32x4 __attribute__((ext_vector_type(4)));
constexpr int BM = 256, BK = 64, HALF = 128, HTB = HALF * BK * 2  , STAGE_BYTES = 8 * HTB, NXCD = 8, WGM = 8;

__host__ __device__ __forceinline__ int lds_byte(int r, int c) { const int st = (r >> 4) * 2 + (c >> 5), rr = r & 15, cc = c & 31, ob = rr * 64 + cc * 2; return st * 1024 + (ob ^ (((ob >> 9) & 1) << 5)); }
__host__ __device__ __forceinline__ void stage_rc(int b, int& R, int& C) { const int st = b / 1024, sb = b % 1024, swz = sb ^ (((sb >> 9) & 1) << 5); R = (st >> 1) * 16 + swz / 64; C = (st & 1) * 32 + (swz % 64) / 2; }
__host__ __device__ __forceinline__ int perm32(int rho) { const int n = rho >> 4, i = rho & 15; return 8 * (i >> 2) + 4 * n + (i & 3); }

struct Unit { int pm, pn, kt0, nkt, part; };
struct Gemm { const bf16_t* A; const bf16_t* Bt; int M, N, K; };

struct StaticOrder {
    int nM, nN, nwg, G, c;
    __host__ __device__ void init(int M, int N, int G_, int c_) { nM = M / BM; nN = N / BM; nwg = nM * nN; G = G_; c = c_; }
    __host__ __device__ bool next(int i, Unit& u) const {
        const long L = (long)i * G + c; if (L >= nwg) return false;
        int wgid = (int)L; { const int q = nwg / NXCD, r = nwg % NXCD, xcd = wgid % NXCD, off = wgid / NXCD; wgid = (xcd < r ? xcd * (q + 1) : r * (q + 1) + (xcd - r) * q) + off; }
        const int nig = WGM * nN, gid = wgid / nig, fm = gid * WGM, gsz = (nM - fm) < WGM ? (nM - fm) : WGM;
        u.pm = fm + ((wgid % nig) % gsz); u.pn = (wgid % nig) / gsz; u.kt0 = 0; u.nkt = 0; u.part = 0; return true;
    }
    __device__ __forceinline__ void a_ready(const Unit&) const {}
    __device__ __forceinline__ void done(const Unit&) const {}
};

__device__ __forceinline__ unsigned cvt_pk_bf16(float lo, float hi) { unsigned r; asm volatile("v_cvt_pk_bf16_f32 %0, %1, %2" : "=v"(r) : "v"(lo), "v"(hi)); return r; }

struct EpiStoreBf16 {
    static constexpr bool PERM = true, AFTER_DRAIN = false;
    bf16_t* O; int ldc;
    __device__ __forceinline__ void operator()(const f32x4 (&acc)[2][2][4][2], const Unit& u, int wr, int wc, int fr, int fq) const {
        const int row0 = u.pm * BM + wr * 64 + fr, col0 = u.pn * BM + wc * 32 + 8 * fq;
#pragma unroll
        for (int ai = 0; ai < 2; ++ai)
#pragma unroll
            for (int m = 0; m < 4; ++m) { bf16_t* rowp = O + (size_t)(row0 + ai * HALF + m * 16) * ldc + col0;
#pragma unroll
                for (int bj = 0; bj < 2; ++bj) { const f32x4 v0 = acc[ai][bj][m][0], v1 = acc[ai][bj][m][1];
                    u32x4 w; w.x = cvt_pk_bf16(v0[0], v0[1]); w.y = cvt_pk_bf16(v0[2], v0[3]); w.z = cvt_pk_bf16(v1[0], v1[1]); w.w = cvt_pk_bf16(v1[2], v1[3]);
                    *(u32x4*)(rowp + bj * HALF) = w; } }
    }
};
__device__ __forceinline__ float silu_fast(float g) { return g * __builtin_amdgcn_rcpf(1.0f + __builtin_amdgcn_exp2f(-1.4426950408889634f * g)); }
struct EpiSwiglu {
    static constexpr bool PERM = true, AFTER_DRAIN = false;
    bf16_t* O; int ldc;
    __device__ __forceinline__ void operator()(const f32x4 (&acc)[2][2][4][2], const Unit& u, int wr, int wc, int fr, int fq) const {
        const int row0 = u.pm * BM + wr * 64 + fr, col0 = u.pn * HALF + wc * 32 + 8 * fq;
#pragma unroll
        for (int ai = 0; ai < 2; ++ai)
#pragma unroll
            for (int m = 0; m < 4; ++m) { bf16_t* rowp = O + (size_t)(row0 + ai * HALF + m * 16) * ldc + col0;
                const f32x4 g0 = acc[ai][0][m][0], g1 = acc[ai][0][m][1], u0 = acc[ai][1][m][0], u1 = acc[ai][1][m][1];
                float r[8];
#pragma unroll
                for (int i = 0; i < 4; ++i) { r[i] = silu_fast(g0[i]) * u0[i]; r[4 + i] = silu_fast(g1[i]) * u1[i]; }
                u32x4 w; w.x = cvt_pk_bf16(r[0], r[1]); w.y = cvt_pk_bf16(r[2], r[3]); w.z = cvt_pk_bf16(r[4], r[5]); w.w = cvt_pk_bf16(r[6], r[7]);
                *(u32x4*)rowp = w; }
    }
};
struct EpiDelta {
    static constexpr bool PERM = true, AFTER_DRAIN = false;
    bf16_t* D; bf16_t* PART; const float* modl; int gidx; float coef; int nkt_full;
    __device__ __forceinline__ void operator()(const f32x4 (&acc)[2][2][4][2], const Unit& u, int wr, int wc, int fr, int fq) const {
        const int mi = (u.pm % 17 == 0) ? 4 : (u.pm / 17);
        const float* gp = modl + (size_t)mi * 18432 + gidx * 2048;
        const int col0 = u.pn * BM + wc * 32 + 8 * fq;
        const bool part = u.nkt != nkt_full;
#pragma unroll
        for (int bj = 0; bj < 2; ++bj) {
            const f32x4 g0 = *(const f32x4*)(gp + col0 + bj * HALF) * coef, g1 = *(const f32x4*)(gp + col0 + bj * HALF + 4) * coef;
#pragma unroll
            for (int ai = 0; ai < 2; ++ai)
#pragma unroll
                for (int m = 0; m < 4; ++m) { const int rt = ai * HALF + wr * 64 + m * 16 + fr;
                    const f32x4 d0 = g0 * acc[ai][bj][m][0], d1 = g1 * acc[ai][bj][m][1];
                    u32x4 w; w.x = cvt_pk_bf16(d0[0], d0[1]); w.y = cvt_pk_bf16(d0[2], d0[3]); w.z = cvt_pk_bf16(d1[0], d1[1]); w.w = cvt_pk_bf16(d1[2], d1[3]);
                    if (part) *(u32x4*)(PART + ((size_t)u.part * 1024 + (size_t)(u.pm / 17) * 256 + rt) * 2048 + col0 + bj * HALF) = w;
                    else *(u32x4*)(D + (size_t)(u.pm * BM + rt) * 2048 + col0 + bj * HALF) = w; }
        }
    }
};

template <class Epi, class Sched, bool ALIGN_EPI = false, bool SP2 = false>
__device__ __forceinline__ void gemm_phase(PG8_LAS unsigned char* lds, const Gemm g, const Sched& S, const Epi& E, int wv_) {
    const int tid = ltid(), wid = __builtin_amdgcn_readfirstlane(tid >> 6), lane = tid & 63, wr = wid >> 2, wc = wid & 3, fr = lane & 15, fq = lane >> 4;
    const int K = g.K;
    unsigned voffA[2], voffB[2];
#pragma unroll
    for (int i = 0; i < 2; ++i) { int R, C; stage_rc(tid * 16 + i * 8192, R, C); const int Rb = Epi::PERM ? ((R & ~31) + perm32(R & 31)) : R;
        voffA[i] = (unsigned)(R * K + C) * 2u; voffB[i] = (unsigned)(Rb * K + C) * 2u; }
    const size_t kstep = (size_t)(BK * 2);
    const size_t hstep = (size_t)HALF * K * 2;
    const size_t tstep = 2 * hstep;
    const unsigned ldsw = (unsigned)wid * 1024u;
    const int aoff = lds_byte(wr * 64 + fr, fq * 8), boff = lds_byte(wc * 32 + fr, fq * 8);
#define PG8_SA(b, h) (((b) * 2 + (h)) * HTB)
#define PG8_SB(b, h) ((4 + (b) * 2 + (h)) * HTB)
#define PG8_STAGE(bufoff, gbase, voff) do { _Pragma("unroll") for (int _i = 0; _i < 2; ++_i) \
        __builtin_amdgcn_global_load_lds((const unsigned*)((const char*)(gbase) + (voff)[_i]), (PG8_LAS unsigned*)(lds + (bufoff) + ldsw + _i * 8192), 16, 0, 0); } while (0)
#define PG8_LDA(dst, b, h) do { _Pragma("unroll") for (int m = 0; m < 4; ++m) _Pragma("unroll") for (int k = 0; k < 2; ++k) dst[m][k] = *(const PG8_LAS bf16x8*)(lds + PG8_SA(b, h) + aoff + m * 2048 + k * 1024); } while (0)
#define PG8_LDB(dst, b, h) do { _Pragma("unroll") for (int n = 0; n < 2; ++n) _Pragma("unroll") for (int k = 0; k < 2; ++k) dst[n][k] = *(const PG8_LAS bf16x8*)(lds + PG8_SB(b, h) + boff + n * 2048 + k * 1024); } while (0)
#define PG8_MMA(ai, bj, At, Bt) do { __builtin_amdgcn_s_setprio(1); _Pragma("unroll") for (int m = 0; m < 4; ++m) _Pragma("unroll") for (int n = 0; n < 2; ++n) _Pragma("unroll") for (int k = 0; k < 2; ++k) \
        acc[ai][bj][m][n] = __builtin_amdgcn_mfma_f32_16x16x32_bf16(Bt[n][k], At[m][k], acc[ai][bj][m][n], 0, 0, 0); __builtin_amdgcn_s_setprio(0); } while (0)
#define PG8_WAIT_V(n) asm volatile("s_waitcnt vmcnt(" #n ")" ::: "memory")
#define PG8_WAIT_L(n) asm volatile("s_waitcnt lgkmcnt(" #n ")" ::: "memory")
#define PG8_BAR __builtin_amdgcn_s_barrier()
#define PG8_SCHED __builtin_amdgcn_sched_barrier(0)
    Unit cur, nxt; int ui = 0;
    if (!S.next(0, cur)) return;
    f32x4 acc[2][2][4][2];
#pragma unroll
    for (int a = 0; a < 2; ++a)
#pragma unroll
        for (int b = 0; b < 2; ++b)
#pragma unroll
            for (int m = 0; m < 4; ++m)
#pragma unroll
                for (int n = 0; n < 2; ++n) acc[a][b][m][n] = (f32x4){0.f, 0.f, 0.f, 0.f};
    bf16x8 At[4][2], B0[2][2], B1[2][2];
    const char* cA = (const char*)g.A + (size_t)cur.pm * tstep + (size_t)cur.kt0 * kstep; const char* cB = (const char*)g.Bt + (size_t)cur.pn * tstep + (size_t)cur.kt0 * kstep;
    S.a_ready(cur);
    if constexpr (SP2) {
        PG8_STAGE(PG8_SB(0, 0), cB, voffB); PG8_STAGE(PG8_SB(0, 1), cB + hstep, voffB); PG8_STAGE(PG8_SA(0, 0), cA, voffA); PG8_STAGE(PG8_SA(0, 1), cA + hstep, voffA);
        if (wr == 1) PG8_BAR;
        PG8_WAIT_V(2); PG8_BAR;
        PG8_STAGE(PG8_SB(1, 0), cB + kstep, voffB); PG8_STAGE(PG8_SA(1, 0), cA + kstep, voffA); PG8_STAGE(PG8_SB(1, 1), cB + hstep + kstep, voffB);
        PG8_WAIT_V(6); PG8_BAR;
    } else {
        PG8_STAGE(PG8_SB(0, 0), cB, voffB); PG8_STAGE(PG8_SA(0, 0), cA, voffA); PG8_STAGE(PG8_SB(0, 1), cB + hstep, voffB); PG8_STAGE(PG8_SA(0, 1), cA + hstep, voffA);
        if (wr == 1) PG8_BAR;
        PG8_WAIT_V(4); PG8_BAR;
        PG8_STAGE(PG8_SB(1, 0), cB + kstep, voffB); PG8_STAGE(PG8_SA(1, 0), cA + kstep, voffA); PG8_STAGE(PG8_SB(1, 1), cB + hstep + kstep, voffB);
        PG8_WAIT_V(6); PG8_BAR;
    }
    for (;;) {
        const bool has_next = S.next(ui + 1, nxt);
        const char* nA = has_next ? (const char*)g.A + (size_t)nxt.pm * tstep + (size_t)nxt.kt0 * kstep : cA; const char* nB = has_next ? (const char*)g.Bt + (size_t)nxt.pn * tstep + (size_t)nxt.kt0 * kstep : cB;
        const int nt = cur.nkt;
        for (int t = 0; t < nt; t += 2) {
            const bool last = (t == nt - 2);
            const char* a1 = cA + (size_t)(t + 1) * kstep;
            const char* a2 = last ? nA : cA + (size_t)(t + 2) * kstep; const char* b2 = last ? nB : cB + (size_t)(t + 2) * kstep;
            const char* a3 = a2 + kstep; const char* b3 = b2 + kstep;
            if (last && has_next) S.a_ready(nxt);
            if constexpr (SP2) {
            PG8_LDB(B0, 0, 0); PG8_LDB(B1, 0, 1); PG8_SCHED; PG8_LDA(At, 0, 0); PG8_STAGE(PG8_SA(1, 1), a1 + hstep, voffA);
            PG8_WAIT_V(8); PG8_WAIT_L(0); PG8_BAR; PG8_MMA(0, 0, At, B0); PG8_MMA(0, 1, At, B1); PG8_BAR; PG8_SCHED;
            PG8_LDA(At, 0, 1); PG8_STAGE(PG8_SB(0, 0), b2, voffB); PG8_STAGE(PG8_SB(0, 1), b2 + hstep, voffB); PG8_STAGE(PG8_SA(0, 0), a2, voffA);
            PG8_WAIT_V(8); PG8_WAIT_L(0); PG8_BAR; PG8_MMA(1, 0, At, B0); PG8_MMA(1, 1, At, B1); PG8_BAR; PG8_SCHED;
            PG8_LDB(B0, 1, 0); PG8_LDB(B1, 1, 1); PG8_SCHED; PG8_LDA(At, 1, 0); PG8_STAGE(PG8_SA(0, 1), a2 + hstep, voffA);
            PG8_WAIT_V(8); PG8_WAIT_L(0); PG8_BAR; PG8_MMA(0, 0, At, B0); PG8_MMA(0, 1, At, B1); PG8_BAR; PG8_SCHED;
            PG8_LDA(At, 1, 1); PG8_STAGE(PG8_SB(1, 0), b3, voffB); PG8_STAGE(PG8_SB(1, 1), b3 + hstep, voffB); PG8_STAGE(PG8_SA(1, 0), a3, voffA);
            PG8_WAIT_V(8); PG8_WAIT_L(0); PG8_BAR; PG8_MMA(1, 0, At, B0); PG8_MMA(1, 1, At, B1); PG8_BAR; PG8_SCHED;
            } else {
            PG8_LDB(B0, 0, 0); PG8_SCHED; PG8_LDA(At, 0, 0); PG8_STAGE(PG8_SA(1, 1), a1 + hstep, voffA);
            PG8_WAIT_L(8); PG8_BAR; PG8_WAIT_L(0); PG8_MMA(0, 0, At, B0); PG8_BAR; PG8_SCHED;
            PG8_LDB(B1, 0, 1); PG8_STAGE(PG8_SB(0, 0), b2, voffB);
            PG8_BAR; PG8_WAIT_L(0); PG8_MMA(0, 1, At, B1); PG8_BAR;
            PG8_LDA(At, 0, 1); PG8_STAGE(PG8_SA(0, 0), a2, voffA);
            PG8_BAR; PG8_WAIT_L(0); PG8_MMA(1, 0, At, B0); PG8_BAR; PG8_SCHED;
            PG8_STAGE(PG8_SB(0, 1), b2 + hstep, voffB);
            PG8_WAIT_V(6); PG8_BAR; PG8_MMA(1, 1, At, B1); PG8_BAR;
            PG8_LDB(B0, 1, 0); PG8_SCHED; PG8_LDA(At, 1, 0); PG8_STAGE(PG8_SA(0, 1), a2 + hstep, voffA);
            PG8_WAIT_L(8); PG8_BAR; PG8_WAIT_L(0); PG8_MMA(0, 0, At, B0); PG8_BAR; PG8_SCHED;
            PG8_LDB(B1, 1, 1); PG8_STAGE(PG8_SB(1, 0), b3, voffB);
            PG8_BAR; PG8_WAIT_L(0); PG8_MMA(0, 1, At, B1); PG8_BAR;
            PG8_LDA(At, 1, 1); PG8_STAGE(PG8_SA(1, 0), a3, voffA);
            PG8_BAR; PG8_WAIT_L(0); PG8_MMA(1, 0, At, B0); PG8_BAR; PG8_SCHED;
            PG8_STAGE(PG8_SB(1, 1), b3 + hstep, voffB);
            PG8_WAIT_V(6); PG8_BAR; PG8_MMA(1, 1, At, B1); PG8_BAR;
            }
        }
        if constexpr (ALIGN_EPI) { if (wr == 0) PG8_BAR; }
        if constexpr (!Epi::AFTER_DRAIN) { E(acc, cur, wr, wc, fr, fq); S.done(cur); }
        if (!has_next) break;
#pragma unroll
        for (int a = 0; a < 2; ++a)
#pragma unroll
            for (int b = 0; b < 2; ++b)
#pragma unroll
                for (int m = 0; m < 4; ++m)
#pragma unroll
                    for (int n = 0; n < 2; ++n) acc[a][b][m][n] = (f32x4){0.f, 0.f, 0.f, 0.f};
        cur = nxt; cA = nA; cB = nB; ++ui;
        if constexpr (ALIGN_EPI) { if (wr == 1) PG8_BAR; }
    }
    PG8_WAIT_V(0);
    if constexpr (!ALIGN_EPI) { if (wr == 0) PG8_BAR; }
    PG8_BAR;
    if constexpr (Epi::AFTER_DRAIN) { E.fused(acc, cur, wr, wc, fr, fq, lds, wid, lane); S.done(cur); }
#undef PG8_SA
#undef PG8_SB
#undef PG8_STAGE
#undef PG8_LDA
#undef PG8_LDB
#undef PG8_MMA
#undef PG8_WAIT_V
#undef PG8_WAIT_L
#undef PG8_BAR
#undef PG8_SCHED
}
}

#ifndef PG8_SP2
#define PG8_SP2 true
#endif
#ifndef PG8_ALIGN
#define PG8_ALIGN true
#endif

namespace att {
using bf16 = unsigned short;
constexpr int   D = 128, NW = 8, QBLK = 32, KVBLK = 64;
constexpr float SCALE = 0.088388347648318440f;
constexpr float THR = 8.f;
constexpr int SDEPTH = 2;
constexpr int LDQ = 1024, LDK = 512, LDO = 2048;
constexpr size_t SHM_V = KVBLK * D * 2, SHM_K = KVBLK * D * 2, SHM_ATTN = 2 * SHM_V + 2 * SHM_K + NW * 64 * 4;
__device__ __forceinline__ unsigned short f2bf_rne(float f) { unsigned u = __builtin_bit_cast(unsigned, f); return (unsigned short)((u + 0x7fffu + ((u >> 16) & 1u)) >> 16); }
using bf16x8 = __attribute__((ext_vector_type(8))) short;
using s16x4  = __attribute__((ext_vector_type(4))) short;
using f32x16 = __attribute__((ext_vector_type(16))) float;
using f32x8  = __attribute__((ext_vector_type(8))) float;
using u32x4  = __attribute__((ext_vector_type(4))) unsigned;
#define KSWZ(row, colB) ((row) * 256 + ((colB) ^ (((row) & 7) << 4)))
#define SBAR() __builtin_amdgcn_sched_barrier(0)
__device__ __forceinline__ int crow(int r, int hi) { return (r & 3) + 8 * (r >> 2) + 4 * hi; }
__device__ __forceinline__ unsigned cvtpk(float lo, float hi) {
  unsigned r; asm volatile("v_cvt_pk_bf16_f32 %0, %1, %2" : "=v"(r) : "v"(lo), "v"(hi)); return r;
}
template <typename TIn> struct Stage;
template <> struct Stage<bf16>  { using T = bf16x8;
  __device__ static __forceinline__ T ld8(const bf16* p) { return *reinterpret_cast<const bf16x8*>(p); }
  __device__ static __forceinline__ bf16x8 tobf(T x) { return x; } };
template <> struct Stage<float> { using T = f32x8;
  __device__ static __forceinline__ T ld8(const float* p) { return *reinterpret_cast<const f32x8*>(p); }
  __device__ static __forceinline__ bf16x8 tobf(T x) {
    u32x4 w = {cvtpk(x[0], x[1]), cvtpk(x[2], x[3]), cvtpk(x[4], x[5]), cvtpk(x[6], x[7])}; return *reinterpret_cast<bf16x8*>(&w); } };

__device__ __forceinline__ void partialSM(f32x16& p0, f32x16& p1, float& m_reg, float& mn, float& alpha) {
  constexpr float C = SCALE * 1.4426950408889634f;
  float pmax = p0[0]; for (int r = 1; r < 16; ++r) pmax = fmaxf(pmax, p0[r]); for (int r = 0; r < 16; ++r) pmax = fmaxf(pmax, p1[r]);
  { auto rr = __builtin_amdgcn_permlane32_swap(__float_as_uint(pmax), __float_as_uint(pmax), false, false);
    pmax = fmaxf(__uint_as_float(rr[0]), __uint_as_float(rr[1])); }
  if (__builtin_expect(__all(pmax - m_reg <= THR / SCALE), 1)) { mn = m_reg; alpha = 1.f; }
  else { mn = fmaxf(m_reg, pmax); alpha = __builtin_amdgcn_exp2f((m_reg - mn) * C); m_reg = mn; }
  float mnC = -mn * C;
  for (int r = 0; r < 16; ++r) p0[r] = fmaf(p0[r], C, mnC); for (int r = 0; r < 16; ++r) p1[r] = fmaf(p1[r], C, mnC);
  for (int r = 0; r < 16; ++r) p0[r] = __builtin_amdgcn_exp2f(p0[r]);
}
__device__ __forceinline__ void finishSM(f32x16& p0, f32x16& p1, float alpha, float& l_reg, bf16x8& pa0, bf16x8& pa1, bf16x8& pa2, bf16x8& pa3) {
  for (int r = 0; r < 16; ++r) p1[r] = __builtin_amdgcn_exp2f(p1[r]);
  float ps = 0; for (int r = 0; r < 16; ++r) ps += p0[r]; for (int r = 0; r < 16; ++r) ps += p1[r];
  { auto rr = __builtin_amdgcn_permlane32_swap(__float_as_uint(ps), __float_as_uint(ps), false, false);
    ps = __uint_as_float(rr[0]) + __uint_as_float(rr[1]); }
  l_reg = l_reg * alpha + ps;
#define PK4(P, BASE, OUT) do { unsigned a0 = cvtpk(P[BASE + 0], P[BASE + 1]), a1 = cvtpk(P[BASE + 2], P[BASE + 3]);   \
    unsigned b0 = cvtpk(P[BASE + 4], P[BASE + 5]), b1 = cvtpk(P[BASE + 6], P[BASE + 7]);                              \
    auto r0 = __builtin_amdgcn_permlane32_swap(a0, b0, false, false); auto r1 = __builtin_amdgcn_permlane32_swap(a1, b1, false, false); \
    u32x4 w = {r0[0], r1[0], r0[1], r1[1]}; OUT = *reinterpret_cast<bf16x8*>(&w); } while (0)
  PK4(p0, 0, pa0); PK4(p0, 8, pa1); PK4(p1, 0, pa2); PK4(p1, 8, pa3);
#undef PK4
}
__device__ __forceinline__ void qkt(f32x16& p0, f32x16& p1, const bf16* Ks, const bf16x8* qr, int r32, int hi) {
  p0 = f32x16{}; p1 = f32x16{};
  for (int d0 = 0; d0 < 8; ++d0) { int cb = (d0 * 16 + hi * 8) * 2;
    bf16x8 b0 = *reinterpret_cast<const bf16x8*>((const char*)Ks + KSWZ(r32, cb));
    bf16x8 b1 = *reinterpret_cast<const bf16x8*>((const char*)Ks + KSWZ(32 + r32, cb));
    p0 = __builtin_amdgcn_mfma_f32_32x32x16_bf16(b0, qr[d0], p0, 0, 0, 0);
    p1 = __builtin_amdgcn_mfma_f32_32x32x16_bf16(b1, qr[d0], p1, 0, 0, 0); }
}
__device__ __forceinline__ int v_st(int k, int c) { const int kk = (k & ~0xC) | ((k & 4) << 1) | ((k & 8) >> 1); return ((kk >> 3) * 4 + (c >> 5)) * 512 + ((kk & 7) * 32 + (c & 31)) * 2; }
__device__ __forceinline__ int v_rd_base(int lane) { return ((lane & 3) << 3) | (((lane >> 2) & 3) << 6) | (((lane >> 4) & 1) << 5) | (((lane >> 5) & 1) << 8); }
constexpr int v_rd_off(int d0, int ks, int half) { return d0 * 512 + ks * 4096 + half * 2048; }
template <int OFF> __device__ __forceinline__ s16x4 tr_read(int vb) {
  s16x4 r; asm volatile("ds_read_b64_tr_b16 %0, %1 offset:%2" : "=&v"(r) : "v"(vb), "i"(OFF) : "memory"); return r;
}
template <int D0> __device__ __forceinline__ void pv_one(f32x16& od, int vb, bf16x8 pa0, bf16x8 pa1, bf16x8 pa2, bf16x8 pa3) {
  const s16x4 l0 = tr_read<v_rd_off(D0, 0, 0)>(vb), h0 = tr_read<v_rd_off(D0, 0, 1)>(vb), l1 = tr_read<v_rd_off(D0, 1, 0)>(vb), h1 = tr_read<v_rd_off(D0, 1, 1)>(vb);
  const s16x4 l2 = tr_read<v_rd_off(D0, 2, 0)>(vb), h2 = tr_read<v_rd_off(D0, 2, 1)>(vb), l3 = tr_read<v_rd_off(D0, 3, 0)>(vb), h3 = tr_read<v_rd_off(D0, 3, 1)>(vb);
  asm volatile("s_waitcnt lgkmcnt(0)" ::: "memory"); SBAR();
#define PK(L, H) (bf16x8){L[0], L[1], L[2], L[3], H[0], H[1], H[2], H[3]}
  od = __builtin_amdgcn_mfma_f32_32x32x16_bf16(pa0, PK(l0, h0), od, 0, 0, 0);
  od = __builtin_amdgcn_mfma_f32_32x32x16_bf16(pa1, PK(l1, h1), od, 0, 0, 0);
  od = __builtin_amdgcn_mfma_f32_32x32x16_bf16(pa2, PK(l2, h2), od, 0, 0, 0);
  od = __builtin_amdgcn_mfma_f32_32x32x16_bf16(pa3, PK(l3, h3), od, 0, 0, 0);
#undef PK
}
__device__ __forceinline__ void pv_d0(f32x16* o, int vb, bf16x8 pa0, bf16x8 pa1, bf16x8 pa2, bf16x8 pa3) {
  pv_one<0>(o[0], vb, pa0, pa1, pa2, pa3); pv_one<1>(o[1], vb, pa0, pa1, pa2, pa3); pv_one<2>(o[2], vb, pa0, pa1, pa2, pa3); pv_one<3>(o[3], vb, pa0, pa1, pa2, pa3);
}

template <typename TQ>
__device__ __forceinline__ void attn_dense_body(const TQ* __restrict__ Qb, const bf16* __restrict__ Kh, const bf16* __restrict__ Vh,
                                                bf16* __restrict__ Ob, int seq, char* lds, int wv_) {
  using St = Stage<bf16>; using SQ = Stage<TQ>;
  const int tid = ltid(), wid = tid >> 6, lane = tid & 63, r32 = lane & 31, hi = lane >> 5;
  bf16* V_lds = (bf16*)lds; bf16* K_lds = (bf16*)(lds + 2 * SHM_V);
  float* ws = (float*)(lds + 2 * SHM_V + 2 * SHM_K) + wid * 64; float* li_l = ws; float* al_l = ws + 32;
  float m_reg = -1e30f, l_reg = 0; f32x16 o[4] = {}; bf16x8 qr[8];
  const TQ* Qw = Qb + (long)(wid * QBLK + r32) * LDQ + hi * 8;
#pragma unroll
  for (int d0 = 0; d0 < 8; ++d0) qr[d0] = SQ::tobf(SQ::ld8(Qw + d0 * 16));
  const int sr = tid >> 4, sc = (tid & 15) * 8, vst0 = v_st(sr, sc), vst1 = v_st(32 + sr, sc);
  const int vb0 = (int)(uintptr_t)V_lds + v_rd_base(lane);
  struct { typename St::T vs0, vs1, ks0, ks1; } sr_[SDEPTH];
#define SLOAD(i, k0) do { sr_[i].vs0 = St::ld8(&Vh[(long)((k0) + sr) * LDK + sc]); sr_[i].vs1 = St::ld8(&Vh[(long)((k0) + 32 + sr) * LDK + sc]); \
    sr_[i].ks0 = St::ld8(&Kh[(long)((k0) + sr) * LDK + sc]); sr_[i].ks1 = St::ld8(&Kh[(long)((k0) + 32 + sr) * LDK + sc]); } while (0)
#define SWRITE(b, i) do { *(bf16x8*)((char*)V_lds + (b) * SHM_V + vst0) = St::tobf(sr_[i].vs0);          \
    *(bf16x8*)((char*)V_lds + (b) * SHM_V + vst1) = St::tobf(sr_[i].vs1); int kc = sc * 2;               \
    *(bf16x8*)((char*)K_lds + (b) * SHM_K + KSWZ(sr, kc)) = St::tobf(sr_[i].ks0);                       \
    *(bf16x8*)((char*)K_lds + (b) * SHM_K + KSWZ(32 + sr, kc)) = St::tobf(sr_[i].ks1); } while (0)
#define SWAIT() do { if constexpr (SDEPTH == 2) asm volatile("s_waitcnt vmcnt(4)" ::: "memory"); else asm volatile("s_waitcnt vmcnt(0)" ::: "memory"); } while (0)
#define RESC(a) do { if (__any((a) < 1.f)) { if (hi == 0) al_l[r32] = (a); asm volatile("s_waitcnt lgkmcnt(0)" ::: "memory"); \
    for (int d = 0; d < 4; ++d) for (int r = 0; r < 16; ++r) o[d][r] *= al_l[crow(r, hi)]; } } while (0)
  f32x16 pA0, pA1, pB0, pB1; float mnA, mnB, alA, alB; bf16x8 pa0, pa1, pa2, pa3; const int NT = seq / KVBLK;
  constexpr int SE = 0, SO = SDEPTH - 1;
  SLOAD(SE, 0); asm volatile("s_waitcnt vmcnt(0)" ::: "memory"); SWRITE(0, SE); __syncthreads();
  qkt(pA0, pA1, K_lds, qr, r32, hi); partialSM(pA0, pA1, m_reg, mnA, alA);
  SLOAD(SO, KVBLK); if constexpr (SDEPTH == 2) { if (2 < NT) SLOAD(SE, 2 * KVBLK); }
  SWAIT(); SWRITE(1, SO); __syncthreads();
  for (int j = 1; j + 1 < NT; j += 2) {
    SBAR(); qkt(pB0, pB1, (bf16*)((char*)K_lds + SHM_K), qr, r32, hi);
    finishSM(pA0, pA1, alA, l_reg, pa0, pa1, pa2, pa3); SBAR();
    SLOAD(SO, (j + SDEPTH) * KVBLK); SBAR();
    pv_d0(o, vb0, pa0, pa1, pa2, pa3); partialSM(pB0, pB1, m_reg, mnB, alB);
    __syncthreads(); SWAIT(); SWRITE(0, SE);
    RESC(alB); __syncthreads();
    SBAR(); qkt(pA0, pA1, K_lds, qr, r32, hi);
    finishSM(pB0, pB1, alB, l_reg, pa0, pa1, pa2, pa3); SBAR();
    if (SDEPTH == 1 || j + 3 < NT) SLOAD(SE, (j + 1 + SDEPTH) * KVBLK); SBAR();
    pv_d0(o, vb0 + (int)SHM_V, pa0, pa1, pa2, pa3); partialSM(pA0, pA1, m_reg, mnA, alA);
    __syncthreads(); SWAIT(); SWRITE(1, SO);
    RESC(alA); __syncthreads();
  }
  SBAR(); qkt(pB0, pB1, (bf16*)((char*)K_lds + SHM_K), qr, r32, hi);
  finishSM(pA0, pA1, alA, l_reg, pa0, pa1, pa2, pa3); SBAR();
  pv_d0(o, vb0, pa0, pa1, pa2, pa3); partialSM(pB0, pB1, m_reg, mnB, alB);
  __syncthreads(); RESC(alB);
  finishSM(pB0, pB1, alB, l_reg, pa0, pa1, pa2, pa3); SBAR();
  pv_d0(o, vb0 + (int)SHM_V, pa0, pa1, pa2, pa3);
  if (hi == 0) li_l[r32] = l_reg; asm volatile("s_waitcnt lgkmcnt(0)" ::: "memory");
  float rli[16];
#pragma unroll
  for (int r = 0; r < 16; ++r) rli[r] = __builtin_amdgcn_rcpf(li_l[crow(r, hi)]);
  bf16* Ow = Ob + (long)(wid * QBLK) * LDO;
#pragma unroll
  for (int r = 0; r < 16; ++r) { int orow = crow(r, hi);
    for (int d0 = 0; d0 < 4; ++d0) Ow[(long)orow * LDO + d0 * 32 + r32] = f2bf_rne(o[d0][r] * rli[r]); }
#undef SLOAD
#undef SWRITE
#undef SWAIT
#undef RESC
}
}

typedef unsigned short bf16;
typedef float f32x4 __attribute__((ext_vector_type(4)));
typedef unsigned u32x4 __attribute__((ext_vector_type(4)));
typedef unsigned u32x2 __attribute__((ext_vector_type(2)));
typedef _Float16 h16x4 __attribute__((ext_vector_type(4)));
#define DI __device__ __forceinline__

constexpr int DM = 2048, NBATCH = 4, SEQL = 4096, CTXL = 256, TT = SEQL + CTXL  , MROWS = NBATCH * TT  ;
constexpr int FF = 5632, NLAYER = 2, NMODV = 9 * DM  ;
constexpr int ZW = 5376;
constexpr int ZGQ = 0, ZGK = 256, ZGV = 512, ZGR = 1024, ZDQ = 1536, ZDK = 2048, ZDV = 2560, ZDG = 3072, ZAQ = 3584, ZAK = 4608, ZAV = 4864, ZWA1 = 5120, ZWAB = 5152;
constexpr float LN_EPS = 1e-6f;
constexpr float DN_ALPHA = 1.4142135623730951f;
constexpr int NTHR = 512, NWAVE = 8;

constexpr size_t MiB = 1u << 20;
constexpr size_t WS_CTL = 0, CTL_ZERO_BYTES = 1 * MiB;
constexpr size_t WS_MOD = 1 * MiB;
constexpr size_t WS_ROPE = 2 * MiB;
constexpr size_t WS_WGU = 4 * MiB;
constexpr size_t WGU_ELEMS = (size_t)2 * FF * DM;
constexpr size_t WS_WD = 180 * MiB;
constexpr size_t WD_ELEMS = (size_t)DM * FF;
constexpr size_t WS_WIN = 268 * MiB;
constexpr size_t WIN_ELEMS = (size_t)ZW * DM;
constexpr size_t WS_WOUT = 310 * MiB;
constexpr size_t WOUT_ELEMS = (size_t)DM * DM;
constexpr size_t WS_XS = 326 * MiB;
constexpr size_t WS_H = 462 * MiB;
constexpr size_t WS_ACT = 530 * MiB;
constexpr size_t WS_LA = 717 * MiB;
constexpr size_t WS_DQ = 751 * MiB, WS_DK = 768 * MiB, WS_DV = 785 * MiB;
constexpr size_t WS_DBG = 802 * MiB;
constexpr size_t WS_AQ = 804 * MiB;
constexpr size_t WS_AKV = 838 * MiB;
constexpr size_t WS_GLAO = 855 * MiB;
constexpr size_t WS_DNO = 923 * MiB;
constexpr size_t WS_END = 991 * MiB;
constexpr size_t WS_DELTA = WS_GLAO;
constexpr size_t WS_PART = 1060 * MiB;
static_assert(WS_WGU + 4 * WGU_ELEMS * 2 <= WS_WD && WS_WD + 4 * WD_ELEMS * 2 <= WS_WIN && WS_WIN + 2 * WIN_ELEMS * 2 <= WS_WOUT && WS_WOUT + 2 * WOUT_ELEMS * 2 <= WS_XS, "ws map (weights)");
static_assert(WS_XS + (size_t)MROWS * DM * 4 <= WS_H && WS_H + (size_t)MROWS * DM * 2 <= WS_ACT && WS_ACT + (size_t)MROWS * FF * 2 <= WS_LA, "ws map (stream)");
static_assert(WS_LA + (size_t)2 * MROWS * 256 * 4 <= WS_DQ && WS_DQ + (size_t)MROWS * 512 * 2 <= WS_DK && WS_DV + (size_t)MROWS * 512 * 2 <= WS_DBG && WS_DBG + (size_t)4 * MROWS * 4 * 4 <= WS_AQ, "ws map (mixer 1)");
static_assert(WS_AQ + (size_t)MROWS * 1024 * 2 <= WS_AKV && WS_AKV + (size_t)MROWS * 512 * 2 <= WS_GLAO && WS_GLAO + (size_t)2 * MROWS * 512 * 4 <= WS_DNO && WS_DNO + (size_t)2 * MROWS * 512 * 4 <= WS_END, "ws map (mixer 2)");

struct Params {
    const float *x, *c, *ctx, *c_ctx, *w_ada, *b_ada, *ln_g, *ln_b, *w_gate, *w_up, *w_down, *w_in, *gla_wa1, *gla_wa2, *gla_ba, *gla_norm_g,
                *dn_conv, *dn_wab, *dn_a_log, *dn_dt_bias, *dn_norm_g, *q_norm_g, *k_norm_g, *w_out;
    float* out; unsigned char* ws;
};

#define GIN(p) ((const float*)(const GAS1 float*)(p))
typedef const __attribute__((address_space(4))) Params* KP;
typedef float f32x2_t __attribute__((ext_vector_type(2)));
typedef __bf16 bf16x2_t __attribute__((ext_vector_type(2)));
DI unsigned pk2(float lo, float hi) { const f32x2_t v = {lo, hi}; const bf16x2_t b = __builtin_convertvector(v, bf16x2_t); return __builtin_bit_cast(unsigned, b); }
DI unsigned f2bf(float f) { return pk2(f, 0.f) & 0xffffu; }
DI float bf2f(unsigned short b) { return __builtin_bit_cast(float, (unsigned)b << 16); }
DI float bflo(unsigned w) { return __builtin_bit_cast(float, w << 16); }
DI float bfhi(unsigned w) { return __builtin_bit_cast(float, w & 0xffff0000u); }
template <int MASK> DI float shx(float v) {
    static_assert(MASK >= 1 && MASK <= 32, "xor mask");
    if constexpr (MASK < 32) return __builtin_bit_cast(float, __builtin_amdgcn_ds_swizzle(__builtin_bit_cast(int, v), 0x1F | (MASK << 10)));
    else { const unsigned u = __builtin_bit_cast(unsigned, v); auto r = __builtin_amdgcn_permlane32_swap(u, u, false, false);
           const unsigned mine = __builtin_bit_cast(unsigned, v); return __builtin_bit_cast(float, r[0] == mine ? r[1] : r[0]); }
}
DI float wave_sum(float v) {
    v += shx<1>(v); v += shx<2>(v); v += shx<4>(v); v += shx<8>(v); v += shx<16>(v);
    return __builtin_bit_cast(float, __builtin_amdgcn_readlane(__builtin_bit_cast(int, v), 0)) + __builtin_bit_cast(float, __builtin_amdgcn_readlane(__builtin_bit_cast(int, v), 32));
    return v;
}
DI float silu_f(float v) { return v * __builtin_amdgcn_rcpf(1.0f + __builtin_amdgcn_exp2f(-1.4426950408889634f * v)); }
DI float log1pexp_neg_abs(float x) { return 0.6931471805599453f * __builtin_amdgcn_logf(1.0f + __builtin_amdgcn_exp2f(-1.4426950408889634f * fabsf(x))); }
DI float softplus_f(float x) { return fmaxf(x, 0.f) + log1pexp_neg_abs(x); }
DI float logsigmoid_f(float x) { return fminf(x, 0.f) - log1pexp_neg_abs(x); }
DI float rsqrt_f(float x) { return __builtin_amdgcn_rsqf(x); }

DI void phase_mod(KP P, char* lds, int bid, int nb, int wv_) {
    const gptr_t ws_ = lptr(P->ws);
    const int tid = ltid(), lane = tid & 63, ks = tid >> 6;
    float* s = (float*)lds;
    float* red = s + 5 * 2048;
    if (bid < 144) {
        for (int i = tid; i < 5 * 2048; i += NTHR) { const int j = i >> 11, k = i & 2047; const float v = j < 4 ? GIN(P->c)[j * 2048 + k] : GIN(P->c_ctx)[k]; s[i] = silu_f(v); }
        __syncthreads();
    }
    float* MOD = (float*)(ws_ + WS_MOD);
    for (int u = bid; u < 144; u += nb) {
        const int l = u / 72, n0 = (u % 72) * 256;
        const float* w = GIN(P->w_ada) + ((size_t)l * 2048 + ks * 256) * NMODV + n0 + 4 * lane;
        f32x4 a[5];
#pragma unroll
        for (int j = 0; j < 5; ++j) a[j] = (f32x4){0.f, 0.f, 0.f, 0.f};
#pragma unroll 1
        for (int k0 = 0; k0 < 256; k0 += 8) {
            f32x4 wv[8];
#pragma unroll
            for (int q = 0; q < 8; ++q) wv[q] = __builtin_nontemporal_load((const f32x4*)(w + (size_t)(k0 + q) * NMODV));
#pragma unroll
            for (int q = 0; q < 8; ++q) { const int kk = ks * 256 + k0 + q;
#pragma unroll
                for (int j = 0; j < 5; ++j) a[j] += wv[q] * s[j * 2048 + kk]; }
        }
#pragma unroll
        for (int j = 0; j < 5; ++j) *(f32x4*)(red + (ks * 5 + j) * 256 + 4 * lane) = a[j];
        __syncthreads();
        if (tid < 320) { const int j = tid >> 6; f32x4 sum = *(const f32x4*)(GIN(P->b_ada) + (size_t)l * NMODV + n0 + 4 * lane);
#pragma unroll
            for (int q = 0; q < 8; ++q) sum += *(const f32x4*)(red + (q * 5 + j) * 256 + 4 * lane);
            *(f32x4*)(MOD + ((size_t)l * 5 + j) * NMODV + n0 + 4 * lane) = sum; }
        __syncthreads();
    }
    if (bid == nb - 1) {
        float* R = (float*)(ws_ + WS_ROPE);
        for (int e = tid; e < 64 * 32; e += NTHR) { const int pos = e >> 5, i = e & 31; const float inv = powf(10000.0f, -(float)(2 * i) / 64.0f); const float ang = (float)pos * inv;
            R[2 * e] = cosf(ang); R[2 * e + 1] = sinf(ang); }
    }
}

struct WTile { const float* src; bf16* dst; int N, K, k0, n0; bool plain; };
DI float win_elem(KP P, int l, int k, int n) {
    if (n < 5120) return GIN(P->w_in)[((size_t)l * DM + k) * 5120 + n];
    if (n < 5136) return GIN(P->gla_wa1)[((size_t)(l * 2 + 0) * DM + k) * 16 + n - 5120];
    if (n < 5152) return GIN(P->gla_wa1)[((size_t)(l * 2 + 1) * DM + k) * 16 + n - 5136];
    if (n < 5160) return GIN(P->dn_wab)[((size_t)(l * 2 + 0) * DM + k) * 8 + n - 5152];
    if (n < 5168) return GIN(P->dn_wab)[((size_t)(l * 2 + 1) * DM + k) * 8 + n - 5160];
    return 0.f;
}
DI void phase_wcvt(KP P, char* lds, int bid, int nb, int wv_) {
    const gptr_t ws_ = lptr(P->ws);
    const int tid = ltid();
    float* scr = (float*)lds;
    constexpr int T_GU = 32 * 88, T_D = 88 * 16, T_IN = 32 * 42, T_OUT = 32 * 16;
    constexpr int NT = 4 * T_GU + 4 * T_D + 2 * T_IN + 2 * T_OUT;
    int lgen = 0;
#define WT_DESC(it, T) do { int r = (it); \
        if (r < 4 * T_GU) { const int m = r / T_GU, tile = r % T_GU, kb = tile / 88, j = tile % 88; \
            T.src = ((j & 1) ? GIN(P->w_up) : GIN(P->w_gate)) + (size_t)m * DM * FF + (size_t)(kb * 64) * FF + (j >> 1) * 128; T.N = FF; T.K = DM; T.k0 = kb * 64; T.n0 = j * 128; \
            T.dst = (bf16*)(ws_ + WS_WGU) + (size_t)m * WGU_ELEMS; T.plain = true; } \
        else if ((r -= 4 * T_GU) < 4 * T_D) { const int m = r / T_D, tile = r % T_D, kb = tile / 16, j = tile % 16; \
            T.src = GIN(P->w_down) + (size_t)m * FF * DM + (size_t)(kb * 64) * DM + j * 128; T.N = DM; T.K = FF; T.k0 = kb * 64; T.n0 = j * 128; \
            T.dst = (bf16*)(ws_ + WS_WD) + (size_t)m * WD_ELEMS; T.plain = true; } \
        else if ((r -= 4 * T_D) < 2 * T_IN) { const int l = r / T_IN, tile = r % T_IN, kb = tile / 42, j = tile % 42; \
            T.src = GIN(P->w_in) + (size_t)l * DM * 5120 + (size_t)(kb * 64) * 5120 + j * 128; T.N = 5120; T.K = DM; T.k0 = kb * 64; T.n0 = j * 128; \
            T.dst = (bf16*)(ws_ + WS_WIN) + (size_t)l * WIN_ELEMS; T.plain = j < 40; lgen = l; } \
        else { r -= 2 * T_IN; const int l = r / T_OUT, tile = r % T_OUT, kb = tile / 16, j = tile % 16; \
            T.src = GIN(P->w_out) + (size_t)l * DM * DM + (size_t)(kb * 64) * DM + j * 128; T.N = DM; T.K = DM; T.k0 = kb * 64; T.n0 = j * 128; \
            T.dst = (bf16*)(ws_ + WS_WOUT) + (size_t)l * WOUT_ELEMS; T.plain = true; } } while (0)
    WTile cur; f32x4 pre[4];
    int it = bid;
    if (it < NT) { WT_DESC(it, cur);
        if (cur.plain) {
#pragma unroll
            for (int i = 0; i < 4; ++i) { const int q = tid + 512 * i; pre[i] = __builtin_nontemporal_load((const f32x4*)(cur.src + (size_t)(q >> 5) * cur.N + (q & 31) * 4)); } } }
    for (; it < NT; it += nb) {
        const int lg = lgen;
        if (cur.plain) {
#pragma unroll
            for (int i = 0; i < 4; ++i) { const int q = tid + 512 * i; *(f32x4*)(scr + (q >> 5) * 132 + (q & 31) * 4) = pre[i]; }
        } else {
#pragma unroll 4
            for (int i = 0; i < 16; ++i) { const int kk = i * 4 + (tid >> 7), nn = tid & 127; scr[kk * 132 + nn] = win_elem(P, lg, cur.k0 + kk, cur.n0 + nn); }
        }
        const WTile done = cur;
        if (it + nb < NT) { WT_DESC(it + nb, cur);
            if (cur.plain) {
#pragma unroll
                for (int i = 0; i < 4; ++i) { const int q = tid + 512 * i; pre[i] = __builtin_nontemporal_load((const f32x4*)(cur.src + (size_t)(q >> 5) * cur.N + (q & 31) * 4)); } } }
        __syncthreads();
#pragma unroll
        for (int i = 0; i < 2; ++i) { const int q = tid + 512 * i, nn = q >> 3, kc = q & 7; const float* sp = scr + (kc * 8) * 132 + nn;
            u32x4 o; o.x = pk2(sp[0], sp[132]); o.y = pk2(sp[2 * 132], sp[3 * 132]); o.z = pk2(sp[4 * 132], sp[5 * 132]); o.w = pk2(sp[6 * 132], sp[7 * 132]);
            *(u32x4*)(done.dst + (size_t)(done.n0 + nn) * done.K + done.k0 + kc * 8) = o; }
        __syncthreads();
    }
#undef WT_DESC
}


DI void phase_init(KP P, char* lds, int bid, int wv_) {
    const gptr_t ws_ = lptr(P->ws);
    const int lane = ltid() & 63, wave = ltid() >> 6;
    _Float16* XS = (_Float16*)(ws_ + WS_XS); bf16* H = (bf16*)(ws_ + WS_H); const float* MOD = (const float*)(ws_ + WS_MOD);
    float* L = (float*)lds;
    { const int tid = ltid(); f32x4 sv[10];
#pragma unroll
      for (int m = 0; m < 5; ++m) { const float* sh = MOD + (size_t)m * NMODV; sv[2 * m] = *(const f32x4*)(sh + 4 * tid); sv[2 * m + 1] = *(const f32x4*)(sh + DM + 4 * tid); }
#pragma unroll
      for (int m = 0; m < 10; ++m) *(f32x4*)(L + m * DM + 4 * tid) = sv[m]; }
    __syncthreads();
    auto put = [&](const f32x4 (&v)[8], size_t r, int mi) {
#pragma unroll
        for (int j = 0; j < 8; ++j) __builtin_nontemporal_store(__builtin_convertvector(v[j] * DN_ALPHA, h16x4), (h16x4*)(XS + r * DM + 4 * lane + 256 * j));
        const float* sh = L + 2 * mi * DM + 4 * lane; const float* sc = sh + DM;
#pragma unroll
        for (int j = 0; j < 8; ++j) { const f32x4 a = *(const f32x4*)(sh + 256 * j), c = *(const f32x4*)(sc + 256 * j);
            const f32x4 h = v[j] * (c + 1.0f) + a; u32x2 w; w.x = pk2(h.x, h.y); w.y = pk2(h.z, h.w);
            *(u32x2*)(H + r * DM + 4 * lane + 256 * j) = w; }
    };
    auto fetch = [&](int k, f32x4 (&v)[8]) { const int q = k * 2048 + bid * NWAVE + wave; const float* s = GIN(P->x) + (size_t)q * DM + 4 * lane;
#pragma unroll
        for (int j = 0; j < 8; ++j) v[j] = __builtin_nontemporal_load((const f32x4*)(s + 256 * j)); };
    auto rowof = [&](int k) -> size_t { const int q = k * 2048 + bid * NWAVE + wave; return (size_t)(q >> 12) * TT + CTXL + (q & 4095); };
    f32x4 va[8], vb[8];
    fetch(0, va);
#pragma unroll
    for (int k = 0; k < 8; k += 2) {
        fetch(k + 1, vb);
        put(va, rowof(k), k >> 1);
        if (k + 2 < 8) fetch(k + 2, va);
        put(vb, rowof(k + 1), k >> 1);
    }
    if (wave < 4) { const int c = bid * 4 + wave; const float* s = GIN(P->ctx) + (size_t)c * DM + 4 * lane;
#pragma unroll
        for (int j = 0; j < 8; ++j) va[j] = __builtin_nontemporal_load((const f32x4*)(s + 256 * j));
        put(va, (size_t)(c >> 8) * TT + (c & 255), 4); }
}

template <bool FINAL> DI void phase_ln(KP P, char* lds, int l_ln, int which, int l_mod, int shift_idx, bool skip_ctx, int nparts, int bid, int wv_) {
    const gptr_t ws_ = lptr(P->ws);
    const int lane = ltid() & 63, wave = ltid() >> 6;
    _Float16* XS = (_Float16*)(ws_ + WS_XS); bf16* H = (bf16*)(ws_ + WS_H); const float* MOD = (const float*)(ws_ + WS_MOD);
    const bf16* DEL = (const bf16*)(ws_ + WS_DELTA);
    float* L = (float*)lds;
    { const int tid = ltid();
      const float* g = GIN(P->ln_g) + (size_t)(l_ln * 3 + which) * DM; const float* bb = GIN(P->ln_b) + (size_t)(l_ln * 3 + which) * DM;
      constexpr int NV = FINAL ? 2 : 12; f32x4 sv[NV];
      sv[0] = *(const f32x4*)(g + 4 * tid); sv[1] = *(const f32x4*)(bb + 4 * tid);
      if constexpr (!FINAL) {
#pragma unroll
          for (int m = 0; m < 5; ++m) { const float* sh = MOD + ((size_t)l_mod * 5 + m) * NMODV + (size_t)shift_idx * DM;
              sv[2 + 2 * m] = *(const f32x4*)(sh + 4 * tid); sv[3 + 2 * m] = *(const f32x4*)(sh + DM + 4 * tid); } }
#pragma unroll
      for (int m = 0; m < NV; ++m) *(f32x4*)(L + m * DM + 4 * tid) = sv[m]; }
    auto finish = [&](f32x4 (&v)[8], size_t r, int mi, int b, int t) {
        float s = 0.f;
#pragma unroll
        for (int j = 0; j < 8; ++j) s += (v[j].x + v[j].y) + (v[j].z + v[j].w);
        const float mean = wave_sum(s) * (1.0f / DM); float s2 = 0.f;
#pragma unroll
        for (int j = 0; j < 8; ++j) { v[j] = v[j] - mean; s2 += (v[j].x * v[j].x + v[j].y * v[j].y) + (v[j].z * v[j].z + v[j].w * v[j].w); }
        const float rstd = rsqrt_f(wave_sum(s2) * (1.0f / DM) + LN_EPS);
#pragma unroll
        for (int j = 0; j < 8; ++j) { const f32x4 gg = *(const f32x4*)(L + 4 * lane + 256 * j), bv = *(const f32x4*)(L + DM + 4 * lane + 256 * j); v[j] = v[j] * rstd * gg + bv; }
        if constexpr (FINAL) { float* o = P->out + ((size_t)b * SEQL + (t - CTXL)) * DM + 4 * lane;
#pragma unroll
            for (int j = 0; j < 8; ++j) __builtin_nontemporal_store(v[j], (f32x4*)(o + 256 * j));
            return; }
#pragma unroll
        for (int j = 0; j < 8; ++j) __builtin_nontemporal_store(__builtin_convertvector(v[j] * DN_ALPHA, h16x4), (h16x4*)(XS + r * DM + 4 * lane + 256 * j));
        if constexpr (!FINAL) {
            const float* sh = L + (2 + 2 * mi) * DM + 4 * lane; const float* sc = sh + DM;
#pragma unroll
            for (int j = 0; j < 8; ++j) { const f32x4 a = *(const f32x4*)(sh + 256 * j), c = *(const f32x4*)(sc + 256 * j);
                const f32x4 h = v[j] * (c + 1.0f) + a; u32x2 w; w.x = pk2(h.x, h.y); w.y = pk2(h.z, h.w);
                *(u32x2*)(H + r * DM + 4 * lane + 256 * j) = w; }
        }
    };
    h16x4 xa[8], xb[8]; u32x2 da[8], db[8];
    auto rowof = [&](int k) -> size_t { const int q = k * 2048 + bid * NWAVE + wave; return (size_t)(q >> 12) * TT + CTXL + (q & 4095); };
    auto prefetch = [&](int k, h16x4 (&xr)[8], u32x2 (&dr)[8]) { const size_t r = rowof(k);
#pragma unroll
        for (int j = 0; j < 8; ++j) { xr[j] = __builtin_nontemporal_load((const h16x4*)(XS + r * DM + 4 * lane + 256 * j)); dr[j] = *(const u32x2*)(DEL + r * DM + 4 * lane + 256 * j); } };
    auto consume = [&](f32x4 (&v)[8], const h16x4 (&xr)[8], const u32x2 (&dr)[8]) {
#pragma unroll
        for (int j = 0; j < 8; ++j) v[j] = __builtin_convertvector(xr[j], f32x4) + (f32x4){bflo(dr[j].x), bfhi(dr[j].x), bflo(dr[j].y), bfhi(dr[j].y)}; };
    auto fin_lat = [&](f32x4 (&v)[8], int k) { const int q = k * 2048 + bid * NWAVE + wave; const int b = q >> 12, t = CTXL + (q & 4095); finish(v, (size_t)b * TT + t, b, b, t); };
    prefetch(0, xa, da); prefetch(1, xb, db);
    __syncthreads();
    if (!(FINAL || skip_ctx) && wave < 4) {
        const int c = bid * 4 + wave, b = c >> 8, t = c & 255; const size_t r = (size_t)b * TT + t;
        f32x4 v[8]; h16x4 xc[8];
#pragma unroll
        for (int j = 0; j < 8; ++j) xc[j] = __builtin_nontemporal_load((const h16x4*)(XS + r * DM + 4 * lane + 256 * j));
        if (nparts == 0) { u32x2 w[8];
#pragma unroll
            for (int j = 0; j < 8; ++j) w[j] = *(const u32x2*)(DEL + r * DM + 4 * lane + 256 * j);
#pragma unroll
            for (int j = 0; j < 8; ++j) v[j] = __builtin_convertvector(xc[j], f32x4) + (f32x4){bflo(w[j].x), bfhi(w[j].x), bflo(w[j].y), bfhi(w[j].y)};
        } else {
            const bf16* ps = (const bf16*)(ws_ + WS_PART) + (size_t)c * DM + 4 * lane;
#pragma unroll
            for (int p0 = 0; p0 < 8; p0 += 4) { u32x2 w[4][8];
#pragma unroll
                for (int p = 0; p < 4; ++p)
#pragma unroll
                    for (int j = 0; j < 8; ++j) w[p][j] = *(const u32x2*)(ps + (size_t)(p0 + p) * 1024 * DM + 256 * j);
                if (p0 == 0) {
#pragma unroll
                    for (int j = 0; j < 8; ++j) v[j] = __builtin_convertvector(xc[j], f32x4); }
#pragma unroll
                for (int p = 0; p < 4; ++p)
#pragma unroll
                    for (int j = 0; j < 8; ++j) v[j] += (f32x4){bflo(w[p][j].x), bfhi(w[p][j].x), bflo(w[p][j].y), bfhi(w[p][j].y)}; } }
        finish(v, r, 4, b, t);
    }
    f32x4 v[8];
    consume(v, xa, da);
#pragma unroll 1
    for (int k = 0; k < 6; k += 2) {
        prefetch(k + 2, xa, da);
        fin_lat(v, k);
        consume(v, xb, db);
        prefetch(k + 3, xb, db);
        fin_lat(v, k + 1);
        consume(v, xa, da);
    }
    fin_lat(v, 6);
    consume(v, xb, db);
    fin_lat(v, 7);
}

DI void phase_prep(KP P, int l, int bid, int nb, int wv_) {
    const gptr_t ws_ = lptr(P->ws);
    const int lane = ltid() & 63, wave = ltid() >> 6;
    const bf16* __restrict__ Z = (const bf16*)(ws_ + WS_ACT);
    float* __restrict__ LA = (float*)(ws_ + WS_LA); bf16* __restrict__ DQ = (bf16*)(ws_ + WS_DQ); bf16* __restrict__ DK = (bf16*)(ws_ + WS_DK); bf16* __restrict__ DV = (bf16*)(ws_ + WS_DV);
    float* __restrict__ DBETA = (float*)(ws_ + WS_DBG); float* __restrict__ DG = DBETA + (size_t)2 * MROWS * 4;
    bf16* __restrict__ AQ = (bf16*)(ws_ + WS_AQ); bf16* __restrict__ AKV = (bf16*)(ws_ + WS_AKV); const float* __restrict__ ROPE = (const float*)(ws_ + WS_ROPE);
    const int rbeg = bid * NWAVE + wave, rstep = nb * NWAVE;
#pragma unroll 1
    for (int d = 0; d < 2; ++d) {
        f32x4 w2r[16];
        const float* w2 = GIN(P->gla_wa2) + (size_t)(l * 2 + d) * 16 * 256 + 4 * lane;
#pragma unroll
        for (int e = 0; e < 16; ++e) w2r[e] = *(const f32x4*)(w2 + e * 256);
        const f32x4 bar = *(const f32x4*)(GIN(P->gla_ba) + (size_t)(l * 2 + d) * 256 + 4 * lane);
#pragma unroll 2
        for (int r = rbeg; ; r += rstep) { if (r >= MROWS) break;
            const bf16* z = Z + (size_t)r * ZW + ZWA1 + 16 * d;
            const u32x4 za = *(const u32x4*)z, zb = *(const u32x4*)(z + 8);
            const float z1[16] = {bflo(za.x), bfhi(za.x), bflo(za.y), bfhi(za.y), bflo(za.z), bfhi(za.z), bflo(za.w), bfhi(za.w),
                                  bflo(zb.x), bfhi(zb.x), bflo(zb.y), bfhi(zb.y), bflo(zb.z), bfhi(zb.z), bflo(zb.w), bfhi(zb.w)};
            f32x4 acc = bar;
#pragma unroll
            for (int e = 0; e < 16; ++e) acc += w2r[e] * z1[e];
            f32x4 o; o.x = logsigmoid_f(acc.x) * 0.0625f; o.y = logsigmoid_f(acc.y) * 0.0625f; o.z = logsigmoid_f(acc.z) * 0.0625f; o.w = logsigmoid_f(acc.w) * 0.0625f;
            *(f32x4*)(LA + ((size_t)d * MROWS + r) * 256 + 4 * lane) = o;
        }
    }
    {
        float cw[3][3][8];
#pragma unroll
        for (int part = 0; part < 3; ++part)
#pragma unroll
            for (int tap = 0; tap < 3; ++tap) { const float* cp = GIN(P->dn_conv) + (size_t)l * 3 * 1536 + tap * 1536 + part * 512 + lane * 8;
                const f32x4 c0 = *(const f32x4*)cp, c1 = *(const f32x4*)(cp + 4);
                cw[part][tap][0] = c0.x; cw[part][tap][1] = c0.y; cw[part][tap][2] = c0.z; cw[part][tap][3] = c0.w; cw[part][tap][4] = c1.x; cw[part][tap][5] = c1.y; cw[part][tap][6] = c1.z; cw[part][tap][7] = c1.w; }
        const float nal = lane < 8 ? -__expf(GIN(P->dn_a_log)[(l * 2 + (lane >> 2)) * 4 + (lane & 3)]) : 0.f, dtb = lane < 8 ? GIN(P->dn_dt_bias)[(l * 2 + (lane >> 2)) * 4 + (lane & 3)] : 0.f;
#pragma unroll 2
        for (int r = rbeg; ; r += rstep) { if (r >= MROWS) break;
            const int t = r % TT; const bool isctx = t < CTXL;
            const bf16* z = Z + (size_t)r * ZW;
            const bool has_prev = isctx ? (t > 0) : (t > CTXL), has_next = isctx ? (t < CTXL - 1) : (t < TT - 1);
            u32x4 zc[3], zp[3], zn[3];
#pragma unroll
            for (int part = 0; part < 3; ++part) { const int ch = part * 512 + lane * 8;
                zc[part] = *(const u32x4*)(z + ZDQ + ch); zp[part] = (u32x4){0u, 0u, 0u, 0u}; zn[part] = (u32x4){0u, 0u, 0u, 0u};
                if (has_prev) zp[part] = *(const u32x4*)(z - ZW + ZDQ + ch);
                if (has_next) zn[part] = *(const u32x4*)(z + ZW + ZDQ + ch); }
            unsigned short zab = 0; if (lane < 8) zab = z[ZWAB + 8 * (lane >> 2) + (lane & 3)];
            unsigned short zbb = 0; if (lane < 8) zbb = z[ZWAB + 8 * (lane >> 2) + 4 + (lane & 3)];
#pragma unroll
            for (int part = 0; part < 3; ++part) {
                float v[8]; float ss = 0.f;
#pragma unroll
                for (int e = 0; e < 4; ++e) {
                    const unsigned wp = e == 0 ? zp[part].x : e == 1 ? zp[part].y : e == 2 ? zp[part].z : zp[part].w, wc = e == 0 ? zc[part].x : e == 1 ? zc[part].y : e == 2 ? zc[part].z : zc[part].w,
                                   wn = e == 0 ? zn[part].x : e == 1 ? zn[part].y : e == 2 ? zn[part].z : zn[part].w;
                    const float a0 = bflo(wp) * cw[part][0][2 * e] + bflo(wc) * cw[part][1][2 * e] + bflo(wn) * cw[part][2][2 * e];
                    const float a1 = bfhi(wp) * cw[part][0][2 * e + 1] + bfhi(wc) * cw[part][1][2 * e + 1] + bfhi(wn) * cw[part][2][2 * e + 1];
                    v[2 * e] = silu_f(a0); v[2 * e + 1] = silu_f(a1); ss += v[2 * e] * v[2 * e] + v[2 * e + 1] * v[2 * e + 1];
                }
                float scale = 1.f;
                if (part < 2) { ss += shx<1>(ss); ss += shx<2>(ss); ss += shx<4>(ss); ss += shx<8>(ss);
                    scale = rsqrt_f(ss + LN_EPS); if (part == 0) scale *= 0.08838834764831845f; }
                u32x4 o; o.x = pk2(v[0] * scale, v[1] * scale); o.y = pk2(v[2] * scale, v[3] * scale); o.z = pk2(v[4] * scale, v[5] * scale); o.w = pk2(v[6] * scale, v[7] * scale);
                bf16* dst = part == 0 ? DQ : part == 1 ? DK : DV;
                *(u32x4*)(dst + (size_t)r * 512 + lane * 8) = o;
            }
            if (lane < 8) { const int d = lane >> 2, hh = lane & 3;
                const float g = nal * softplus_f(bf2f(zab) + dtb);
                const float beta = 1.0f / (1.0f + __expf(-bf2f(zbb)));
                DG[((size_t)d * MROWS + r) * 4 + hh] = g; DBETA[((size_t)d * MROWS + r) * 4 + hh] = beta; }
        }
    }
    {
        const int l8 = lane & 7, quarter = l8 >> 1, i0 = (l8 & 1) * 16;
        const int l32 = lane & 31, kq = l32 >> 3, ki0 = (l32 & 7) * 4;
        float gq[16], gk[4];
#pragma unroll
        for (int e = 0; e < 16; ++e) gq[e] = GIN(P->q_norm_g)[(size_t)l * 128 + l8 * 16 + e];
#pragma unroll
        for (int e = 0; e < 4; ++e) gk[e] = GIN(P->k_norm_g)[(size_t)l * 128 + l32 * 4 + e];
#pragma unroll 2
        for (int r = rbeg; ; r += rstep) { if (r >= MROWS) break;
            const int t = r % TT; const bool isctx = t < CTXL;
            const bf16* z = Z + (size_t)r * ZW;
            const int lt = t - CTXL, prow = lt >> 6, pcol = lt & 63;
            const u32x4 qa = *(const u32x4*)(z + ZAQ + lane * 16), qb = *(const u32x4*)(z + ZAQ + lane * 16 + 8);
            const u32x2 ka = *(const u32x2*)(z + ZAK + lane * 4), va = *(const u32x2*)(z + ZAV + lane * 4);
            float v[16] = {bflo(qa.x), bfhi(qa.x), bflo(qa.y), bfhi(qa.y), bflo(qa.z), bfhi(qa.z), bflo(qa.w), bfhi(qa.w),
                           bflo(qb.x), bfhi(qb.x), bflo(qb.y), bfhi(qb.y), bflo(qb.z), bfhi(qb.z), bflo(qb.w), bfhi(qb.w)};
            float ss = 0.f;
#pragma unroll
            for (int e = 0; e < 16; ++e) ss += v[e] * v[e];
            ss += shx<1>(ss); ss += shx<2>(ss); ss += shx<4>(ss);
            const float rs = rsqrt_f(ss * (1.0f / 128.0f) + LN_EPS);
#pragma unroll
            for (int e = 0; e < 16; ++e) v[e] = v[e] * rs * gq[e];
            const int pos = quarter < 2 ? prow : pcol; const float* rp = ROPE + ((size_t)(isctx ? 0 : pos) * 32 + i0) * 2;
            unsigned ow[8];
#pragma unroll
            for (int e = 0; e < 16; e += 2) {
                const float p0 = shx<2>(v[e]), p1 = shx<2>(v[e + 1]);
                float o0 = v[e], o1 = v[e + 1];
                if (!isctx) { const float c0 = rp[2 * e], s0 = rp[2 * e + 1], c1 = rp[2 * e + 2], s1 = rp[2 * e + 3];
                    if ((quarter & 1) == 0) { o0 = v[e] * c0 - p0 * s0; o1 = v[e + 1] * c1 - p1 * s1; } else { o0 = v[e] * c0 + p0 * s0; o1 = v[e + 1] * c1 + p1 * s1; } }
                ow[e >> 1] = pk2(o0, o1);
            }
            u32x4 o0 = {ow[0], ow[1], ow[2], ow[3]}, o1 = {ow[4], ow[5], ow[6], ow[7]};
            *(u32x4*)(AQ + (size_t)r * 1024 + lane * 16) = o0; *(u32x4*)(AQ + (size_t)r * 1024 + lane * 16 + 8) = o1;
            float kv[4] = {bflo(ka.x), bfhi(ka.x), bflo(ka.y), bfhi(ka.y)};
            float ks = kv[0] * kv[0] + kv[1] * kv[1] + kv[2] * kv[2] + kv[3] * kv[3];
            ks += shx<1>(ks); ks += shx<2>(ks); ks += shx<4>(ks); ks += shx<8>(ks); ks += shx<16>(ks);
            const float krs = rsqrt_f(ks * (1.0f / 128.0f) + LN_EPS);
#pragma unroll
            for (int e = 0; e < 4; ++e) kv[e] = kv[e] * krs * gk[e];
            const int kpos = kq < 2 ? prow : pcol; const float* krp = ROPE + ((size_t)(isctx ? 0 : kpos) * 32 + ki0) * 2;
            float ko[4];
#pragma unroll
            for (int e = 0; e < 4; ++e) { const float pp = shx<8>(kv[e]); ko[e] = kv[e];
                if (!isctx) { const float cc = krp[2 * e], sn = krp[2 * e + 1]; ko[e] = (kq & 1) == 0 ? kv[e] * cc - pp * sn : kv[e] * cc + pp * sn; } }
            u32x2 kw; kw.x = pk2(ko[0], ko[1]); kw.y = pk2(ko[2], ko[3]);
            *(u32x2*)(AKV + (size_t)r * 512 + lane * 4) = kw;
            *(u32x2*)(AKV + (size_t)r * 512 + 256 + lane * 4) = va;
        }
    }
}

DI int scan_tok(int dir, int p) { return dir == 0 ? p : (p < CTXL ? CTXL - 1 - p : TT + CTXL - 1 - p); }

typedef short bf16x8v __attribute__((ext_vector_type(8)));
typedef short v4i16_t __attribute__((ext_vector_type(4)));
#define LDSP __attribute__((address_space(3)))
#define MFMA16(a, b, c) __builtin_amdgcn_mfma_f32_16x16x32_bf16((a), (b), (c), 0, 0, 0)
DI bf16x8v ld_row(const LDSP char* tile, int stride, int row0, int col0, int lane) {
    return *(const LDSP bf16x8v*)(tile + (row0 + (lane & 15)) * stride + (col0 + 8 * (lane >> 4)) * 2);
}
DI bf16x8v ld_tr(const LDSP char* tile, int stride, int k0, int n0, int lane) {
    const int g = lane >> 4, i = lane & 15;
    const LDSP char* a = tile + (k0 + 8 * g + (i >> 2)) * stride + (n0 + 4 * (i & 3)) * 2;
    const v4i16_t lo = __builtin_amdgcn_ds_read_tr16_b64_v4i16((LDSP v4i16_t*)a);
    const v4i16_t hi = __builtin_amdgcn_ds_read_tr16_b64_v4i16((LDSP v4i16_t*)(a + 4 * stride));
    return (bf16x8v){lo[0], lo[1], lo[2], lo[3], hi[0], hi[1], hi[2], hi[3]};
}
constexpr int NCHUNK = TT / 64;
constexpr int GL_VS = 272, GL_DS = 144;
DI int chunk_of(int dir, int j) { return dir == 0 ? j : (j < 4 ? 3 - j : 71 - j); }
constexpr size_t WS_GKV = WS_GLAO;
constexpr size_t WS_GST = 991 * MiB;
constexpr size_t WS_GDEC = 1025 * MiB;
constexpr size_t WS_GOS = 1026 * MiB;
constexpr size_t WS_END2 = 1124 * MiB;


DI void phase_gla_local(KP P, char* lds_, int bid, int nb, int wv_) {
    const gptr_t ws_ = lptr(P->ws);
    const int tid = ltid(), lane = tid & 63, wave = tid >> 6;
    LDSP char* L = (LDSP char*)lds_;
    LDSP char* Vt = L;
    LDSP char* KE = L + 64 * GL_VS;
    LDSP float* tot = (LDSP float*)(L + 64 * GL_VS + 2 * 64 * GL_DS);
    const bf16* Z = (const bf16*)(ws_ + WS_ACT); const float* LA = (const float*)(ws_ + WS_LA);
    float* KVT = (float*)(ws_ + WS_GKV); float* DEC = (float*)(ws_ + WS_GDEC);
    for (int u = bid; u < NBATCH * 4 * NCHUNK; u += nb) {
        const int j = u % NCHUNK, h = (u / NCHUNK) & 3, b = u / (4 * NCHUNK);
        const size_t row0 = (size_t)b * TT + (size_t)j * 64;
        const int dir = tid >> 8, qt = (tid >> 6) & 3, d = tid & 63;
        u32x4 vreg[2]; unsigned short kraw[16]; float lar[16];
#pragma unroll
        for (int i = 0; i < 2; ++i) { const int q = tid + 512 * i, t = q >> 4, ch = q & 15; vreg[i] = *(const u32x4*)(Z + (row0 + t) * ZW + ZGV + h * 128 + ch * 8); }
#pragma unroll
        for (int tt = 0; tt < 16; ++tt) { const int i = 16 * qt + tt, t = dir ? 63 - i : i; kraw[tt] = Z[(row0 + t) * ZW + ZGK + h * 64 + d]; lar[tt] = LA[((size_t)dir * MROWS + row0 + t) * 256 + h * 64 + d]; }
        __builtin_amdgcn_sched_barrier(0);
#pragma unroll
        for (int i = 0; i < 2; ++i) { const int q = tid + 512 * i, t = q >> 4, ch = q & 15; *(LDSP u32x4*)(Vt + t * GL_VS + ch * 16) = vreg[i]; }
        float c[16], offs = 0.f, blast = 0.f;
        { float sacc = 0.f;
#pragma unroll
          for (int tt = 0; tt < 16; ++tt) { sacc += lar[tt]; c[tt] = sacc; }
          tot[(dir * 4 + qt) * 64 + d] = sacc;
          __syncthreads();
#pragma unroll
          for (int q2 = 0; q2 < 4; ++q2) { const float v = tot[(dir * 4 + q2) * 64 + d]; if (q2 < qt) offs += v; blast += v; } }
#pragma unroll
        for (int tt = 0; tt < 16; ++tt) { const int i = 16 * qt + tt, t = dir ? 63 - i : i;
            *(LDSP unsigned short*)(KE + (dir * 64 + t) * GL_DS + d * 2) = (unsigned short)f2bf(bf2f(kraw[tt]) * __expf(blast - (offs + c[tt]))); }
        const int n = chunk_of(dir, j); const size_t cidx = ((size_t)((b * 4 + h) * 2 + dir)) * NCHUNK + n;
        if (qt == 0) DEC[cidx * 64 + d] = __expf(blast);
        __syncthreads();
        const int wd = wave >> 2;
        f32x4 acc[2][4];
#pragma unroll
        for (int a = 0; a < 2; ++a)
#pragma unroll
            for (int n4 = 0; n4 < 4; ++n4) acc[a][n4] = (f32x4){0.f, 0.f, 0.f, 0.f};
#pragma unroll
        for (int s = 0; s < 2; ++s) {
            bf16x8v af[2], bfr[4];
#pragma unroll
            for (int a = 0; a < 2; ++a) af[a] = ld_tr(Vt, GL_VS, 32 * s, 16 * ((wave & 3) * 2 + a), lane);
#pragma unroll
            for (int n4 = 0; n4 < 4; ++n4) bfr[n4] = ld_tr(KE + wd * 64 * GL_DS, GL_DS, 32 * s, 16 * n4, lane);
#pragma unroll
            for (int a = 0; a < 2; ++a)
#pragma unroll
                for (int n4 = 0; n4 < 4; ++n4) acc[a][n4] = MFMA16(af[a], bfr[n4], acc[a][n4]);
        }
        const size_t cw = ((size_t)((b * 4 + h) * 2 + wd)) * NCHUNK + chunk_of(wd, j);
        float* out = KVT + cw * 8192;
#pragma unroll
        for (int a = 0; a < 2; ++a)
#pragma unroll
            for (int n4 = 0; n4 < 4; ++n4)
#pragma unroll
                for (int r = 0; r < 4; ++r) out[(size_t)(16 * ((wave & 3) * 2 + a) + 4 * (lane >> 4) + r) * 64 + 16 * n4 + (lane & 15)] = acc[a][n4][r];
        __syncthreads();
    }
}

DI void phase_gla_scan(KP P, int bid, int nb, int wv_) {
    const gptr_t ws_ = lptr(P->ws);
    const int tid = ltid();
    const float* KVT = (const float*)(ws_ + WS_GKV); const float* DEC = (const float*)(ws_ + WS_GDEC); bf16* ST = (bf16*)(ws_ + WS_GST);
    const int nitem = ((32 * 16 - bid + nb - 1) / nb) * 4;
    float ka[17], da[17], kb[17], db[17];
    auto issue = [&](int it, float (&kv)[17], float (&dc)[17]) { const int u = bid + (it >> 2) * nb, n0 = (it & 3) * 17; const int sc = u >> 4, e = (u & 15) * 512 + tid, d = e & 63;
        const float* kvp = KVT + (size_t)sc * NCHUNK * 8192 + e; const float* dcp = DEC + (size_t)sc * NCHUNK * 64 + d;
#pragma unroll
        for (int q = 0; q < 17; ++q) { kv[q] = kvp[(size_t)(n0 + q) * 8192]; dc[q] = dcp[(n0 + q) * 64]; } };
    float S = 0.f;
    auto run = [&](int it, const float (&kv)[17], const float (&dc)[17]) { const int u = bid + (it >> 2) * nb, n0 = (it & 3) * 17; const int sc = u >> 4, e = (u & 15) * 512 + tid;
        bf16* st = ST + (size_t)sc * NCHUNK * 8192 + e;
        if ((it & 3) == 0) S = 0.f;
#pragma unroll
        for (int q = 0; q < 17; ++q) { st[(size_t)(n0 + q) * 8192] = (bf16)f2bf(S); S = S * dc[q] + kv[q]; } };
    if (nitem <= 0) return;
    issue(0, ka, da);
#pragma unroll 1
    for (int it = 0; it < nitem; it += 2) {
        issue(it + 1, kb, db);
        run(it, ka, da);
        if (it + 2 < nitem) issue(it + 2, ka, da);
        run(it + 1, kb, db);
    }
}

DI void gla_out_unit(KP P, char* lds_, int u, int l, int wv_) {
    const gptr_t ws_ = lptr(P->ws);
    const int tid = ltid(), lane = tid & 63, wave = tid >> 6;
    LDSP char* L = (LDSP char*)lds_;
    LDSP char* Vt = L;
    LDSP char* QI = Vt + 64 * GL_VS;
    LDSP char* KI = QI + 2 * 64 * GL_DS;
    LDSP char* STt = KI + 2 * 64 * GL_DS;
    LDSP char* PT = STt + 2 * 128 * GL_DS;
    LDSP float* tot = (LDSP float*)(PT + 2 * 64 * GL_DS);
    LDSP float* nred = tot + 512;
    const bf16* Z = (const bf16*)(ws_ + WS_ACT); const float* LA = (const float*)(ws_ + WS_LA);
    const bf16* ST = (const bf16*)(ws_ + WS_GST); bf16* MIX = (bf16*)(ws_ + WS_H);
    {
        const int j = u % NCHUNK, h = (u / NCHUNK) & 3, b = u / (4 * NCHUNK);
        const size_t row0 = (size_t)b * TT + (size_t)j * 64;
        const int dir = tid >> 8, qt = (tid >> 6) & 3, d = tid & 63;
        u32x4 vreg[2], streg[4]; float lar[16]; unsigned short qraw[16], kraw[16];
#pragma unroll
        for (int i = 0; i < 2; ++i) { const int q = tid + 512 * i, t = q >> 4, ch = q & 15; vreg[i] = *(const u32x4*)(Z + (row0 + t) * ZW + ZGV + h * 128 + ch * 8); }
#pragma unroll
        for (int i = 0; i < 4; ++i) { const int q = tid + 512 * i, dd = q >> 10, rem = q & 1023, v = rem >> 3, ch = rem & 7;
            const size_t cidx = ((size_t)((b * 4 + h) * 2 + dd)) * NCHUNK + chunk_of(dd, j);
            streg[i] = *(const u32x4*)(ST + cidx * 8192 + v * 64 + ch * 8); }
#pragma unroll
        for (int tt = 0; tt < 16; ++tt) { const int i = 16 * qt + tt, t = dir ? 63 - i : i;
            lar[tt] = LA[((size_t)dir * MROWS + row0 + t) * 256 + h * 64 + d];
            qraw[tt] = Z[(row0 + t) * ZW + ZGQ + h * 64 + d]; kraw[tt] = Z[(row0 + t) * ZW + ZGK + h * 64 + d]; }
        unsigned short gtr[4][4]; float gnr[4];
#pragma unroll
        for (int n4 = 0; n4 < 4; ++n4) { const int v = 16 * ((wave >> 2) * 4 + n4) + (lane & 15); gnr[n4] = GIN(P->gla_norm_g)[(size_t)l * 128 + v];
#pragma unroll
            for (int r = 0; r < 4; ++r) gtr[n4][r] = Z[(row0 + 16 * (wave & 3) + 4 * (lane >> 4) + r) * ZW + ZGR + h * 128 + v]; }
        __builtin_amdgcn_sched_barrier(0);
#pragma unroll
        for (int i = 0; i < 2; ++i) { const int q = tid + 512 * i, t = q >> 4, ch = q & 15; *(LDSP u32x4*)(Vt + t * GL_VS + ch * 16) = vreg[i]; }
#pragma unroll
        for (int i = 0; i < 4; ++i) { const int q = tid + 512 * i, dd = q >> 10, rem = q & 1023, v = rem >> 3, ch = rem & 7; *(LDSP u32x4*)(STt + (dd * 128 + v) * GL_DS + ch * 16) = streg[i]; }
        float c[16], offs = 0.f, blast = 0.f;
        { float sacc = 0.f;
#pragma unroll
          for (int tt = 0; tt < 16; ++tt) { sacc += lar[tt]; c[tt] = sacc; }
          tot[(dir * 4 + qt) * 64 + d] = sacc;
          __syncthreads();
#pragma unroll
          for (int q2 = 0; q2 < 4; ++q2) { const float v = tot[(dir * 4 + q2) * 64 + d]; if (q2 < qt) offs += v; blast += v; } }
#pragma unroll
        for (int tt = 0; tt < 16; ++tt) { const int i = 16 * qt + tt, t = dir ? 63 - i : i; const float bc = offs + c[tt];
            *(LDSP unsigned short*)(QI + (dir * 64 + t) * GL_DS + d * 2) = (unsigned short)f2bf(bf2f(qraw[tt]) * 0.125f * __expf(bc));
            *(LDSP unsigned short*)(KI + (dir * 64 + t) * GL_DS + d * 2) = (unsigned short)f2bf(bf2f(kraw[tt]) * __expf(-bc)); }
        __syncthreads();
        {
            const int wd = wave >> 2, mt = wave & 3, g = lane >> 4, i16 = lane & 15;
            f32x4 pacc[4];
#pragma unroll
            for (int n4 = 0; n4 < 4; ++n4) pacc[n4] = (f32x4){0.f, 0.f, 0.f, 0.f};
#pragma unroll
            for (int s = 0; s < 2; ++s) {
                const bf16x8v af = ld_row(QI + wd * 64 * GL_DS, GL_DS, 16 * mt, 32 * s, lane);
#pragma unroll
                for (int n4 = 0; n4 < 4; ++n4) pacc[n4] = MFMA16(af, ld_row(KI + wd * 64 * GL_DS, GL_DS, 16 * n4, 32 * s, lane), pacc[n4]);
            }
#pragma unroll
            for (int n4 = 0; n4 < 4; ++n4) { const int tp = 16 * n4 + i16; float pv[4];
#pragma unroll
                for (int r = 0; r < 4; ++r) { const int t = 16 * mt + 4 * g + r; const bool keep = wd == 0 ? (tp <= t) : (tp >= t); pv[r] = keep ? pacc[n4][r] : 0.f; }
                u32x2 w; w.x = pk2(pv[0], pv[1]); w.y = pk2(pv[2], pv[3]);
                *(LDSP u32x2*)(PT + (wd * 64 + tp) * GL_DS + (16 * mt + 4 * g) * 2) = w; }
        }
        __syncthreads();
        {
            const int mt = wave & 3, nh = wave >> 2;
            f32x4 oacc[4];
#pragma unroll
            for (int n4 = 0; n4 < 4; ++n4) oacc[n4] = (f32x4){0.f, 0.f, 0.f, 0.f};
#pragma unroll
            for (int dd = 0; dd < 2; ++dd)
#pragma unroll
                for (int s = 0; s < 2; ++s) {
                    const bf16x8v ap = ld_tr(PT + dd * 64 * GL_DS, GL_DS, 32 * s, 16 * mt, lane);
                    const bf16x8v aq = ld_row(QI + dd * 64 * GL_DS, GL_DS, 16 * mt, 32 * s, lane);
#pragma unroll
                    for (int n4 = 0; n4 < 4; ++n4) { const int nt = nh * 4 + n4;
                        oacc[n4] = MFMA16(ap, ld_tr(Vt, GL_VS, 32 * s, 16 * nt, lane), oacc[n4]);
                        oacc[n4] = MFMA16(aq, ld_row(STt + dd * 128 * GL_DS, GL_DS, 16 * nt, 32 * s, lane), oacc[n4]); }
                }
            const int g = lane >> 4, i16 = lane & 15;
            float ps[4];
#pragma unroll
            for (int r = 0; r < 4; ++r) { float q = 0.f;
#pragma unroll
                for (int n4 = 0; n4 < 4; ++n4) q += oacc[n4][r] * oacc[n4][r];
                q += shx<1>(q); q += shx<2>(q); q += shx<4>(q); q += shx<8>(q); ps[r] = q; }
            if (i16 == 0) {
#pragma unroll
                for (int r = 0; r < 4; ++r) nred[nh * 64 + 16 * mt + 4 * g + r] = ps[r]; }
            __syncthreads();
            float rs[4];
#pragma unroll
            for (int r = 0; r < 4; ++r) { const int t = 16 * mt + 4 * g + r; rs[r] = rsqrt_f((nred[t] + nred[64 + t]) * (1.0f / 128.0f) + LN_EPS); }
#pragma unroll
            for (int n4 = 0; n4 < 4; ++n4) { const int v = 16 * (nh * 4 + n4) + i16; const float gn = gnr[n4];
#pragma unroll
                for (int r = 0; r < 4; ++r) { const size_t row = row0 + 16 * mt + 4 * g + r;
                    const float gt = bf2f(gtr[n4][r]);
                    MIX[row * 2048 + h * 128 + v] = (bf16)f2bf(oacc[n4][r] * rs[r] * gn * silu_f(gt)); } }
        }
        __syncthreads();
    }
}


constexpr size_t DN_REC = 41984;
constexpr size_t DO_REC = 0, DO_U = 88 * MiB;
constexpr int RO_W = 0, RO_A = 16384, RO_K = 24576, RO_G = 40960;
constexpr int NDNC = NBATCH * 4 * 2 * NCHUNK;
static_assert(DO_REC + (size_t)NDNC * DN_REC <= DO_U && DO_U + (size_t)NDNC * 16384 <= (size_t)NBATCH * SEQL * DM * 4, "DN chunk buffers fit d_out");
constexpr int DN_TS = 272;
constexpr int DN_AS = 272;
constexpr int DN_PS = 144;
DI unsigned pk2t(float lo, float hi) { return pk2(lo, hi); }

DI void phase_dn_local(KP P, char* lds_, int bid, int nb, int wv_) {
    const gptr_t ws_ = lptr(P->ws);
    const gptr_t dob = lptr((unsigned char*)P->out);
    const int tid = ltid(), lane = tid & 63, wave = tid >> 6, g = lane >> 4, i16 = lane & 15;
    LDSP char* L = (LDSP char*)lds_;
    LDSP char* Kt = L;
    LDSP char* Qt = Kt + 64 * DN_TS;
    LDSP char* Vt = Qt + 64 * DN_TS;
    LDSP char* As = Vt + 64 * DN_TS;
    LDSP char* TB = As + 64 * DN_AS;
    LDSP char* TG = TB + 64 * DN_PS;
    LDSP float* gcl = (LDSP float*)(TG + 64 * DN_PS);
    LDSP float* btl = gcl + 64;
    LDSP char* Ts = (LDSP char*)(btl + 64);
    LDSP char* Xw = Ts + 64 * DN_AS;
    const bf16* DQ = (const bf16*)(ws_ + WS_DQ); const bf16* DK = (const bf16*)(ws_ + WS_DK); const bf16* DV = (const bf16*)(ws_ + WS_DV);
    const float* DBETA = (const float*)(ws_ + WS_DBG); const float* DG = DBETA + (size_t)2 * MROWS * 4;
    for (int u = (bid + 128) & 255; u < NDNC; u += nb) {
        const int dir = u & 1, j = (u >> 1) % NCHUNK, h = ((u >> 1) / NCHUNK) & 3, b = (u >> 1) / (4 * NCHUNK);
        const size_t row0 = (size_t)b * TT + (size_t)j * 64;
        const size_t c = ((size_t)((b * 4 + h) * 2 + dir)) * NCHUNK + chunk_of(dir, j);
        u32x4 tr6[6]; float gs0 = 0.f, bt0 = 0.f;
#pragma unroll
        for (int i = 0; i < 6; ++i) { const int q = tid + 512 * i, which = q >> 10, rem = q & 1023, t = rem >> 4, ch = rem & 15;
            const bf16* src = (which == 0 ? DK : which == 1 ? DQ : DV) + (row0 + t) * 512 + h * 128 + ch * 8;
            tr6[i] = *(const u32x4*)src; }
        if (wave == 0) { const int t = dir ? 63 - lane : lane; gs0 = DG[((size_t)dir * MROWS + row0 + t) * 4 + h]; bt0 = DBETA[((size_t)dir * MROWS + row0 + t) * 4 + h]; }
        __builtin_amdgcn_sched_barrier(0);
#pragma unroll
        for (int i = 0; i < 6; ++i) { const int q = tid + 512 * i, which = q >> 10, rem = q & 1023, t = rem >> 4, ch = rem & 15;
            *(LDSP u32x4*)(L + which * 64 * DN_TS + t * DN_TS + ch * 16) = tr6[i]; }
        if (wave == 0) {
            const int t = dir ? 63 - lane : lane;
            float gs = gs0;
#pragma unroll
            for (int o = 1; o < 64; o <<= 1) { const float up = __builtin_bit_cast(float, __builtin_amdgcn_ds_bpermute((int)(((unsigned)(lane - o) & 63u) << 2), __builtin_bit_cast(int, gs))); if (lane >= o) gs += up; }
            const float glast = __builtin_bit_cast(float, __builtin_amdgcn_readlane(__builtin_bit_cast(int, gs), 63));
            gcl[t] = gs; btl[t] = bt0;
            float* G = (float*)(dob + DO_REC + c * DN_REC + RO_G);
            G[t] = __expf(gs); G[64 + t] = __expf(glast - gs); if (lane == 0) G[128] = __expf(glast);
        }
        __syncthreads();
        if (wave < 4) {
            const int mt = wave;
            f32x4 acc[4];
#pragma unroll
            for (int n4 = 0; n4 < 4; ++n4) acc[n4] = (f32x4){0.f, 0.f, 0.f, 0.f};
#pragma unroll
            for (int s = 0; s < 4; ++s) { const bf16x8v af = ld_row(Kt, DN_TS, 16 * mt, 32 * s, lane);
#pragma unroll
                for (int n4 = 0; n4 < 4; ++n4) acc[n4] = MFMA16(af, ld_row(Kt, DN_TS, 16 * n4, 32 * s, lane), acc[n4]); }
#pragma unroll
            for (int n4 = 0; n4 < 4; ++n4) { const int tp = 16 * n4 + i16; const float gtp = gcl[tp];
#pragma unroll
                for (int r = 0; r < 4; ++r) { const int t = 16 * mt + 4 * g + r; const bool strict = dir == 0 ? (tp < t) : (tp > t);
                    const float val = strict ? btl[t] * acc[n4][r] * __expf(gcl[t] - gtp) : 0.f;
                    const int si = dir ? 63 - t : t, sj = dir ? 63 - tp : tp;
                    *(LDSP float*)(As + si * DN_AS + sj * 4) = val; } }
        } else {
            const int tt = wave - 4;
            f32x4 acc[4];
#pragma unroll
            for (int n4 = 0; n4 < 4; ++n4) acc[n4] = (f32x4){0.f, 0.f, 0.f, 0.f};
#pragma unroll
            for (int s = 0; s < 4; ++s) { const bf16x8v bq = ld_row(Qt, DN_TS, 16 * tt, 32 * s, lane);
#pragma unroll
                for (int n4 = 0; n4 < 4; ++n4) acc[n4] = MFMA16(ld_row(Kt, DN_TS, 16 * n4, 32 * s, lane), bq, acc[n4]); }
            const int t = 16 * tt + i16; const float gt = gcl[t];
            unsigned pk[4][2];
#pragma unroll
            for (int n4 = 0; n4 < 4; ++n4) { float v4[4];
#pragma unroll
                for (int r = 0; r < 4; ++r) { const int tp = 16 * n4 + 4 * g + r; const bool incl = dir == 0 ? (tp <= t) : (tp >= t);
                    v4[r] = incl ? acc[n4][r] * __expf(gt - gcl[tp]) : 0.f; }
                pk[n4][0] = pk2(v4[0], v4[1]); pk[n4][1] = pk2(v4[2], v4[3]); }
            u32x4* AF = (u32x4*)(dob + DO_REC + c * DN_REC + RO_A);
#pragma unroll
            for (int s = 0; s < 2; ++s) { u32x4 w; w.x = pk[2 * s][0]; w.y = pk[2 * s][1]; w.z = pk[2 * s + 1][0]; w.w = pk[2 * s + 1][1]; AF[(tt * 2 + s) * 64 + lane] = w; }
        }
        __syncthreads();
        {
            for (int e = tid; e < 6 * 256; e += 512) { const int blk = e >> 8, r = (e >> 4) & 15, cc = e & 15;
                const int bi = blk < 3 ? 0 : (blk < 5 ? 1 : 2), bj = blk < 3 ? blk + 1 : (blk < 5 ? blk - 1 : 3);
                *(LDSP float*)(Ts + (16 * bi + r) * DN_AS + (16 * bj + cc) * 4) = 0.f; }
            if (wave == 0) {
                const int blk = lane >> 4, cc = lane & 15;
                float T[16];
#pragma unroll
                for (int i = 0; i < 16; ++i) {
                    float a0 = (i == cc) ? 1.f : 0.f, a1 = 0.f;
#pragma unroll
                    for (int i4 = 0; i4 < (i + 3) / 4; ++i4) { const f32x4 av = *(const LDSP f32x4*)(As + (16 * blk + i) * DN_AS + (16 * blk + 4 * i4) * 4);
#pragma unroll
                        for (int e = 0; e < 4; ++e) if (4 * i4 + e < i) { if (e & 1) a1 -= av[e] * T[4 * i4 + e]; else a0 -= av[e] * T[4 * i4 + e]; } }
                    T[i] = a0 + a1;
                }
#pragma unroll
                for (int i = 0; i < 16; ++i) *(LDSP float*)(Ts + (16 * blk + i) * DN_AS + (16 * blk + cc) * 4) = T[i];
            } else {
                u32x4* KF = (u32x4*)(dob + DO_REC + c * DN_REC + RO_K);
                for (int f = wave - 1; f < 16; f += 7) { const int md = f >> 1, s = f & 1;
                    const LDSP char* a = Kt + (32 * s + 4 * g + (i16 >> 2)) * DN_TS + (16 * md + 4 * (i16 & 3)) * 2;
                    const v4i16_t lo = __builtin_amdgcn_ds_read_tr16_b64_v4i16((LDSP v4i16_t*)a);
                    const v4i16_t hi = __builtin_amdgcn_ds_read_tr16_b64_v4i16((LDSP v4i16_t*)(a + 16 * DN_TS));
                    const bf16x8v fr = (bf16x8v){lo[0], lo[1], lo[2], lo[3], hi[0], hi[1], hi[2], hi[3]};
                    *(bf16x8v*)(KF + f * 64 + lane) = fr; }
            }
            __syncthreads();
#pragma unroll
            for (int dlev = 1; dlev < 4; ++dlev) {
                if (wave < 4 - dlev) {
                    const int bi = wave + dlev, bj = wave;
                    f32x4 x = (f32x4){0.f, 0.f, 0.f, 0.f};
                    for (int bk = bj; bk < bi; ++bk) {
                        const f32x4 av = *(const LDSP f32x4*)(As + (16 * bi + i16) * DN_AS + (16 * bk + 4 * g) * 4);
#pragma unroll
                        for (int sp = 0; sp < 4; ++sp) { const float bv = *(const LDSP float*)(Ts + (16 * bk + 4 * g + sp) * DN_AS + (16 * bj + i16) * 4);
                            x = __builtin_amdgcn_mfma_f32_16x16x4f32(av[sp], bv, x, 0, 0, 0); }
                    }
                    LDSP float* Xs = (LDSP float*)(Xw + wave * 1280);
#pragma unroll
                    for (int r = 0; r < 4; ++r) Xs[(4 * g + r) * 20 + i16] = x[r];
                    asm volatile("s_waitcnt lgkmcnt(0)" ::: "memory");
                    const f32x4 tv = *(const LDSP f32x4*)(Ts + (16 * bi + i16) * DN_AS + (16 * bi + 4 * g) * 4);
                    f32x4 y = (f32x4){0.f, 0.f, 0.f, 0.f};
#pragma unroll
                    for (int sp = 0; sp < 4; ++sp) y = __builtin_amdgcn_mfma_f32_16x16x4f32(tv[sp], Xs[(4 * g + sp) * 20 + i16], y, 0, 0, 0);
#pragma unroll
                    for (int r = 0; r < 4; ++r) *(LDSP float*)(Ts + (16 * bi + 4 * g + r) * DN_AS + (16 * bj + i16) * 4) = -y[r];
                }
                __syncthreads();
            }
            {
                const int i = tid >> 3, c0 = (tid & 7) * 8, tr = dir ? 63 - i : i;
                const f32x4 t0 = *(const LDSP f32x4*)(Ts + i * DN_AS + c0 * 4), t1 = *(const LDSP f32x4*)(Ts + i * DN_AS + c0 * 4 + 16);
                const float tv[8] = {t0[0], t0[1], t0[2], t0[3], t1[0], t1[1], t1[2], t1[3]};
                float vb[8], vg[8];
#pragma unroll
                for (int e = 0; e < 8; ++e) { const int tc = dir ? 63 - (c0 + e) : c0 + e; const float bc = btl[tc]; vb[e] = tv[e] * bc; vg[e] = vb[e] * __expf(gcl[tc]); }
                u32x4 wb, wg;
                if (dir == 0) { wb = (u32x4){pk2(vb[0], vb[1]), pk2(vb[2], vb[3]), pk2(vb[4], vb[5]), pk2(vb[6], vb[7])}; wg = (u32x4){pk2(vg[0], vg[1]), pk2(vg[2], vg[3]), pk2(vg[4], vg[5]), pk2(vg[6], vg[7])}; }
                else          { wb = (u32x4){pk2(vb[7], vb[6]), pk2(vb[5], vb[4]), pk2(vb[3], vb[2]), pk2(vb[1], vb[0])}; wg = (u32x4){pk2(vg[7], vg[6]), pk2(vg[5], vg[4]), pk2(vg[3], vg[2]), pk2(vg[1], vg[0])}; }
                const int tcol = dir ? 63 - (c0 + 7) : c0;
                *(LDSP u32x4*)(TB + tr * DN_PS + tcol * 2) = wb; *(LDSP u32x4*)(TG + tr * DN_PS + tcol * 2) = wg;
            }
        }
        __syncthreads();
        {
            const int mt = wave & 3, nh = wave >> 2;
            f32x4 ua[4], wa[4];
#pragma unroll
            for (int n4 = 0; n4 < 4; ++n4) { ua[n4] = (f32x4){0.f, 0.f, 0.f, 0.f}; wa[n4] = (f32x4){0.f, 0.f, 0.f, 0.f}; }
#pragma unroll
            for (int s = 0; s < 2; ++s) {
                const bf16x8v tb = ld_row(TB, DN_PS, 16 * mt, 32 * s, lane);
                const bf16x8v tg = ld_row(TG, DN_PS, 16 * mt, 32 * s, lane);
#pragma unroll
                for (int n4 = 0; n4 < 4; ++n4) { const int nt = nh * 4 + n4;
                    ua[n4] = MFMA16(tb, ld_tr(Vt, DN_TS, 32 * s, 16 * nt, lane), ua[n4]);
                    wa[n4] = MFMA16(ld_tr(Kt, DN_TS, 32 * s, 16 * nt, lane), tg, wa[n4]); }
            }
            u32x2* UF = (u32x2*)(dob + DO_U) + c * 2048;
#pragma unroll
            for (int n4 = 0; n4 < 4; ++n4) { u32x2 w; w.x = pk2(ua[n4][0], ua[n4][1]); w.y = pk2(ua[n4][2], ua[n4][3]); UF[((nh * 4 + n4) * 4 + mt) * 64 + lane] = w; }
            u32x4* WF = (u32x4*)(dob + DO_REC + c * DN_REC + RO_W);
#pragma unroll
            for (int s2 = 0; s2 < 2; ++s2) { u32x4 w; w.x = pk2(-wa[2 * s2][0], -wa[2 * s2][1]); w.y = pk2(-wa[2 * s2][2], -wa[2 * s2][3]);
                w.z = pk2(-wa[2 * s2 + 1][0], -wa[2 * s2 + 1][1]); w.w = pk2(-wa[2 * s2 + 1][2], -wa[2 * s2 + 1][3]);
                WF[(mt * 4 + nh * 2 + s2) * 64 + lane] = w; }
        }
        __syncthreads();
    }
}

constexpr int DNS_Q = 41984, DNS_U = 58368, DNS_BUF = 62464;
DI void phase_dn_scan(KP P, char* lds_, int bid, int nb, int wv_) {
    const gptr_t ws_ = lptr(P->ws);
    const gptr_t dob = lptr((unsigned char*)P->out);
    const int tid = ltid(), lane = tid & 63, wave = tid >> 6, g = lane >> 4, i16 = lane & 15;
    LDSP char* L = (LDSP char*)lds_;
    const bf16* DQ = (const bf16*)(ws_ + WS_DQ); float* DO = (float*)(ws_ + WS_DNO);
    for (int uu = bid; uu < 128; uu += nb) {
        const int u = uu >> 2, sp = uu & 3, vs = 2 * sp + (wave & 1);
        const int dir = u & 1, h = (u >> 1) & 3, b = u >> 3;
        const size_t c0 = (size_t)u * NCHUNK;
        if (wave >= 2) {
            const int lt = tid - 128;
            u32x4 sr[3][7], sq[3][3], sU[3];
#define DNL_LOAD(stage, n) do { const size_t c = c0 + (n); const int jn = dir == 0 ? (n) : ((n) < 4 ? 3 - (n) : 71 - (n)); const size_t rw = (size_t)b * TT + (size_t)jn * 64; \
                const u32x4* Rg = (const u32x4*)(dob + DO_REC + c * DN_REC) + lt; \
                _Pragma("unroll") for (int k_ = 0; k_ < 7; ++k_) if (k_ < 6 || lt < 320) sr[stage][k_] = Rg[384 * k_]; \
                _Pragma("unroll") for (int k_ = 0; k_ < 3; ++k_) if (k_ < 2 || lt < 256) { const int id = lt + 384 * k_, f_ = id >> 6, ln_ = id & 63, mt_ = f_ >> 2, s_ = f_ & 3; \
                    const bf16* qp_ = DQ + (rw + 16 * mt_ + (ln_ & 15)) * 512 + h * 128 + 32 * s_ + 4 * (ln_ >> 4); const u32x2 lo_ = *(const u32x2*)qp_, hi_ = *(const u32x2*)(qp_ + 16); \
                    sq[stage][k_] = (u32x4){lo_.x, lo_.y, hi_.x, hi_.y}; } \
                if (lt < 256) sU[stage] = *((const u32x4*)(dob + DO_U + c * 16384 + (size_t)sp * 4096) + lt); } while (0)
#define DNL_STORE(stage, bufp) do { LDSP u32x4* B_ = (LDSP u32x4*)(bufp) + lt; \
                _Pragma("unroll") for (int k_ = 0; k_ < 7; ++k_) if (k_ < 6 || lt < 320) B_[384 * k_] = sr[stage][k_]; \
                _Pragma("unroll") for (int k_ = 0; k_ < 3; ++k_) if (k_ < 2 || lt < 256) B_[DNS_Q / 16 + 384 * k_] = sq[stage][k_]; \
                if (lt < 256) B_[DNS_U / 16] = sU[stage]; } while (0)
            DNL_LOAD(0, 0); DNL_LOAD(1, 1); DNL_LOAD(2, 2);
            DNL_STORE(0, L);
            DNL_LOAD(0, 3);
            __syncthreads();
#pragma unroll 1
            for (int n0 = 0; n0 < 69; n0 += 3) {
#pragma unroll
                for (int k = 0; k < 3; ++k) { const int n = n0 + k;
                    if (n + 1 < NCHUNK) DNL_STORE((k + 1) % 3, L + ((n + 1) & 1) * DNS_BUF);
                    if (n + 4 < NCHUNK) DNL_LOAD((k + 1) % 3, n + 4);
                    __syncthreads(); }
            }
#undef DNL_LOAD
#undef DNL_STORE
        } else {
            f32x4 S[8];
#pragma unroll
            for (int m = 0; m < 8; ++m) S[m] = (f32x4){0.f, 0.f, 0.f, 0.f};
            __syncthreads();
#pragma unroll 1
            for (int n = 0; n < 69; ++n) {
              if (n < NCHUNK) {
                const LDSP char* B = L + (n & 1) * DNS_BUF;
                const LDSP bf16x8v* BW = (const LDSP bf16x8v*)(B + RO_W); const LDSP bf16x8v* BQ = (const LDSP bf16x8v*)(B + DNS_Q);
                const LDSP bf16x8v* BA = (const LDSP bf16x8v*)(B + RO_A); const LDSP bf16x8v* BK = (const LDSP bf16x8v*)(B + RO_K);
                const LDSP float* BG = (const LDSP float*)(B + RO_G); const LDSP u32x2* BU = (const LDSP u32x2*)(B + DNS_U + (wave & 1) * 2048);
#define SB() __builtin_amdgcn_sched_barrier(0)
#define LD4(dst, src, off) do { _Pragma("unroll") for (int f_ = 0; f_ < 4; ++f_) dst[f_] = (src)[((off) + f_) * 64 + lane]; } while (0)
                bf16x8v fa[4], fb[4];
                LD4(fa, BW, 0);
                f32x4 vn[4], oa[4];
#pragma unroll
                for (int m = 0; m < 4; ++m) { const u32x2 w = BU[m * 64 + lane]; vn[m] = (f32x4){bflo(w.x), bfhi(w.x), bflo(w.y), bfhi(w.y)}; }
                bf16x8v Sb[4];
#pragma unroll
                for (int s = 0; s < 4; ++s) { u32x4 w; w.x = pk2(S[2 * s][0], S[2 * s][1]); w.y = pk2(S[2 * s][2], S[2 * s][3]); w.z = pk2(S[2 * s + 1][0], S[2 * s + 1][1]); w.w = pk2(S[2 * s + 1][2], S[2 * s + 1][3]);
                    Sb[s] = __builtin_bit_cast(bf16x8v, w); }
#define GRP(acc, buf) do { _Pragma("unroll") for (int s_ = 0; s_ < 4; ++s_) acc = MFMA16(buf[s_], Sb[s_], acc); } while (0)
                SB(); LD4(fb, BW, 4); SB(); GRP(vn[0], fa);
                SB(); LD4(fa, BW, 8); SB(); GRP(vn[1], fb);
                SB(); LD4(fb, BW, 12); SB(); GRP(vn[2], fa);
                SB(); LD4(fa, BQ, 0); SB(); GRP(vn[3], fb);
#pragma unroll
                for (int m = 0; m < 4; ++m) oa[m] = (f32x4){0.f, 0.f, 0.f, 0.f};
                SB(); LD4(fb, BQ, 4); SB(); GRP(oa[0], fa);
                SB(); LD4(fa, BQ, 8); SB(); GRP(oa[1], fb);
                SB(); LD4(fb, BQ, 12);
                f32x4 eb4[4];
#pragma unroll
                for (int m = 0; m < 4; ++m) eb4[m] = *(const LDSP f32x4*)(BG + 64 + 16 * m + 4 * g);
                SB(); GRP(oa[2], fa);
                SB(); LD4(fa, BA, 0); SB(); GRP(oa[3], fb);
#undef GRP
                bf16x8v Vb[2], Vs[2];
#pragma unroll
                for (int s2 = 0; s2 < 2; ++s2) { unsigned wv[4], ws2[4];
#pragma unroll
                    for (int hh = 0; hh < 2; ++hh) { const int m = 2 * s2 + hh; const f32x4 eb = eb4[m];
                        wv[2 * hh] = pk2(vn[m][0], vn[m][1]); wv[2 * hh + 1] = pk2(vn[m][2], vn[m][3]);
                        ws2[2 * hh] = pk2(vn[m][0] * eb[0], vn[m][1] * eb[1]); ws2[2 * hh + 1] = pk2(vn[m][2] * eb[2], vn[m][3] * eb[3]); }
                    Vb[s2] = __builtin_bit_cast(bf16x8v, (u32x4){wv[0], wv[1], wv[2], wv[3]}); Vs[s2] = __builtin_bit_cast(bf16x8v, (u32x4){ws2[0], ws2[1], ws2[2], ws2[3]}); }
                SB(); LD4(fb, BA, 4);
                f32x4 ea4[4];
#pragma unroll
                for (int m = 0; m < 4; ++m) ea4[m] = *(const LDSP f32x4*)(BG + 16 * m + 4 * g);
                const float egl = BG[128];
                SB();
                const int jn = dir == 0 ? n : (n < 4 ? 3 - n : 71 - n); const size_t rw = (size_t)b * TT + (size_t)jn * 64;
#define OGRP(m, buf, o0) do { f32x4 o = oa[m] * ea4[m]; o = MFMA16(buf[o0], Vb[0], o); o = MFMA16(buf[o0 + 1], Vb[1], o); \
                    _Pragma("unroll") for (int r = 0; r < 4; ++r) DO[((size_t)dir * MROWS + rw + 16 * (m) + 4 * g + r) * 512 + h * 128 + 16 * vs + i16] = o[r]; } while (0)
                OGRP(0, fa, 0); OGRP(1, fa, 2);
                SB(); LD4(fa, BK, 0); SB();
                OGRP(2, fb, 0); OGRP(3, fb, 2);
#undef OGRP
#define SGRP(md, buf) do { S[md] = S[md] * egl; S[md] = MFMA16(buf[0], Vs[0], S[md]); S[md] = MFMA16(buf[1], Vs[1], S[md]); \
                    S[md + 1] = S[md + 1] * egl; S[md + 1] = MFMA16(buf[2], Vs[0], S[md + 1]); S[md + 1] = MFMA16(buf[3], Vs[1], S[md + 1]); } while (0)
                SB(); LD4(fb, BK, 4); SB(); SGRP(0, fa);
                SB(); LD4(fa, BK, 8); SB(); SGRP(2, fb);
                SB(); LD4(fb, BK, 12); SB(); SGRP(4, fa);
                SB(); SGRP(6, fb);
#undef SGRP
#undef LD4
#undef SB
              }
              __syncthreads();
            }
        }
        __syncthreads();
    }
}

DI void dn_post_rows(KP P, int l, int rbeg, int rstep, int rend, bool skip_ctx, int wv_) {
    const gptr_t ws_ = lptr(P->ws);
    const int lane = ltid() & 63, wave = ltid() >> 6;
    const bf16* Z = (const bf16*)(ws_ + WS_ACT); bf16* MIX = (bf16*)(ws_ + WS_H);
    const float* gp = GIN(P->dn_norm_g) + (size_t)l * 128 + (lane & 15) * 8;
    const f32x4 g0 = *(const f32x4*)gp, g1 = *(const f32x4*)(gp + 4);
    auto nextr = [&](int r) { while (r < rend && skip_ctx && (r % TT) < CTXL) r += rstep; return r; };
    f32x4 o00, o01, o10, o11; u32x4 gw;
    auto fetch = [&](int r) { const float* O0 = (const float*)(ws_ + WS_DNO) + (size_t)r * 512 + lane * 8; const float* O1 = O0 + (size_t)MROWS * 512;
        o00 = *(const f32x4*)O0; o01 = *(const f32x4*)(O0 + 4); o10 = *(const f32x4*)O1; o11 = *(const f32x4*)(O1 + 4); gw = *(const u32x4*)(Z + (size_t)r * ZW + ZDG + lane * 8); };
    int r = nextr(rbeg + wave);
    if (r >= rend) return;
    fetch(r);
    f32x4 a0 = o00 + o10, a1 = o01 + o11; u32x4 gc = gw;
#pragma unroll 1
    while (true) {
        const int rn = nextr(r + rstep);
        if (rn < rend) fetch(rn);
        const float v[8] = {a0.x, a0.y, a0.z, a0.w, a1.x, a1.y, a1.z, a1.w};
        float ss = 0.f;
#pragma unroll
        for (int e = 0; e < 8; ++e) ss += v[e] * v[e];
        ss += shx<1>(ss); ss += shx<2>(ss); ss += shx<4>(ss); ss += shx<8>(ss);
        const float rs = rsqrt_f(ss * (1.0f / 128.0f) + LN_EPS);
        const float g[8] = {g0.x, g0.y, g0.z, g0.w, g1.x, g1.y, g1.z, g1.w};
        const float gt[8] = {bflo(gc.x), bfhi(gc.x), bflo(gc.y), bfhi(gc.y), bflo(gc.z), bfhi(gc.z), bflo(gc.w), bfhi(gc.w)};
        float o[8];
#pragma unroll
        for (int e = 0; e < 8; ++e) o[e] = v[e] * rs * g[e] * silu_f(gt[e]);
        u32x4 w; w.x = pk2(o[0], o[1]); w.y = pk2(o[2], o[3]); w.z = pk2(o[4], o[5]); w.w = pk2(o[6], o[7]);
        *(u32x4*)(MIX + (size_t)r * 2048 + 512 + lane * 8) = w;
        if (rn >= rend) break;
        a0 = o00 + o10; a1 = o01 + o11; gc = gw; r = rn;
    }
}

struct RowOrder { pg8::StaticOrder base; int nN, nkt, parts; bool lat_only;
    DI void init(bool lat_only_, int N, int K, int parts_, int G, int c) { lat_only = lat_only_; nN = N / 256; nkt = K / 64; parts = parts_; base.init(NBATCH * SEQL, N, G, c); }
    DI bool next(int i, pg8::Unit& u) const {
        if (base.next(i, u)) { u.pm = 17 * (u.pm >> 4) + 1 + (u.pm & 15); u.kt0 = 0; u.nkt = nkt; return true; }
        if (lat_only) return false;
        const int q = i * base.G + base.c - base.nwg;
        if (q >= NBATCH * nN * parts) return false;
        const int unit = q / parts, part = q - unit * parts;
        u.pm = 17 * (unit / nN); u.pn = unit % nN; u.part = part;
        const int sz = nkt / parts;
        if (sz & 1) { const int base = (part >> 1) * 2 * sz; if (part & 1) { u.kt0 = base + sz + 1; u.nkt = sz - 1; } else { u.kt0 = base; u.nkt = sz + 1; } }
        else { u.nkt = sz; u.kt0 = part * sz; }
        return true; }
    DI void a_ready(const pg8::Unit&) const {}
    DI void done(const pg8::Unit&) const {} };
DI void phase_gemm_gu(KP P, int l, int sub, bool lat, char* lds, int bid, int nb, int wv_) {
    const gptr_t ws_ = lptr(P->ws);
    pg8::Gemm g{(const bf16*)(ws_ + WS_H), (const bf16*)(ws_ + WS_WGU) + (size_t)(l * 2 + sub) * WGU_ELEMS, MROWS, 2 * FF, DM};
    RowOrder S; S.init(lat, 2 * FF, DM, 1, nb, bid);
    pg8::EpiSwiglu E{(bf16*)(ws_ + WS_ACT), FF};
    pg8::gemm_phase<pg8::EpiSwiglu, RowOrder, PG8_ALIGN, PG8_SP2>((PG8_LAS unsigned char*)lds, g, S, E, wv_);
}
DI void phase_gemm_down(KP P, int l, int sub, bool lat, char* lds, int bid, int nb, int wv_) {
    const gptr_t ws_ = lptr(P->ws);
    pg8::Gemm g{(const bf16*)(ws_ + WS_ACT), (const bf16*)(ws_ + WS_WD) + (size_t)(l * 2 + sub) * WD_ELEMS, MROWS, DM, FF};
    RowOrder S; S.init(lat, DM, FF, 8, nb, bid);
    pg8::EpiDelta E{(bf16*)(ws_ + WS_DELTA), (bf16*)(ws_ + WS_PART), (const float*)(ws_ + WS_MOD) + (size_t)l * 5 * NMODV, sub == 0 ? 2 : 8, 0.5f, FF / 64};
    pg8::gemm_phase<pg8::EpiDelta, RowOrder, PG8_ALIGN, PG8_SP2>((PG8_LAS unsigned char*)lds, g, S, E, wv_);
}
DI void phase_gemm_in(KP P, int l, char* lds, int bid, int nb, int wv_) {
    const gptr_t ws_ = lptr(P->ws);
    pg8::Gemm g{(const bf16*)(ws_ + WS_H), (const bf16*)(ws_ + WS_WIN) + (size_t)l * WIN_ELEMS, MROWS, ZW, DM};
    RowOrder S; S.init(false, ZW, DM, 1, nb, bid);
    pg8::EpiStoreBf16 E{(bf16*)(ws_ + WS_ACT), ZW};
    pg8::gemm_phase<pg8::EpiStoreBf16, RowOrder, PG8_ALIGN, PG8_SP2>((PG8_LAS unsigned char*)lds, g, S, E, wv_);
}
DI void phase_gemm_out(KP P, int l, bool lat, char* lds, int bid, int nb, int wv_) {
    const gptr_t ws_ = lptr(P->ws);
    pg8::Gemm g{(const bf16*)(ws_ + WS_H), (const bf16*)(ws_ + WS_WOUT) + (size_t)l * WOUT_ELEMS, MROWS, DM, DM};
    RowOrder S; S.init(lat, DM, DM, 8, nb, bid);
    pg8::EpiDelta E{(bf16*)(ws_ + WS_DELTA), (bf16*)(ws_ + WS_PART), (const float*)(ws_ + WS_MOD) + (size_t)l * 5 * NMODV, 5, 1.0f, DM / 64};
    pg8::gemm_phase<pg8::EpiDelta, RowOrder, PG8_ALIGN, PG8_SP2>((PG8_LAS unsigned char*)lds, g, S, E, wv_);
}

#define LAS __attribute__((address_space(3)))
#define XB_TMO      128
#define XB_XCNT(j)  (256  + 64 * (j))
#define XB_XSUB(j)  (1280 + 64 * (j))
#define XB_XGEN(j)  (2304 + 64 * (j))
#define XB_TOP      3328
#define XB_TOPGEN   3392
#define XCD_BAR_WORDS 3456
#define XB_SPIN_CAP (1u << 18)

__device__ __forceinline__ unsigned xb_ld(unsigned* p)              { return __hip_atomic_load(p, __ATOMIC_RELAXED, __HIP_MEMORY_SCOPE_AGENT); }
__device__ __forceinline__ unsigned xb_add(unsigned* p, unsigned v) { return __hip_atomic_fetch_add(p, v, __ATOMIC_RELAXED, __HIP_MEMORY_SCOPE_AGENT); }
__device__ __forceinline__ unsigned xb_xcc_id() { return (unsigned)__builtin_amdgcn_s_getreg((3 << 11) | 20) & 0xFu; }
#define XB_SPIN(cond, bar) do { unsigned _sp = 0; while (cond) { __builtin_amdgcn_s_sleep(1); \
    if ((++_sp & 255u) == 0u) { if (xb_ld(&(bar)[XB_TMO])) break; if (_sp > XB_SPIN_CAP) { atomicAdd(&(bar)[XB_TMO], 1u); break; } } } } while (0)

struct XcdBarrier {
    unsigned* bar; unsigned x;
    volatile LAS unsigned* st;
};

__device__ __forceinline__ XcdBarrier xcd_barrier_post(unsigned* bar, volatile LAS unsigned* st) {
    XcdBarrier b; b.bar = bar; b.x = xb_xcc_id(); b.st = st;
    if (threadIdx.x == 0) (void)xb_add(&bar[XB_XCNT(b.x)], 1u);
    return b;
}
__device__ __forceinline__ void xcd_barrier_complete(unsigned* bar, unsigned x, unsigned& nloc, unsigned& nx) {
    const unsigned G = gridDim.x * gridDim.y * gridDim.z;
    unsigned sum, cnt, mine, sp = 0u;
    for (;;) {
        sum = 0u; cnt = 0u; mine = 0u;
#pragma unroll
        for (unsigned j = 0; j < 16; ++j) { const unsigned c = xb_ld(&bar[XB_XCNT(j)]); sum += c; cnt += (c > 0u) ? 1u : 0u; mine = (j == x) ? c : mine; }
        if (sum == G) break;
        __builtin_amdgcn_s_sleep(1);
        if ((++sp & 255u) == 0u) { if (xb_ld(&bar[XB_TMO])) break; if (sp > XB_SPIN_CAP) { atomicAdd(&bar[XB_TMO], 1u); break; } }
    }
    nloc = mine > 0u ? mine : 1u; nx = cnt > 0u ? cnt : 1u;
}

__device__ __forceinline__ void xcd_barrier(const XcdBarrier& b) {
    asm volatile("s_waitcnt vmcnt(0)" ::: "memory");
    __syncthreads();
    if (threadIdx.x == 0) {
        unsigned* bar = b.bar;
        __builtin_amdgcn_s_waitcnt(0);
        unsigned nloc = b.st[0], nx = b.st[1];
        if (nloc == 0u) { xcd_barrier_complete(bar, b.x, nloc, nx); b.st[0] = nloc; b.st[1] = nx; }
        const unsigned old = xb_add(&bar[XB_XSUB(b.x)], 1u);
        const unsigned gen = old / nloc;
        if (old + 1u == (gen + 1u) * nloc) {
            __builtin_amdgcn_fence(__ATOMIC_RELEASE, "agent");
            asm volatile("s_waitcnt vmcnt(0)" ::: "memory");
            const unsigned og = xb_add(&bar[XB_TOP], 1u);
            const unsigned tg = og / nx;
            if (og + 1u == (tg + 1u) * nx) xb_add(&bar[XB_TOPGEN], 1u);
            else XB_SPIN(xb_ld(&bar[XB_TOPGEN]) == tg, bar);
            __builtin_amdgcn_fence(__ATOMIC_ACQUIRE, "agent");
            xb_add(&bar[XB_XGEN(b.x)], 1u);
            asm volatile("s_waitcnt vmcnt(0)" ::: "memory");
        } else {
            XB_SPIN(xb_ld(&bar[XB_XGEN(b.x)]) == gen, bar);
            __builtin_amdgcn_fence(__ATOMIC_ACQUIRE, "agent");
            asm volatile("s_waitcnt vmcnt(0)" ::: "memory");
        }
    }
    __syncthreads();
}


constexpr int CW_QATT = 1024;
constexpr int CW_BAR = 4096;
constexpr int RING_BYTES = 131072, MISC_OFF = RING_BYTES + 320;
constexpr int LDS_BYTES = 147456;
static_assert((CW_BAR + XCD_BAR_WORDS) * 4 <= (int)CTL_ZERO_BYTES, "barrier words inside the memset region");

DI void dep_signal(unsigned* ctr, int wv_) {
    asm volatile("s_waitcnt vmcnt(0)" ::: "memory");
    __syncthreads();
    if (ltid() == 0) { __builtin_amdgcn_fence(__ATOMIC_RELEASE, "agent"); asm volatile("s_waitcnt vmcnt(0)" ::: "memory"); (void)xb_add(ctr, 1u); }
}
DI void dep_wait(unsigned* ctr, unsigned need, unsigned* bar, int wv_) {
    if (ltid() == 0) { XB_SPIN(xb_ld(ctr) < need, bar); __builtin_amdgcn_fence(__ATOMIC_ACQUIRE, "agent"); asm volatile("s_waitcnt vmcnt(0)" ::: "memory"); }
    __syncthreads();
}
constexpr int CW_DEP = 1536;
DI void phase_scanmix(KP P, char* lds, unsigned* ctl, int l, bool lastl, int bid, int wv_) {
    const gptr_t ws_ = lptr(P->ws);
    unsigned* done_dn = ctl + CW_DEP + 64 * (2 * l), * done_gla = ctl + CW_DEP + 64 * (2 * l + 1);
    if (bid < 128) { phase_dn_scan(P, lds, bid, 128, wv_); dep_signal(done_dn, wv_); }
    else { phase_gla_scan(P, bid - 128, 128, wv_); dep_signal(done_gla, wv_); }
    __syncthreads();
    const bf16* AQ = (const bf16*)(ws_ + WS_AQ); const bf16* AKV = (const bf16*)(ws_ + WS_AKV); bf16* MIX = (bf16*)(ws_ + WS_H);
    const int natt = NBATCH * 8 * 16 + (lastl ? 0 : NBATCH * 8), ngla = NBATCH * 4 * NCHUNK;
    for (int k = 0; k < 3; ++k) {
        const int u = k < 2 ? bid + 256 * k : (bid >= 224 ? 512 + (bid - 224) : natt);
        if (u >= natt) break;
        int qb, bh;
        if (u < NBATCH * 8 * 16) { qb = 1 + (u & 15); bh = u >> 4; } else { qb = 0; bh = u - NBATCH * 8 * 16; }
        const int hq = bh & 3, kvh = (bh >> 2) & 1, b = bh >> 3, h = kvh * 4 + hq;
        const size_t row0 = (size_t)b * TT + (size_t)qb * 256;
        att::attn_dense_body<att::bf16>(AQ + row0 * 1024 + h * 128, AKV + (size_t)b * TT * 512 + kvh * 128, AKV + (size_t)b * TT * 512 + 256 + kvh * 128,
                                        MIX + row0 * 2048 + 1024 + h * 128, qb == 0 ? CTXL : TT, lds, wv_);
        __syncthreads();
    }
    constexpr int R1 = 0;
    if (bid >= 128) { dep_wait(done_gla, 128u, ctl + CW_BAR, wv_);
        for (int u = bid - 128; u < ngla; u += 128) gla_out_unit(P, lds, u, l, wv_); }
    dep_wait(done_dn, 128u, ctl + CW_BAR, wv_);
    if (bid < 128) dn_post_rows(P, l, bid * NWAVE, 128 * NWAVE, R1, lastl, wv_);
    else dn_post_rows(P, l, R1 + (bid - 128) * NWAVE, 128 * NWAVE, MROWS, lastl, wv_);
}

__global__ void __launch_bounds__(NTHR, 2) mega_fwd(Params Pv) {
    extern __shared__ __attribute__((aligned(16))) char lds[];
    const int tid = threadIdx.x, bid = blockIdx.x; constexpr int nb = 256;
    const int wv0_ = __builtin_amdgcn_readfirstlane(tid >> 6);
    for (int u = tid; u < (LDS_BYTES - RING_BYTES) / 4; u += NTHR) ((unsigned*)(lds + RING_BYTES))[u] = 0u;
    __syncthreads();
    unsigned* ctl = (unsigned*)(Pv.ws + WS_CTL);
    const XcdBarrier bar = xcd_barrier_post(ctl + CW_BAR, (volatile LAS unsigned*)(lds + MISC_OFF + 32));
#define WV() ({ int w_ = wv0_; asm volatile("" : "+s"(w_)); w_; })
#define PKA() ({ KP kp_ = (KP)__builtin_amdgcn_kernarg_segment_ptr(); asm volatile("" : "+s"(kp_)); kp_; })
#define GRID_BAR() do { XcdBarrier b2_ = bar; asm volatile("" : "+s"(b2_.x), "+s"(b2_.bar)); xcd_barrier(b2_); } while (0)

    phase_mod(PKA(), lds, bid, nb, WV());
    phase_wcvt(PKA(), lds, bid, nb, WV());
    GRID_BAR();
    phase_init(PKA(), lds, bid, WV());
    GRID_BAR();

    for (int s = 0; s < 2 * NLAYER; ++s) {
        const int l = s >> 1, sub = s & 1; const bool last = (s == 2 * NLAYER - 1);
        const bool lastl = (l == NLAYER - 1);
        phase_gemm_gu(PKA(), l, sub, last, lds, bid, nb, WV());
        GRID_BAR();
        phase_gemm_down(PKA(), l, sub, last, lds, bid, nb, WV());
        GRID_BAR();
        if (sub == 0) phase_ln<false>(PKA(), lds, l, 0, l, 3, false, 8, bid, WV());
        else if (last) phase_ln<true>(PKA(), lds, l, 2, 0, -1, false, 0, bid, WV());
        else          phase_ln<false>(PKA(), lds, l, 2, l + 1, 0, false, 8, bid, WV());
        if (last) break;
        GRID_BAR();
        if (sub == 0) {
            phase_gemm_in(PKA(), l, lds, bid, nb, WV());
            GRID_BAR();
            phase_prep(PKA(), l, bid, nb, WV());
            GRID_BAR();
            phase_gla_local(PKA(), lds, bid, nb, WV());
            phase_dn_local(PKA(), lds, bid, nb, WV());
            GRID_BAR();
            phase_scanmix(PKA(), lds, ctl, l, lastl, bid, WV());
            GRID_BAR();
            phase_gemm_out(PKA(), l, lastl, lds, bid, nb, WV());
            GRID_BAR();
            phase_ln<false>(PKA(), lds, l, 1, l, 6, lastl, lastl ? 0 : 8, bid, WV());
            GRID_BAR();
        }
    }
#undef GRID_BAR
}

extern "C" void kernel_launch(void* const* d_in, const int* in_sizes, int n_in, void* d_out, int out_size, void* d_ws, size_t ws_size, hipStream_t stream) {
    static int grid = 0;
    if (grid == 0) {
        if (n_in != 24 || ws_size < WS_END2 || out_size != NBATCH * SEQL * DM) { fprintf(stderr, "kernel_launch: unexpected shapes (n_in %d, out %d, ws %zu)\n", n_in, out_size, ws_size); grid = -1; return; }
        int dev = 0, cus = 0, per_cu = 0;
        if (hipGetDevice(&dev) != hipSuccess || hipDeviceGetAttribute(&cus, hipDeviceAttributeMultiprocessorCount, dev) != hipSuccess) { grid = -1; return; }
        if (hipFuncSetAttribute((const void*)mega_fwd, hipFuncAttributeMaxDynamicSharedMemorySize, LDS_BYTES) != hipSuccess) { fprintf(stderr, "kernel_launch: hipFuncSetAttribute failed\n"); grid = -1; return; }
        if (hipOccupancyMaxActiveBlocksPerMultiprocessor(&per_cu, (const void*)mega_fwd, NTHR, LDS_BYTES) != hipSuccess || per_cu < 1) fprintf(stderr, "kernel_launch: occupancy query says %d\n", per_cu);
        (void)hipGetLastError();
        if (cus != 256) { fprintf(stderr, "kernel_launch: built for a 256-CU device (one workgroup per CU), found %d CUs; nothing launched\n", cus); grid = -1; return; }
        grid = cus;
    }
    if (grid < 0) return;
    if (hipMemsetAsync((char*)d_ws + WS_CTL, 0, CTL_ZERO_BYTES, stream) != hipSuccess) return;
    Params P{};
    const float** pp = (const float**)&P;
    for (int i = 0; i < 24; ++i) pp[i] = (const float*)d_in[i];
    P.out = (float*)d_out; P.ws = (unsigned char*)d_ws;
    hipLaunchKernelGGL(mega_fwd, dim3(grid), dim3(NTHR), LDS_BYTES, stream, P);
    const hipError_t le = hipPeekAtLastError();
    if (le != hipSuccess) fprintf(stderr, "kernel_launch: launch failed: %s\n", hipGetErrorName(le));
}
```

```cpp
#include <hip/hip_runtime.h>
#include <cstdio>
#include <cstdint>
#include <cmath>
#define GAS1 __attribute__((address_space(1)))
typedef __attribute__((address_space(1))) unsigned char* gptr_t;
__device__ __forceinline__ gptr_t lptr(unsigned char* p) { gptr_t g = (gptr_t)p; asm volatile("" : "+s"(g)); return g; }
__device__ __forceinline__ int ltid_from(int wv) { int l; asm volatile("v_mbcnt_lo_u32_b32 %0, -1, 0\n\tv_mbcnt_hi_u32_b32 %0, -1, %0" : "=v"(l)); return wv * 64 + l; }
#define ltid() ltid_from(wv_)

namespace pg8 {
#define PG8_LAS __attribute__((address_space(3)))
typedef unsigned short bf16_t;
typedef short bf16x8 __attribute__((ext_vector_type(8)));
typedef float f32x4 __attribute__((ext_vector_type(4)));
typedef unsigned u32x4 __attribute__((ext_vector_type(4)));
constexpr int BM = 256, BK = 64, HALF = 128, HTB = HALF * BK * 2  , STAGE_BYTES = 8 * HTB, NXCD = 8, WGM = 8;

__host__ __device__ __forceinline__ int lds_byte(int r, int c) { const int st = (r >> 4) * 2 + (c >> 5), rr = r & 15, cc = c & 31, ob = rr * 64 + cc * 2; return st * 1024 + (ob ^ (((ob >> 9) & 1) << 5)); }
__host__ __device__ __forceinline__ void stage_rc(int b, int& R, int& C) { const int st = b / 1024, sb = b % 1024, swz = sb ^ (((sb >> 9) & 1) << 5); R = (st >> 1) * 16 + swz / 64; C = (st & 1) * 32 + (swz % 64) / 2; }
__host__ __device__ __forceinline__ int perm32(int rho) { const int n = rho >> 4, i = rho & 15; return 8 * (i >> 2) + 4 * n + (i & 3); }

struct Unit { int pm, pn, kt0, nkt, part; };
struct Gemm { const bf16_t* A; const bf16_t* Bt; int M, N, K; };

struct StaticOrder {
    int nM, nN, nwg, G, c;
    __host__ __device__ void init(int M, int N, int G_, int c_) { nM = M / BM; nN = N / BM; nwg = nM * nN; G = G_; c = c_; }
    __host__ __device__ bool next(int i, Unit& u) const {
        const long L = (long)i * G + c; if (L >= nwg) return false;
        int wgid = (int)L; { const int q = nwg / NXCD, r = nwg % NXCD, xcd = wgid % NXCD, off = wgid / NXCD; wgid = (xcd < r ? xcd * (q + 1) : r * (q + 1) + (xcd - r) * q) + off; }
        const int nig = WGM * nN, gid = wgid / nig, fm = gid * WGM, gsz = (nM - fm) < WGM ? (nM - fm) : WGM;
        u.pm = fm + ((wgid % nig) % gsz); u.pn = (wgid % nig) / gsz; u.kt0 = 0; u.nkt = 0; u.part = 0; return true;
    }
    __device__ __forceinline__ void a_ready(const Unit&) const {}
    __device__ __forceinline__ void done(const Unit&) const {}
};

__device__ __forceinline__ unsigned cvt_pk_bf16(float lo, float hi) { unsigned r; asm volatile("v_cvt_pk_bf16_f32 %0, %1, %2" : "=v"(r) : "v"(lo), "v"(hi)); return r; }

struct EpiStoreBf16 {
    static constexpr bool PERM = true, AFTER_DRAIN = false;
    bf16_t* O; int ldc;
    __device__ __forceinline__ void operator()(const f32x4 (&acc)[2][2][4][2], const Unit& u, int wr, int wc, int fr, int fq) const {
        const int row0 = u.pm * BM + wr * 64 + fr, col0 = u.pn * BM + wc * 32 + 8 * fq;
#pragma unroll
        for (int ai = 0; ai < 2; ++ai)
#pragma unroll
            for (int m = 0; m < 4; ++m) { bf16_t* rowp = O + (size_t)(row0 + ai * HALF + m * 16) * ldc + col0;
#pragma unroll
                for (int bj = 0; bj < 2; ++bj) { const f32x4 v0 = acc[ai][bj][m][0], v1 = acc[ai][bj][m][1];
                    u32x4 w; w.x = cvt_pk_bf16(v0[0], v0[1]); w.y = cvt_pk_bf16(v0[2], v0[3]); w.z = cvt_pk_bf16(v1[0], v1[1]); w.w = cvt_pk_bf16(v1[2], v1[3]);
                    *(u32x4*)(rowp + bj * HALF) = w; } }
    }
};
__device__ __forceinline__ float silu_fast(float g) { return g * __builtin_amdgcn_rcpf(1.0f + __builtin_amdgcn_exp2f(-1.4426950408889634f * g)); }
struct EpiSwiglu {
    static constexpr bool PERM = true, AFTER_DRAIN = false;
    bf16_t* O; int ldc;
    __device__ __forceinline__ void operator()(const f32x4 (&acc)[2][2][4][2], const Unit& u, int wr, int wc, int fr, int fq) const {
        const int row0 = u.pm * BM + wr * 64 + fr, col0 = u.pn * HALF + wc * 32 + 8 * fq;
#pragma unroll
        for (int ai = 0; ai < 2; ++ai)
#pragma unroll
            for (int m = 0; m < 4; ++m) { bf16_t* rowp = O + (size_t)(row0 + ai * HALF + m * 16) * ldc + col0;
                const f32x4 g0 = acc[ai][0][m][0], g1 = acc[ai][0][m][1], u0 = acc[ai][1][m][0], u1 = acc[ai][1][m][1];
                typedef float f32x2_t __attribute__((ext_vector_type(2)));
                f32x2_t pr[4];
#pragma unroll
                for (int i = 0; i < 4; ++i) { const f32x2_t gg = i < 2 ? (f32x2_t){g0[2 * i], g0[2 * i + 1]} : (f32x2_t){g1[2 * i - 4], g1[2 * i - 3]};
                    const f32x2_t uu = i < 2 ? (f32x2_t){u0[2 * i], u0[2 * i + 1]} : (f32x2_t){u1[2 * i - 4], u1[2 * i - 3]};
                    const f32x2_t t = gg * -1.4426950408889634f; f32x2_t a; a.x = __builtin_amdgcn_exp2f(t.x); a.y = __builtin_amdgcn_exp2f(t.y); a = a + 1.0f;
                    f32x2_t rc; rc.x = __builtin_amdgcn_rcpf(a.x); rc.y = __builtin_amdgcn_rcpf(a.y);
                    pr[i] = (gg * uu) * rc; }
                u32x4 w; w.x = cvt_pk_bf16(pr[0].x, pr[0].y); w.y = cvt_pk_bf16(pr[1].x, pr[1].y); w.z = cvt_pk_bf16(pr[2].x, pr[2].y); w.w = cvt_pk_bf16(pr[3].x, pr[3].y);
                *(u32x4*)rowp = w; }
    }
};
struct EpiDelta {
    static constexpr bool PERM = true, AFTER_DRAIN = false;
    bf16_t* D; bf16_t* PART; const float* modl; int gidx; float coef; int nkt_full;
    __device__ __forceinline__ void operator()(const f32x4 (&acc)[2][2][4][2], const Unit& u, int wr, int wc, int fr, int fq) const {
        const int mi = (u.pm % 17 == 0) ? 4 : (u.pm / 17);
        const float* gp = modl + (size_t)mi * 18432 + gidx * 2048;
        const int col0 = u.pn * BM + wc * 32 + 8 * fq;
        const bool part = u.nkt != nkt_full;
        f32x4 gv[2][2];
#pragma unroll
        for (int bj = 0; bj < 2; ++bj) { gv[bj][0] = *(const f32x4*)(gp + col0 + bj * HALF); gv[bj][1] = *(const f32x4*)(gp + col0 + bj * HALF + 4); }
#pragma unroll
        for (int bj = 0; bj < 2; ++bj) {
            const f32x4 g0 = gv[bj][0] * coef, g1 = gv[bj][1] * coef;
#pragma unroll
            for (int ai = 0; ai < 2; ++ai)
#pragma unroll
                for (int m = 0; m < 4; ++m) { const int rt = ai * HALF + wr * 64 + m * 16 + fr;
                    const f32x4 d0 = g0 * acc[ai][bj][m][0], d1 = g1 * acc[ai][bj][m][1];
                    u32x4 w; w.x = cvt_pk_bf16(d0[0], d0[1]); w.y = cvt_pk_bf16(d0[2], d0[3]); w.z = cvt_pk_bf16(d1[0], d1[1]); w.w = cvt_pk_bf16(d1[2], d1[3]);
                    if (part) *(u32x4*)(PART + ((size_t)u.part * 1024 + (size_t)(u.pm / 17) * 256 + rt) * 2048 + col0 + bj * HALF) = w;
                    else *(u32x4*)(D + (size_t)(u.pm * BM + rt) * 2048 + col0 + bj * HALF) = w; }
        }
    }
};

template <class Epi, class Sched, bool ALIGN_EPI = false, bool SP2 = false>
__device__ __forceinline__ void gemm_phase(PG8_LAS unsigned char* lds, const Gemm g, const Sched& S, const Epi& E, int wv_) {
    const int tid = ltid(), wid = __builtin_amdgcn_readfirstlane(tid >> 6), lane = tid & 63, wr = wid >> 2, wc = wid & 3, fr = lane & 15, fq = lane >> 4;
    const int K = g.K;
    unsigned voffA[2], voffB[2];
#pragma unroll
    for (int i = 0; i < 2; ++i) { int R, C; stage_rc(tid * 16 + i * 8192, R, C); const int Rb = Epi::PERM ? ((R & ~31) + perm32(R & 31)) : R;
        voffA[i] = (unsigned)(R * K + C) * 2u; voffB[i] = (unsigned)(Rb * K + C) * 2u; }
    const size_t kstep = (size_t)(BK * 2);
    const size_t hstep = (size_t)HALF * K * 2;
    const size_t tstep = 2 * hstep;
    const unsigned ldsw = (unsigned)wid * 1024u;
    const int aoff = lds_byte(wr * 64 + fr, fq * 8), boff = lds_byte(wc * 32 + fr, fq * 8);
#define PG8_SA(b, h) (((b) * 2 + (h)) * HTB)
#define PG8_SB(b, h) ((4 + (b) * 2 + (h)) * HTB)
#define PG8_STAGE(bufoff, gbase, voff) do { _Pragma("unroll") for (int _i = 0; _i < 2; ++_i) \
        __builtin_amdgcn_global_load_lds((const unsigned*)((const char*)(gbase) + (voff)[_i]), (PG8_LAS unsigned*)(lds + (bufoff) + ldsw + _i * 8192), 16, 0, 0); } while (0)
#define PG8_LDA(dst, b, h) do { _Pragma("unroll") for (int m = 0; m < 4; ++m) _Pragma("unroll") for (int k = 0; k < 2; ++k) dst[m][k] = *(const PG8_LAS bf16x8*)(lds + PG8_SA(b, h) + aoff + m * 2048 + k * 1024); } while (0)
#define PG8_LDB(dst, b, h) do { _Pragma("unroll") for (int n = 0; n < 2; ++n) _Pragma("unroll") for (int k = 0; k < 2; ++k) dst[n][k] = *(const PG8_LAS bf16x8*)(lds + PG8_SB(b, h) + boff + n * 2048 + k * 1024); } while (0)
#define PG8_MMA(ai, bj, At, Bt) do { __builtin_amdgcn_s_setprio(1); _Pragma("unroll") for (int m = 0; m < 4; ++m) _Pragma("unroll") for (int n = 0; n < 2; ++n) _Pragma("unroll") for (int k = 0; k < 2; ++k) \
        acc[ai][bj][m][n] = __builtin_amdgcn_mfma_f32_16x16x32_bf16(Bt[n][k], At[m][k], acc[ai][bj][m][n], 0, 0, 0); __builtin_amdgcn_s_setprio(0); } while (0)
#define PG8_WAIT_V(n) asm volatile("s_waitcnt vmcnt(" #n ")" ::: "memory")
#define PG8_WAIT_L(n) asm volatile("s_waitcnt lgkmcnt(" #n ")" ::: "memory")
#define PG8_BAR __builtin_amdgcn_s_barrier()
#define PG8_SCHED __builtin_amdgcn_sched_barrier(0)
    Unit cur, nxt; int ui = 0;
    if (!S.next(0, cur)) return;
    f32x4 acc[2][2][4][2];
#pragma unroll
    for (int a = 0; a < 2; ++a)
#pragma unroll
        for (int b = 0; b < 2; ++b)
#pragma unroll
            for (int m = 0; m < 4; ++m)
#pragma unroll
                for (int n = 0; n < 2; ++n) acc[a][b][m][n] = (f32x4){0.f, 0.f, 0.f, 0.f};
    bf16x8 At[4][2], B0[2][2], B1[2][2];
    const char* cA = (const char*)g.A + (size_t)cur.pm * tstep + (size_t)cur.kt0 * kstep; const char* cB = (const char*)g.Bt + (size_t)cur.pn * tstep + (size_t)cur.kt0 * kstep;
    S.a_ready(cur);
    if constexpr (SP2) {
        PG8_STAGE(PG8_SB(0, 0), cB, voffB); PG8_STAGE(PG8_SB(0, 1), cB + hstep, voffB); PG8_STAGE(PG8_SA(0, 0), cA, voffA); PG8_STAGE(PG8_SA(0, 1), cA + hstep, voffA);
        if (wr == 1) PG8_BAR;
        PG8_WAIT_V(2); PG8_BAR;
        PG8_STAGE(PG8_SB(1, 0), cB + kstep, voffB); PG8_STAGE(PG8_SA(1, 0), cA + kstep, voffA); PG8_STAGE(PG8_SB(1, 1), cB + hstep + kstep, voffB);
        PG8_WAIT_V(6); PG8_BAR;
    } else {
        PG8_STAGE(PG8_SB(0, 0), cB, voffB); PG8_STAGE(PG8_SA(0, 0), cA, voffA); PG8_STAGE(PG8_SB(0, 1), cB + hstep, voffB); PG8_STAGE(PG8_SA(0, 1), cA + hstep, voffA);
        if (wr == 1) PG8_BAR;
        PG8_WAIT_V(4); PG8_BAR;
        PG8_STAGE(PG8_SB(1, 0), cB + kstep, voffB); PG8_STAGE(PG8_SA(1, 0), cA + kstep, voffA); PG8_STAGE(PG8_SB(1, 1), cB + hstep + kstep, voffB);
        PG8_WAIT_V(6); PG8_BAR;
    }
    for (;;) {
        const bool has_next = S.next(ui + 1, nxt);
        const char* nA = has_next ? (const char*)g.A + (size_t)nxt.pm * tstep + (size_t)nxt.kt0 * kstep : cA; const char* nB = has_next ? (const char*)g.Bt + (size_t)nxt.pn * tstep + (size_t)nxt.kt0 * kstep : cB;
        const int nt = cur.nkt;
        for (int t = 0; t < nt; t += 2) {
            const bool last = (t == nt - 2);
            const char* a1 = cA + (size_t)(t + 1) * kstep;
            const char* a2 = last ? nA : cA + (size_t)(t + 2) * kstep; const char* b2 = last ? nB : cB + (size_t)(t + 2) * kstep;
            const char* a3 = a2 + kstep; const char* b3 = b2 + kstep;
            if (last && has_next) S.a_ready(nxt);
            if constexpr (SP2) {
            PG8_LDB(B0, 0, 0); PG8_LDB(B1, 0, 1); PG8_SCHED; PG8_LDA(At, 0, 0); PG8_STAGE(PG8_SA(1, 1), a1 + hstep, voffA);
            PG8_WAIT_V(8); PG8_WAIT_L(0); PG8_BAR; PG8_MMA(0, 0, At, B0); PG8_MMA(0, 1, At, B1); PG8_BAR; PG8_SCHED;
            PG8_LDA(At, 0, 1); PG8_STAGE(PG8_SB(0, 0), b2, voffB); PG8_STAGE(PG8_SB(0, 1), b2 + hstep, voffB); PG8_STAGE(PG8_SA(0, 0), a2, voffA);
            PG8_WAIT_V(8); PG8_WAIT_L(0); PG8_BAR; PG8_MMA(1, 0, At, B0); PG8_MMA(1, 1, At, B1); PG8_BAR; PG8_SCHED;
            PG8_LDB(B0, 1, 0); PG8_LDB(B1, 1, 1); PG8_SCHED; PG8_LDA(At, 1, 0); PG8_STAGE(PG8_SA(0, 1), a2 + hstep, voffA);
            PG8_WAIT_V(8); PG8_WAIT_L(0); PG8_BAR; PG8_MMA(0, 0, At, B0); PG8_MMA(0, 1, At, B1); PG8_BAR; PG8_SCHED;
            PG8_LDA(At, 1, 1); PG8_STAGE(PG8_SB(1, 0), b3, voffB); PG8_STAGE(PG8_SB(1, 1), b3 + hstep, voffB); PG8_STAGE(PG8_SA(1, 0), a3, voffA);
            PG8_WAIT_V(8); PG8_WAIT_L(0); PG8_BAR; PG8_MMA(1, 0, At, B0); PG8_MMA(1, 1, At, B1); PG8_BAR; PG8_SCHED;
            } else {
            PG8_LDB(B0, 0, 0); PG8_SCHED; PG8_LDA(At, 0, 0); PG8_STAGE(PG8_SA(1, 1), a1 + hstep, voffA);
            PG8_WAIT_L(8); PG8_BAR; PG8_WAIT_L(0); PG8_MMA(0, 0, At, B0); PG8_BAR; PG8_SCHED;
            PG8_LDB(B1, 0, 1); PG8_STAGE(PG8_SB(0, 0), b2, voffB);
            PG8_BAR; PG8_WAIT_L(0); PG8_MMA(0, 1, At, B1); PG8_BAR;
            PG8_LDA(At, 0, 1); PG8_STAGE(PG8_SA(0, 0), a2, voffA);
            PG8_BAR; PG8_WAIT_L(0); PG8_MMA(1, 0, At, B0); PG8_BAR; PG8_SCHED;
            PG8_STAGE(PG8_SB(0, 1), b2 + hstep, voffB);
            PG8_WAIT_V(6); PG8_BAR; PG8_MMA(1, 1, At, B1); PG8_BAR;
            PG8_LDB(B0, 1, 0); PG8_SCHED; PG8_LDA(At, 1, 0); PG8_STAGE(PG8_SA(0, 1), a2 + hstep, voffA);
            PG8_WAIT_L(8); PG8_BAR; PG8_WAIT_L(0); PG8_MMA(0, 0, At, B0); PG8_BAR; PG8_SCHED;
            PG8_LDB(B1, 1, 1); PG8_STAGE(PG8_SB(1, 0), b3, voffB);
            PG8_BAR; PG8_WAIT_L(0); PG8_MMA(0, 1, At, B1); PG8_BAR;
            PG8_LDA(At, 1, 1); PG8_STAGE(PG8_SA(1, 0), a3, voffA);
            PG8_BAR; PG8_WAIT_L(0); PG8_MMA(1, 0, At, B0); PG8_BAR; PG8_SCHED;
            PG8_STAGE(PG8_SB(1, 1), b3 + hstep, voffB);
            PG8_WAIT_V(6); PG8_BAR; PG8_MMA(1, 1, At, B1); PG8_BAR;
            }
        }
        if constexpr (ALIGN_EPI) { if (wr == 0) PG8_BAR; }
        if constexpr (!Epi::AFTER_DRAIN) { E(acc, cur, wr, wc, fr, fq); S.done(cur); }
        if (!has_next) break;
#pragma unroll
        for (int a = 0; a < 2; ++a)
#pragma unroll
            for (int b = 0; b < 2; ++b)
#pragma unroll
                for (int m = 0; m < 4; ++m)
#pragma unroll
                    for (int n = 0; n < 2; ++n) acc[a][b][m][n] = (f32x4){0.f, 0.f, 0.f, 0.f};
        cur = nxt; cA = nA; cB = nB; ++ui;
        if constexpr (ALIGN_EPI) { if (wr == 1) PG8_BAR; }
    }
    PG8_WAIT_V(0);
    if constexpr (!ALIGN_EPI) { if (wr == 0) PG8_BAR; }
    PG8_BAR;
    if constexpr (Epi::AFTER_DRAIN) { E.fused(acc, cur, wr, wc, fr, fq, lds, wid, lane); S.done(cur); }
#undef PG8_SA
#undef PG8_SB
#undef PG8_STAGE
#undef PG8_LDA
#undef PG8_LDB
#undef PG8_MMA
#undef PG8_WAIT_V
#undef PG8_WAIT_L
#undef PG8_BAR
#undef PG8_SCHED
}
}

#ifndef PG8_SP2
#define PG8_SP2 true
#endif
#ifndef PG8_ALIGN
#define PG8_ALIGN true
#endif

namespace att {
using bf16 = unsigned short;
constexpr int   D = 128, NW = 8, QBLK = 32, KVBLK = 64;
constexpr float SCALE = 0.088388347648318440f;
constexpr float THR = 8.f;
constexpr int SDEPTH = 2;
constexpr int LDQ = 1024, LDK = 512, LDO = 2048;
constexpr size_t SHM_V = KVBLK * D * 2, SHM_K = KVBLK * D * 2, SHM_ATTN = 2 * SHM_V + 2 * SHM_K + NW * 64 * 4;
__device__ __forceinline__ unsigned short f2bf_rne(float f) { unsigned u = __builtin_bit_cast(unsigned, f); return (unsigned short)((u + 0x7fffu + ((u >> 16) & 1u)) >> 16); }
using bf16x8 = __attribute__((ext_vector_type(8))) short;
using s16x4  = __attribute__((ext_vector_type(4))) short;
using f32x16 = __attribute__((ext_vector_type(16))) float;
using f32x8  = __attribute__((ext_vector_type(8))) float;
using u32x4  = __attribute__((ext_vector_type(4))) unsigned;
#define KSWZ(row, colB) ((row) * 256 + ((colB) ^ (((row) & 7) << 4)))
#define SBAR() __builtin_amdgcn_sched_barrier(0)
__device__ __forceinline__ int crow(int r, int hi) { return (r & 3) + 8 * (r >> 2) + 4 * hi; }
__device__ __forceinline__ unsigned cvtpk(float lo, float hi) {
  unsigned r; asm volatile("v_cvt_pk_bf16_f32 %0, %1, %2" : "=v"(r) : "v"(lo), "v"(hi)); return r;
}
template <typename TIn> struct Stage;
template <> struct Stage<bf16>  { using T = bf16x8;
  __device__ static __forceinline__ T ld8(const bf16* p) { return *reinterpret_cast<const bf16x8*>(p); }
  __device__ static __forceinline__ bf16x8 tobf(T x) { return x; } };
template <> struct Stage<float> { using T = f32x8;
  __device__ static __forceinline__ T ld8(const float* p) { return *reinterpret_cast<const f32x8*>(p); }
  __device__ static __forceinline__ bf16x8 tobf(T x) {
    u32x4 w = {cvtpk(x[0], x[1]), cvtpk(x[2], x[3]), cvtpk(x[4], x[5]), cvtpk(x[6], x[7])}; return *reinterpret_cast<bf16x8*>(&w); } };

__device__ __forceinline__ void partialSM(f32x16& p0, f32x16& p1, float& m_reg, float& mn, float& alpha) {
  constexpr float C = SCALE * 1.4426950408889634f;
  float pmax = p0[0]; for (int r = 1; r < 16; ++r) pmax = fmaxf(pmax, p0[r]); for (int r = 0; r < 16; ++r) pmax = fmaxf(pmax, p1[r]);
  { auto rr = __builtin_amdgcn_permlane32_swap(__float_as_uint(pmax), __float_as_uint(pmax), false, false);
    pmax = fmaxf(__uint_as_float(rr[0]), __uint_as_float(rr[1])); }
  if (__builtin_expect(__all(pmax - m_reg <= THR / SCALE), 1)) { mn = m_reg; alpha = 1.f; }
  else { mn = fmaxf(m_reg, pmax); alpha = __builtin_amdgcn_exp2f((m_reg - mn) * C); m_reg = mn; }
  float mnC = -mn * C;
  for (int r = 0; r < 16; ++r) p0[r] = fmaf(p0[r], C, mnC); for (int r = 0; r < 16; ++r) p1[r] = fmaf(p1[r], C, mnC);
  for (int r = 0; r < 16; ++r) p0[r] = __builtin_amdgcn_exp2f(p0[r]);
}
__device__ __forceinline__ void finishSM(f32x16& p0, f32x16& p1, float alpha, float& l_reg, bf16x8& pa0, bf16x8& pa1, bf16x8& pa2, bf16x8& pa3) {
  for (int r = 0; r < 16; ++r) p1[r] = __builtin_amdgcn_exp2f(p1[r]);
  float ps = 0; for (int r = 0; r < 16; ++r) ps += p0[r]; for (int r = 0; r < 16; ++r) ps += p1[r];
  { auto rr = __builtin_amdgcn_permlane32_swap(__float_as_uint(ps), __float_as_uint(ps), false, false);
    ps = __uint_as_float(rr[0]) + __uint_as_float(rr[1]); }
  l_reg = l_reg * alpha + ps;
#define PK4(P, BASE, OUT) do { unsigned a0 = cvtpk(P[BASE + 0], P[BASE + 1]), a1 = cvtpk(P[BASE + 2], P[BASE + 3]);   \
    unsigned b0 = cvtpk(P[BASE + 4], P[BASE + 5]), b1 = cvtpk(P[BASE + 6], P[BASE + 7]);                              \
    auto r0 = __builtin_amdgcn_permlane32_swap(a0, b0, false, false); auto r1 = __builtin_amdgcn_permlane32_swap(a1, b1, false, false); \
    u32x4 w = {r0[0], r1[0], r0[1], r1[1]}; OUT = *reinterpret_cast<bf16x8*>(&w); } while (0)
  PK4(p0, 0, pa0); PK4(p0, 8, pa1); PK4(p1, 0, pa2); PK4(p1, 8, pa3);
#undef PK4
}
__device__ __forceinline__ void qkt(f32x16& p0, f32x16& p1, const bf16* Ks, const bf16x8* qr, int r32, int hi) {
  p0 = f32x16{}; p1 = f32x16{};
  for (int d0 = 0; d0 < 8; ++d0) { int cb = (d0 * 16 + hi * 8) * 2;
    bf16x8 b0 = *reinterpret_cast<const bf16x8*>((const char*)Ks + KSWZ(r32, cb));
    bf16x8 b1 = *reinterpret_cast<const bf16x8*>((const char*)Ks + KSWZ(32 + r32, cb));
    p0 = __builtin_amdgcn_mfma_f32_32x32x16_bf16(b0, qr[d0], p0, 0, 0, 0);
    p1 = __builtin_amdgcn_mfma_f32_32x32x16_bf16(b1, qr[d0], p1, 0, 0, 0); }
}
__device__ __forceinline__ int v_st(int k, int c) { const int kk = (k & ~0xC) | ((k & 4) << 1) | ((k & 8) >> 1); return ((kk >> 3) * 4 + (c >> 5)) * 512 + ((kk & 7) * 32 + (c & 31)) * 2; }
__device__ __forceinline__ int v_rd_base(int lane) { return ((lane & 3) << 3) | (((lane >> 2) & 3) << 6) | (((lane >> 4) & 1) << 5) | (((lane >> 5) & 1) << 8); }
constexpr int v_rd_off(int d0, int ks, int half) { return d0 * 512 + ks * 4096 + half * 2048; }
template <int OFF> __device__ __forceinline__ s16x4 tr_read(int vb) {
  s16x4 r; asm volatile("ds_read_b64_tr_b16 %0, %1 offset:%2" : "=&v"(r) : "v"(vb), "i"(OFF) : "memory"); return r;
}
template <int D0> __device__ __forceinline__ void pv_one(f32x16& od, int vb, bf16x8 pa0, bf16x8 pa1, bf16x8 pa2, bf16x8 pa3) {
  const s16x4 l0 = tr_read<v_rd_off(D0, 0, 0)>(vb), h0 = tr_read<v_rd_off(D0, 0, 1)>(vb), l1 = tr_read<v_rd_off(D0, 1, 0)>(vb), h1 = tr_read<v_rd_off(D0, 1, 1)>(vb);
  const s16x4 l2 = tr_read<v_rd_off(D0, 2, 0)>(vb), h2 = tr_read<v_rd_off(D0, 2, 1)>(vb), l3 = tr_read<v_rd_off(D0, 3, 0)>(vb), h3 = tr_read<v_rd_off(D0, 3, 1)>(vb);
  asm volatile("s_waitcnt lgkmcnt(0)" ::: "memory"); SBAR();
#define PK(L, H) (bf16x8){L[0], L[1], L[2], L[3], H[0], H[1], H[2], H[3]}
  od = __builtin_amdgcn_mfma_f32_32x32x16_bf16(pa0, PK(l0, h0), od, 0, 0, 0);
  od = __builtin_amdgcn_mfma_f32_32x32x16_bf16(pa1, PK(l1, h1), od, 0, 0, 0);
  od = __builtin_amdgcn_mfma_f32_32x32x16_bf16(pa2, PK(l2, h2), od, 0, 0, 0);
  od = __builtin_amdgcn_mfma_f32_32x32x16_bf16(pa3, PK(l3, h3), od, 0, 0, 0);
#undef PK
}
__device__ __forceinline__ void pv_d0(f32x16* o, int vb, bf16x8 pa0, bf16x8 pa1, bf16x8 pa2, bf16x8 pa3) {
  pv_one<0>(o[0], vb, pa0, pa1, pa2, pa3); pv_one<1>(o[1], vb, pa0, pa1, pa2, pa3); pv_one<2>(o[2], vb, pa0, pa1, pa2, pa3); pv_one<3>(o[3], vb, pa0, pa1, pa2, pa3);
}

template <typename TQ>
__device__ __forceinline__ void attn_dense_body(const TQ* __restrict__ Qb, const bf16* __restrict__ Kh, const bf16* __restrict__ Vh,
                                                bf16* __restrict__ Ob, int seq, char* lds, int wv_) {
  using St = Stage<bf16>; using SQ = Stage<TQ>;
  const int tid = ltid(), wid = tid >> 6, lane = tid & 63, r32 = lane & 31, hi = lane >> 5;
  bf16* V_lds = (bf16*)lds; bf16* K_lds = (bf16*)(lds + 2 * SHM_V);
  float* ws = (float*)(lds + 2 * SHM_V + 2 * SHM_K) + wid * 64; float* li_l = ws; float* al_l = ws + 32;
  float m_reg = -1e30f, l_reg = 0; f32x16 o[4] = {}; bf16x8 qr[8];
  const TQ* Qw = Qb + (long)(wid * QBLK + r32) * LDQ + hi * 8;
#pragma unroll
  for (int d0 = 0; d0 < 8; ++d0) qr[d0] = SQ::tobf(SQ::ld8(Qw + d0 * 16));
  const int sr = tid >> 4, sc = (tid & 15) * 8, vst0 = v_st(sr, sc), vst1 = v_st(32 + sr, sc);
  const int vb0 = (int)(uintptr_t)V_lds + v_rd_base(lane);
  struct { typename St::T vs0, vs1, ks0, ks1; } sr_[SDEPTH];
#define SLOAD(i, k0) do { sr_[i].vs0 = St::ld8(&Vh[(long)((k0) + sr) * LDK + sc]); sr_[i].vs1 = St::ld8(&Vh[(long)((k0) + 32 + sr) * LDK + sc]); \
    sr_[i].ks0 = St::ld8(&Kh[(long)((k0) + sr) * LDK + sc]); sr_[i].ks1 = St::ld8(&Kh[(long)((k0) + 32 + sr) * LDK + sc]); } while (0)
#define SWRITE(b, i) do { *(bf16x8*)((char*)V_lds + (b) * SHM_V + vst0) = St::tobf(sr_[i].vs0);          \
    *(bf16x8*)((char*)V_lds + (b) * SHM_V + vst1) = St::tobf(sr_[i].vs1); int kc = sc * 2;               \
    *(bf16x8*)((char*)K_lds + (b) * SHM_K + KSWZ(sr, kc)) = St::tobf(sr_[i].ks0);                       \
    *(bf16x8*)((char*)K_lds + (b) * SHM_K + KSWZ(32 + sr, kc)) = St::tobf(sr_[i].ks1); } while (0)
#define SWAIT() do { if constexpr (SDEPTH == 2) asm volatile("s_waitcnt vmcnt(4)" ::: "memory"); else asm volatile("s_waitcnt vmcnt(0)" ::: "memory"); } while (0)
#define RESC(a) do { if (__any((a) < 1.f)) { if (hi == 0) al_l[r32] = (a); asm volatile("s_waitcnt lgkmcnt(0)" ::: "memory"); \
    for (int d = 0; d < 4; ++d) for (int r = 0; r < 16; ++r) o[d][r] *= al_l[crow(r, hi)]; } } while (0)
  f32x16 pA0, pA1, pB0, pB1; float mnA, mnB, alA, alB; bf16x8 pa0, pa1, pa2, pa3; const int NT = seq / KVBLK;
  constexpr int SE = 0, SO = SDEPTH - 1;
  SLOAD(SE, 0); asm volatile("s_waitcnt vmcnt(0)" ::: "memory"); SWRITE(0, SE); __syncthreads();
  qkt(pA0, pA1, K_lds, qr, r32, hi); partialSM(pA0, pA1, m_reg, mnA, alA);
  SLOAD(SO, KVBLK); if constexpr (SDEPTH == 2) { if (2 < NT) SLOAD(SE, 2 * KVBLK); }
  SWAIT(); SWRITE(1, SO); __syncthreads();
  for (int j = 1; j + 1 < NT; j += 2) {
    SBAR(); qkt(pB0, pB1, (bf16*)((char*)K_lds + SHM_K), qr, r32, hi);
    finishSM(pA0, pA1, alA, l_reg, pa0, pa1, pa2, pa3); SBAR();
    SLOAD(SO, (j + SDEPTH) * KVBLK); SBAR();
    pv_d0(o, vb0, pa0, pa1, pa2, pa3); partialSM(pB0, pB1, m_reg, mnB, alB);
    __syncthreads(); SWAIT(); SWRITE(0, SE);
    RESC(alB); __syncthreads();
    SBAR(); qkt(pA0, pA1, K_lds, qr, r32, hi);
    finishSM(pB0, pB1, alB, l_reg, pa0, pa1, pa2, pa3); SBAR();
    if (SDEPTH == 1 || j + 3 < NT) SLOAD(SE, (j + 1 + SDEPTH) * KVBLK); SBAR();
    pv_d0(o, vb0 + (int)SHM_V, pa0, pa1, pa2, pa3); partialSM(pA0, pA1, m_reg, mnA, alA);
    __syncthreads(); SWAIT(); SWRITE(1, SO);
    RESC(alA); __syncthreads();
  }
  SBAR(); qkt(pB0, pB1, (bf16*)((char*)K_lds + SHM_K), qr, r32, hi);
  finishSM(pA0, pA1, alA, l_reg, pa0, pa1, pa2, pa3); SBAR();
  pv_d0(o, vb0, pa0, pa1, pa2, pa3); partialSM(pB0, pB1, m_reg, mnB, alB);
  __syncthreads(); RESC(alB);
  finishSM(pB0, pB1, alB, l_reg, pa0, pa1, pa2, pa3); SBAR();
  pv_d0(o, vb0 + (int)SHM_V, pa0, pa1, pa2, pa3);
  if (hi == 0) li_l[r32] = l_reg; asm volatile("s_waitcnt lgkmcnt(0)" ::: "memory");
  float rli[16];
#pragma unroll
  for (int r = 0; r < 16; ++r) rli[r] = __builtin_amdgcn_rcpf(li_l[crow(r, hi)]);
  bf16* Ow = Ob + (long)(wid * QBLK) * LDO;
#pragma unroll
  for (int r = 0; r < 16; ++r) { int orow = crow(r, hi);
    for (int d0 = 0; d0 < 4; ++d0) Ow[(long)orow * LDO + d0 * 32 + r32] = f2bf_rne(o[d0][r] * rli[r]); }
#undef SLOAD
#undef SWRITE
#undef SWAIT
#undef RESC
}
}

typedef unsigned short bf16;
typedef float f32x4 __attribute__((ext_vector_type(4)));
typedef unsigned u32x4 __attribute__((ext_vector_type(4)));
typedef unsigned u32x2 __attribute__((ext_vector_type(2)));
typedef _Float16 h16x4 __attribute__((ext_vector_type(4)));
#define DI __device__ __forceinline__

constexpr int DM = 2048, NBATCH = 4, SEQL = 4096, CTXL = 256, TT = SEQL + CTXL  , MROWS = NBATCH * TT  ;
constexpr int FF = 5632, NLAYER = 2, NMODV = 9 * DM  ;
constexpr int ZW = 5376;
constexpr int ZGQ = 0, ZGK = 256, ZGV = 512, ZGR = 1024, ZDQ = 1536, ZDK = 2048, ZDV = 2560, ZDG = 3072, ZAQ = 3584, ZAK = 4608, ZAV = 4864, ZWA1 = 5120, ZWAB = 5152;
constexpr float LN_EPS = 1e-6f;
constexpr float DN_ALPHA = 1.4142135623730951f;
constexpr int NTHR = 512, NWAVE = 8;

constexpr size_t MiB = 1u << 20;
constexpr size_t WS_CTL = 0, CTL_ZERO_BYTES = 1 * MiB;
constexpr size_t WS_MOD = 1 * MiB;
constexpr size_t WS_ROPE = 2 * MiB;
constexpr size_t WS_WGU = 4 * MiB;
constexpr size_t WGU_ELEMS = (size_t)2 * FF * DM;
constexpr size_t WS_WD = 180 * MiB;
constexpr size_t WD_ELEMS = (size_t)DM * FF;
constexpr size_t WS_WIN = 268 * MiB;
constexpr size_t WIN_ELEMS = (size_t)ZW * DM;
constexpr size_t WS_WOUT = 310 * MiB;
constexpr size_t WOUT_ELEMS = (size_t)DM * DM;
constexpr size_t WS_XS = 326 * MiB;
constexpr size_t WS_H = 462 * MiB;
constexpr size_t WS_ACT = 530 * MiB;
constexpr size_t WS_LA = 717 * MiB;
constexpr size_t WS_DQ = 751 * MiB, WS_DK = 768 * MiB, WS_DV = 785 * MiB;
constexpr size_t WS_DBG = 802 * MiB;
constexpr size_t WS_AQ = 804 * MiB;
constexpr size_t WS_AKV = 838 * MiB;
constexpr size_t WS_GLAO = 855 * MiB;
constexpr size_t WS_DNO = 923 * MiB;
constexpr size_t WS_END = 991 * MiB;
constexpr size_t WS_DELTA = WS_GLAO;
constexpr size_t WS_PART = 1060 * MiB;
static_assert(WS_WGU + 4 * WGU_ELEMS * 2 <= WS_WD && WS_WD + 4 * WD_ELEMS * 2 <= WS_WIN && WS_WIN + 2 * WIN_ELEMS * 2 <= WS_WOUT && WS_WOUT + 2 * WOUT_ELEMS * 2 <= WS_XS, "ws map (weights)");
static_assert(WS_XS + (size_t)MROWS * DM * 4 <= WS_H && WS_H + (size_t)MROWS * DM * 2 <= WS_ACT && WS_ACT + (size_t)MROWS * FF * 2 <= WS_LA, "ws map (stream)");
static_assert(WS_LA + (size_t)2 * MROWS * 256 * 4 <= WS_DQ && WS_DQ + (size_t)MROWS * 512 * 2 <= WS_DK && WS_DV + (size_t)MROWS * 512 * 2 <= WS_DBG && WS_DBG + (size_t)4 * MROWS * 4 * 4 <= WS_AQ, "ws map (mixer 1)");
static_assert(WS_AQ + (size_t)MROWS * 1024 * 2 <= WS_AKV && WS_AKV + (size_t)MROWS * 512 * 2 <= WS_GLAO && WS_GLAO + (size_t)2 * MROWS * 512 * 4 <= WS_DNO && WS_DNO + (size_t)2 * MROWS * 512 * 4 <= WS_END, "ws map (mixer 2)");

struct Params {
    const float *x, *c, *ctx, *c_ctx, *w_ada, *b_ada, *ln_g, *ln_b, *w_gate, *w_up, *w_down, *w_in, *gla_wa1, *gla_wa2, *gla_ba, *gla_norm_g,
                *dn_conv, *dn_wab, *dn_a_log, *dn_dt_bias, *dn_norm_g, *q_norm_g, *k_norm_g, *w_out;
    float* out; unsigned char* ws;
};

#define GIN(p) ((const float*)(const GAS1 float*)(p))
typedef const __attribute__((address_space(4))) Params* KP;
typedef float f32x2_t __attribute__((ext_vector_type(2)));
typedef __bf16 bf16x2_t __attribute__((ext_vector_type(2)));
DI unsigned pk2(float lo, float hi) { const f32x2_t v = {lo, hi}; const bf16x2_t b = __builtin_convertvector(v, bf16x2_t); return __builtin_bit_cast(unsigned, b); }
DI unsigned f2bf(float f) { return pk2(f, 0.f) & 0xffffu; }
DI float bf2f(unsigned short b) { return __builtin_bit_cast(float, (unsigned)b << 16); }
DI float bflo(unsigned w) { return __builtin_bit_cast(float, w << 16); }
DI float bfhi(unsigned w) { return __builtin_bit_cast(float, w & 0xffff0000u); }
template <int MASK> DI float shx(float v) {
    static_assert(MASK >= 1 && MASK <= 32, "xor mask");
    if constexpr (MASK < 32) return __builtin_bit_cast(float, __builtin_amdgcn_ds_swizzle(__builtin_bit_cast(int, v), 0x1F | (MASK << 10)));
    else { const unsigned u = __builtin_bit_cast(unsigned, v); auto r = __builtin_amdgcn_permlane32_swap(u, u, false, false);
           const unsigned mine = __builtin_bit_cast(unsigned, v); return __builtin_bit_cast(float, r[0] == mine ? r[1] : r[0]); }
}
DI float wave_sum(float v) {
    v += shx<1>(v); v += shx<2>(v); v += shx<4>(v); v += shx<8>(v); v += shx<16>(v);
    return __builtin_bit_cast(float, __builtin_amdgcn_readlane(__builtin_bit_cast(int, v), 0)) + __builtin_bit_cast(float, __builtin_amdgcn_readlane(__builtin_bit_cast(int, v), 32));
    return v;
}
DI float silu_f(float v) { return v * __builtin_amdgcn_rcpf(1.0f + __builtin_amdgcn_exp2f(-1.4426950408889634f * v)); }
DI float log1pexp_neg_abs(float x) { return 0.6931471805599453f * __builtin_amdgcn_logf(1.0f + __builtin_amdgcn_exp2f(-1.4426950408889634f * fabsf(x))); }
DI float softplus_f(float x) { return fmaxf(x, 0.f) + log1pexp_neg_abs(x); }
DI float logsigmoid_f(float x) { return fminf(x, 0.f) - log1pexp_neg_abs(x); }
DI float rsqrt_f(float x) { return __builtin_amdgcn_rsqf(x); }

DI void phase_mod(KP P, char* lds, int bid, int nb, int wv_) {
    const gptr_t ws_ = lptr(P->ws);
    const int tid = ltid(), lane = tid & 63, ks = tid >> 6;
    float* s = (float*)lds;
    float* red = s + 5 * 2048;
    {
        float cv[20];
#pragma unroll
        for (int q = 0; q < 20; ++q) { const int i = tid + 512 * q, j = i >> 11, k = i & 2047; cv[q] = j < 4 ? GIN(P->c)[j * 2048 + k] : GIN(P->c_ctx)[k]; }
#pragma unroll
        for (int q = 0; q < 20; ++q) s[tid + 512 * q] = silu_f(cv[q]);
    }
    __syncthreads();
    float* MOD = (float*)(ws_ + WS_MOD);
    {
        const int l = bid >> 7, n0 = (bid & 127) * 144; const bool act = lane < 36;
        const float* w = GIN(P->w_ada) + ((size_t)l * 2048 + ks * 256) * NMODV + n0 + 4 * (act ? lane : 0);
        f32x4 a[5];
#pragma unroll
        for (int j = 0; j < 5; ++j) a[j] = (f32x4){0.f, 0.f, 0.f, 0.f};
        f32x4 wa[8], wb[8];
        auto fetch = [&](int k0, f32x4 (&wv)[8]) {
#pragma unroll
            for (int q = 0; q < 8; ++q) wv[q] = act ? __builtin_nontemporal_load((const f32x4*)(w + (size_t)(k0 + q) * NMODV)) : (f32x4){0.f, 0.f, 0.f, 0.f}; };
        auto fma16 = [&](int k0, const f32x4 (&wv)[8]) {
#pragma unroll
            for (int q = 0; q < 8; ++q) { const int kk = ks * 256 + k0 + q;
#pragma unroll
                for (int j = 0; j < 5; ++j) a[j] += wv[q] * s[j * 2048 + kk]; } };
        fetch(0, wa);
#pragma unroll 1
        for (int k0 = 0; k0 < 256; k0 += 16) {
            fetch(k0 + 8, wb);
            fma16(k0, wa);
            if (k0 + 16 < 256) fetch(k0 + 16, wa);
            fma16(k0 + 8, wb);
        }
        if (act) {
#pragma unroll
            for (int j = 0; j < 5; ++j) *(f32x4*)(red + (ks * 5 + j) * 144 + 4 * lane) = a[j]; }
        __syncthreads();
        if (tid < 320 && act) { const int j = tid >> 6; f32x4 sum = *(const f32x4*)(GIN(P->b_ada) + (size_t)l * NMODV + n0 + 4 * lane);
#pragma unroll
            for (int q = 0; q < 8; ++q) sum += *(const f32x4*)(red + (q * 5 + j) * 144 + 4 * lane);
            *(f32x4*)(MOD + ((size_t)l * 5 + j) * NMODV + n0 + 4 * lane) = sum; }
        __syncthreads();
    }
    if (bid == nb - 1) {
        float* R = (float*)(ws_ + WS_ROPE);
        for (int e = tid; e < 64 * 32; e += NTHR) { const int pos = e >> 5, i = e & 31; const float inv = powf(10000.0f, -(float)(2 * i) / 64.0f); const float ang = (float)pos * inv;
            R[2 * e] = cosf(ang); R[2 * e + 1] = sinf(ang); }
    }
}

struct WTile { const float* src; bf16* dst; int N, K, k0, n0; bool plain; };
DI float win_elem(KP P, int l, int k, int n) {
    if (n < 5120) return GIN(P->w_in)[((size_t)l * DM + k) * 5120 + n];
    if (n < 5136) return GIN(P->gla_wa1)[((size_t)(l * 2 + 0) * DM + k) * 16 + n - 5120];
    if (n < 5152) return GIN(P->gla_wa1)[((size_t)(l * 2 + 1) * DM + k) * 16 + n - 5136];
    if (n < 5160) return GIN(P->dn_wab)[((size_t)(l * 2 + 0) * DM + k) * 8 + n - 5152];
    if (n < 5168) return GIN(P->dn_wab)[((size_t)(l * 2 + 1) * DM + k) * 8 + n - 5160];
    return 0.f;
}
DI void phase_wcvt(KP P, char* lds, int bid, int nb, int wv_) {
    const gptr_t ws_ = lptr(P->ws);
    const int tid = ltid();
    float* scr = (float*)lds;
    constexpr int T_GU = 32 * 88, T_D = 88 * 16, T_IN = 32 * 42, T_OUT = 32 * 16;
    constexpr int NT = 4 * T_GU + 4 * T_D + 2 * T_IN + 2 * T_OUT;
    int lgen = 0;
#define WT_DESC(it, T) do { int r = (it); \
        if (r < 4 * T_GU) { const int m = r / T_GU, tile = r % T_GU, kb = tile / 88, j = tile % 88; \
            T.src = ((j & 1) ? GIN(P->w_up) : GIN(P->w_gate)) + (size_t)m * DM * FF + (size_t)(kb * 64) * FF + (j >> 1) * 128; T.N = FF; T.K = DM; T.k0 = kb * 64; T.n0 = j * 128; \
            T.dst = (bf16*)(ws_ + WS_WGU) + (size_t)m * WGU_ELEMS; T.plain = true; } \
        else if ((r -= 4 * T_GU) < 4 * T_D) { const int m = r / T_D, tile = r % T_D, kb = tile / 16, j = tile % 16; \
            T.src = GIN(P->w_down) + (size_t)m * FF * DM + (size_t)(kb * 64) * DM + j * 128; T.N = DM; T.K = FF; T.k0 = kb * 64; T.n0 = j * 128; \
            T.dst = (bf16*)(ws_ + WS_WD) + (size_t)m * WD_ELEMS; T.plain = true; } \
        else if ((r -= 4 * T_D) < 2 * T_IN) { const int l = r / T_IN, tile = r % T_IN, kb = tile / 42, j = tile % 42; \
            T.src = GIN(P->w_in) + (size_t)l * DM * 5120 + (size_t)(kb * 64) * 5120 + j * 128; T.N = 5120; T.K = DM; T.k0 = kb * 64; T.n0 = j * 128; \
            T.dst = (bf16*)(ws_ + WS_WIN) + (size_t)l * WIN_ELEMS; T.plain = j < 40; lgen = l; } \
        else { r -= 2 * T_IN; const int l = r / T_OUT, tile = r % T_OUT, kb = tile / 16, j = tile % 16; \
            T.src = GIN(P->w_out) + (size_t)l * DM * DM + (size_t)(kb * 64) * DM + j * 128; T.N = DM; T.K = DM; T.k0 = kb * 64; T.n0 = j * 128; \
            T.dst = (bf16*)(ws_ + WS_WOUT) + (size_t)l * WOUT_ELEMS; T.plain = true; } } while (0)
    WTile cur; f32x4 pre[4];
    int it = bid;
    if (it < NT) { WT_DESC(it, cur);
        if (cur.plain) {
#pragma unroll
            for (int i = 0; i < 4; ++i) { const int q = tid + 512 * i; pre[i] = __builtin_nontemporal_load((const f32x4*)(cur.src + (size_t)(q >> 5) * cur.N + (q & 31) * 4)); } } }
    for (; it < NT; it += nb) {
        const int lg = lgen;
        if (cur.plain) {
#pragma unroll
            for (int i = 0; i < 4; ++i) { const int q = tid + 512 * i; *(f32x4*)(scr + (q >> 5) * 132 + (q & 31) * 4) = pre[i]; }
        } else {
            {
                const int nn = tid & 127, n = cur.n0 + nn, k_first = cur.k0 + (tid >> 7);
                const float* bp = GIN(P->w_in); size_t rs = 0; bool valid = n < 5168;
                if (n < 5120)      { bp = GIN(P->w_in) + ((size_t)lg * DM + k_first) * 5120 + n; rs = 5120; }
                else if (n < 5136) { bp = GIN(P->gla_wa1) + ((size_t)(lg * 2 + 0) * DM + k_first) * 16 + n - 5120; rs = 16; }
                else if (n < 5152) { bp = GIN(P->gla_wa1) + ((size_t)(lg * 2 + 1) * DM + k_first) * 16 + n - 5136; rs = 16; }
                else if (n < 5160) { bp = GIN(P->dn_wab) + ((size_t)(lg * 2 + 0) * DM + k_first) * 8 + n - 5152; rs = 8; }
                else if (n < 5168) { bp = GIN(P->dn_wab) + ((size_t)(lg * 2 + 1) * DM + k_first) * 8 + n - 5160; rs = 8; }
                float ev[16];
#pragma unroll
                for (int i = 0; i < 16; ++i) ev[i] = bp[(size_t)(i * 4) * rs];
#pragma unroll
                for (int i = 0; i < 16; ++i) scr[(i * 4 + (tid >> 7)) * 132 + nn] = valid ? ev[i] : 0.f; }
        }
        const WTile done = cur;
        if (it + nb < NT) { WT_DESC(it + nb, cur);
            if (cur.plain) {
#pragma unroll
                for (int i = 0; i < 4; ++i) { const int q = tid + 512 * i; pre[i] = __builtin_nontemporal_load((const f32x4*)(cur.src + (size_t)(q >> 5) * cur.N + (q & 31) * 4)); } } }
        __syncthreads();
#pragma unroll
        for (int i = 0; i < 2; ++i) { const int q = tid + 512 * i, nn = q >> 3, kc = q & 7; const float* sp = scr + (kc * 8) * 132 + nn;
            u32x4 o; o.x = pk2(sp[0], sp[132]); o.y = pk2(sp[2 * 132], sp[3 * 132]); o.z = pk2(sp[4 * 132], sp[5 * 132]); o.w = pk2(sp[6 * 132], sp[7 * 132]);
            *(u32x4*)(done.dst + (size_t)(done.n0 + nn) * done.K + done.k0 + kc * 8) = o; }
        __syncthreads();
    }
#undef WT_DESC
}


DI void phase_init(KP P, char* lds, int bid, int wv_) {
    const gptr_t ws_ = lptr(P->ws);
    const int lane = ltid() & 63, wave = ltid() >> 6;
    _Float16* XS = (_Float16*)(ws_ + WS_XS); bf16* H = (bf16*)(ws_ + WS_H); const float* MOD = (const float*)(ws_ + WS_MOD);
    float* L = (float*)lds;
    { const int tid = ltid(); f32x4 sv[10];
#pragma unroll
      for (int m = 0; m < 5; ++m) { const float* sh = MOD + (size_t)m * NMODV; sv[2 * m] = *(const f32x4*)(sh + 4 * tid); sv[2 * m + 1] = *(const f32x4*)(sh + DM + 4 * tid); }
#pragma unroll
      for (int m = 0; m < 10; ++m) *(f32x4*)(L + m * DM + 4 * tid) = sv[m]; }
    __syncthreads();
    auto put = [&](const f32x4 (&v)[8], size_t r, int mi) {
#pragma unroll
        for (int j = 0; j < 8; ++j) __builtin_nontemporal_store(__builtin_convertvector(v[j] * DN_ALPHA, h16x4), (h16x4*)(XS + r * DM + 4 * lane + 256 * j));
        const float* sh = L + 2 * mi * DM + 4 * lane; const float* sc = sh + DM;
#pragma unroll
        for (int j = 0; j < 8; ++j) { const f32x4 a = *(const f32x4*)(sh + 256 * j), c = *(const f32x4*)(sc + 256 * j);
            const f32x4 h = v[j] * (c + 1.0f) + a; u32x2 w; w.x = pk2(h.x, h.y); w.y = pk2(h.z, h.w);
            *(u32x2*)(H + r * DM + 4 * lane + 256 * j) = w; }
    };
    auto fetch = [&](int k, f32x4 (&v)[8]) { const int q = k * 2048 + bid * NWAVE + wave; const float* s = GIN(P->x) + (size_t)q * DM + 4 * lane;
#pragma unroll
        for (int j = 0; j < 8; ++j) v[j] = __builtin_nontemporal_load((const f32x4*)(s + 256 * j)); };
    auto rowof = [&](int k) -> size_t { const int q = k * 2048 + bid * NWAVE + wave; return (size_t)(q >> 12) * TT + CTXL + (q & 4095); };
    f32x4 va[8], vb[8];
    fetch(0, va);
#pragma unroll
    for (int k = 0; k < 8; k += 2) {
        fetch(k + 1, vb);
        put(va, rowof(k), k >> 1);
        if (k + 2 < 8) fetch(k + 2, va);
        put(vb, rowof(k + 1), k >> 1);
    }
    if (wave < 4) { const int c = bid * 4 + wave; const float* s = GIN(P->ctx) + (size_t)c * DM + 4 * lane;
#pragma unroll
        for (int j = 0; j < 8; ++j) va[j] = __builtin_nontemporal_load((const f32x4*)(s + 256 * j));
        put(va, (size_t)(c >> 8) * TT + (c & 255), 4); }
}

template <bool FINAL> DI void phase_ln(KP P, char* lds, int l_ln, int which, int l_mod, int shift_idx, bool skip_ctx, int nparts, int bid, int wv_) {
    const gptr_t ws_ = lptr(P->ws);
    const int lane = ltid() & 63, wave = ltid() >> 6;
    _Float16* XS = (_Float16*)(ws_ + WS_XS); bf16* H = (bf16*)(ws_ + WS_H); const float* MOD = (const float*)(ws_ + WS_MOD);
    const bf16* DEL = (const bf16*)(ws_ + WS_DELTA);
    float* L = (float*)lds;
    { const int tid = ltid();
      const float* g = GIN(P->ln_g) + (size_t)(l_ln * 3 + which) * DM; const float* bb = GIN(P->ln_b) + (size_t)(l_ln * 3 + which) * DM;
      constexpr int NV = FINAL ? 2 : 12; f32x4 sv[NV];
      sv[0] = *(const f32x4*)(g + 4 * tid); sv[1] = *(const f32x4*)(bb + 4 * tid);
      if constexpr (!FINAL) {
#pragma unroll
          for (int m = 0; m < 5; ++m) { const float* sh = MOD + ((size_t)l_mod * 5 + m) * NMODV + (size_t)shift_idx * DM;
              sv[2 + 2 * m] = *(const f32x4*)(sh + 4 * tid); sv[3 + 2 * m] = *(const f32x4*)(sh + DM + 4 * tid); } }
#pragma unroll
      for (int m = 0; m < NV; ++m) *(f32x4*)(L + m * DM + 4 * tid) = sv[m]; }
    auto finish = [&](f32x4 (&v)[8], size_t r, int mi, int b, int t) {
        float s = 0.f;
#pragma unroll
        for (int j = 0; j < 8; ++j) s += (v[j].x + v[j].y) + (v[j].z + v[j].w);
        const float mean = wave_sum(s) * (1.0f / DM); float s2 = 0.f;
#pragma unroll
        for (int j = 0; j < 8; ++j) { v[j] = v[j] - mean; s2 += (v[j].x * v[j].x + v[j].y * v[j].y) + (v[j].z * v[j].z + v[j].w * v[j].w); }
        const float rstd = rsqrt_f(wave_sum(s2) * (1.0f / DM) + LN_EPS);
#pragma unroll
        for (int j = 0; j < 8; ++j) { const f32x4 gg = *(const f32x4*)(L + 4 * lane + 256 * j), bv = *(const f32x4*)(L + DM + 4 * lane + 256 * j); v[j] = v[j] * rstd * gg + bv; }
        if constexpr (FINAL) { float* o = P->out + ((size_t)b * SEQL + (t - CTXL)) * DM + 4 * lane;
#pragma unroll
            for (int j = 0; j < 8; ++j) __builtin_nontemporal_store(v[j], (f32x4*)(o + 256 * j));
            return; }
#pragma unroll
        for (int j = 0; j < 8; ++j) __builtin_nontemporal_store(__builtin_convertvector(v[j] * DN_ALPHA, h16x4), (h16x4*)(XS + r * DM + 4 * lane + 256 * j));
        if constexpr (!FINAL) {
            const float* sh = L + (2 + 2 * mi) * DM + 4 * lane; const float* sc = sh + DM;
#pragma unroll
            for (int j = 0; j < 8; ++j) { const f32x4 a = *(const f32x4*)(sh + 256 * j), c = *(const f32x4*)(sc + 256 * j);
                const f32x4 h = v[j] * (c + 1.0f) + a; u32x2 w; w.x = pk2(h.x, h.y); w.y = pk2(h.z, h.w);
                *(u32x2*)(H + r * DM + 4 * lane + 256 * j) = w; }
        }
    };
    h16x4 xa[8], xb[8]; u32x2 da[8], db[8];
    auto rowof = [&](int k) -> size_t { const int q = k * 2048 + bid * NWAVE + wave; return (size_t)(q >> 12) * TT + CTXL + (q & 4095); };
    auto prefetch = [&](int k, h16x4 (&xr)[8], u32x2 (&dr)[8]) { const size_t r = rowof(k);
#pragma unroll
        for (int j = 0; j < 8; ++j) { xr[j] = __builtin_nontemporal_load((const h16x4*)(XS + r * DM + 4 * lane + 256 * j)); dr[j] = *(const u32x2*)(DEL + r * DM + 4 * lane + 256 * j); } };
    auto consume = [&](f32x4 (&v)[8], const h16x4 (&xr)[8], const u32x2 (&dr)[8]) {
#pragma unroll
        for (int j = 0; j < 8; ++j) v[j] = __builtin_convertvector(xr[j], f32x4) + (f32x4){bflo(dr[j].x), bfhi(dr[j].x), bflo(dr[j].y), bfhi(dr[j].y)}; };
    auto fin_lat = [&](f32x4 (&v)[8], int k) { const int q = k * 2048 + bid * NWAVE + wave; const int b = q >> 12, t = CTXL + (q & 4095); finish(v, (size_t)b * TT + t, b, b, t); };
    prefetch(0, xa, da); prefetch(1, xb, db);
    __syncthreads();
    if (!(FINAL || skip_ctx) && wave < 4) {
        const int c = bid * 4 + wave, b = c >> 8, t = c & 255; const size_t r = (size_t)b * TT + t;
        f32x4 v[8]; h16x4 xc[8];
#pragma unroll
        for (int j = 0; j < 8; ++j) xc[j] = __builtin_nontemporal_load((const h16x4*)(XS + r * DM + 4 * lane + 256 * j));
        if (nparts == 0) { u32x2 w[8];
#pragma unroll
            for (int j = 0; j < 8; ++j) w[j] = *(const u32x2*)(DEL + r * DM + 4 * lane + 256 * j);
#pragma unroll
            for (int j = 0; j < 8; ++j) v[j] = __builtin_convertvector(xc[j], f32x4) + (f32x4){bflo(w[j].x), bfhi(w[j].x), bflo(w[j].y), bfhi(w[j].y)};
        } else {
            const bf16* ps = (const bf16*)(ws_ + WS_PART) + (size_t)c * DM + 4 * lane;
#pragma unroll
            for (int p0 = 0; p0 < 8; p0 += 4) { u32x2 w[4][8];
#pragma unroll
                for (int p = 0; p < 4; ++p)
#pragma unroll
                    for (int j = 0; j < 8; ++j) w[p][j] = *(const u32x2*)(ps + (size_t)(p0 + p) * 1024 * DM + 256 * j);
                if (p0 == 0) {
#pragma unroll
                    for (int j = 0; j < 8; ++j) v[j] = __builtin_convertvector(xc[j], f32x4); }
#pragma unroll
                for (int p = 0; p < 4; ++p)
#pragma unroll
                    for (int j = 0; j < 8; ++j) v[j] += (f32x4){bflo(w[p][j].x), bfhi(w[p][j].x), bflo(w[p][j].y), bfhi(w[p][j].y)}; } }
        finish(v, r, 4, b, t);
    }
    f32x4 v[8];
    consume(v, xa, da);
#pragma unroll 1
    for (int k = 0; k < 6; k += 2) {
        prefetch(k + 2, xa, da);
        fin_lat(v, k);
        consume(v, xb, db);
        prefetch(k + 3, xb, db);
        fin_lat(v, k + 1);
        consume(v, xa, da);
    }
    fin_lat(v, 6);
    consume(v, xb, db);
    fin_lat(v, 7);
}

template <class Raw, class F, class C> DI void row_pipeline(int rbeg, int rstep, F&& fetch, C&& compute) {
    int r = rbeg; if (r >= MROWS) return;
    Raw raw; fetch(r, raw); Raw cur = raw;
#pragma unroll 1
    while (true) { const int rn = r + rstep; const bool more = rn < MROWS; if (more) fetch(rn, raw); compute(r, cur); if (!more) break; cur = raw; r = rn; }
}
struct PrepRawG { u32x4 za, zb; };
struct PrepRawD { u32x4 zc[3], zp[3], zn[3]; unsigned short zab, zbb; };
struct PrepRawA { u32x4 qa, qb; u32x2 ka, va; f32x4 rq[8], rk[2]; };
DI void phase_prep(KP P, int l, int bid, int nb, int wv_) {
    const gptr_t ws_ = lptr(P->ws);
    const int lane = ltid() & 63, wave = ltid() >> 6;
    const bf16* __restrict__ Z = (const bf16*)(ws_ + WS_ACT);
    float* __restrict__ LA = (float*)(ws_ + WS_LA); bf16* __restrict__ DQ = (bf16*)(ws_ + WS_DQ); bf16* __restrict__ DK = (bf16*)(ws_ + WS_DK); bf16* __restrict__ DV = (bf16*)(ws_ + WS_DV);
    float* __restrict__ DBETA = (float*)(ws_ + WS_DBG); float* __restrict__ DG = DBETA + (size_t)2 * MROWS * 4;
    bf16* __restrict__ AQ = (bf16*)(ws_ + WS_AQ); bf16* __restrict__ AKV = (bf16*)(ws_ + WS_AKV); const float* __restrict__ ROPE = (const float*)(ws_ + WS_ROPE);
    const int rbeg = bid * NWAVE + wave, rstep = nb * NWAVE;
#pragma unroll 1
    for (int d = 0; d < 2; ++d) {
        f32x4 w2r[16];
        const float* w2 = GIN(P->gla_wa2) + (size_t)(l * 2 + d) * 16 * 256 + 4 * lane;
#pragma unroll
        for (int e = 0; e < 16; ++e) w2r[e] = *(const f32x4*)(w2 + e * 256);
        const f32x4 bar = *(const f32x4*)(GIN(P->gla_ba) + (size_t)(l * 2 + d) * 256 + 4 * lane);
        row_pipeline<PrepRawG>(rbeg, rstep,
            [&](int r, PrepRawG& w) { const bf16* z = Z + (size_t)r * ZW + ZWA1 + 16 * d; w.za = *(const u32x4*)z; w.zb = *(const u32x4*)(z + 8); },
            [&](int r, const PrepRawG& w) { const u32x4 za = w.za, zb = w.zb;
                const float z1[16] = {bflo(za.x), bfhi(za.x), bflo(za.y), bfhi(za.y), bflo(za.z), bfhi(za.z), bflo(za.w), bfhi(za.w),
                                      bflo(zb.x), bfhi(zb.x), bflo(zb.y), bfhi(zb.y), bflo(zb.z), bfhi(zb.z), bflo(zb.w), bfhi(zb.w)};
                f32x4 acc = bar;
#pragma unroll
                for (int e = 0; e < 16; ++e) acc += w2r[e] * z1[e];
                f32x4 o; o.x = logsigmoid_f(acc.x) * 0.0625f; o.y = logsigmoid_f(acc.y) * 0.0625f; o.z = logsigmoid_f(acc.z) * 0.0625f; o.w = logsigmoid_f(acc.w) * 0.0625f;
                *(f32x4*)(LA + ((size_t)d * MROWS + r) * 256 + 4 * lane) = o; });
    }
    {
        float cw[3][3][8];
#pragma unroll
        for (int part = 0; part < 3; ++part)
#pragma unroll
            for (int tap = 0; tap < 3; ++tap) { const float* cp = GIN(P->dn_conv) + (size_t)l * 3 * 1536 + tap * 1536 + part * 512 + lane * 8;
                const f32x4 c0 = *(const f32x4*)cp, c1 = *(const f32x4*)(cp + 4);
                cw[part][tap][0] = c0.x; cw[part][tap][1] = c0.y; cw[part][tap][2] = c0.z; cw[part][tap][3] = c0.w; cw[part][tap][4] = c1.x; cw[part][tap][5] = c1.y; cw[part][tap][6] = c1.z; cw[part][tap][7] = c1.w; }
        const float nal = lane < 8 ? -__expf(GIN(P->dn_a_log)[(l * 2 + (lane >> 2)) * 4 + (lane & 3)]) : 0.f, dtb = lane < 8 ? GIN(P->dn_dt_bias)[(l * 2 + (lane >> 2)) * 4 + (lane & 3)] : 0.f;
        row_pipeline<PrepRawD>(rbeg, rstep,
            [&](int r, PrepRawD& w) { const int t = r % TT; const bool isctx = t < CTXL;
                const bf16* z = Z + (size_t)r * ZW;
                const bool has_prev = isctx ? (t > 0) : (t > CTXL), has_next = isctx ? (t < CTXL - 1) : (t < TT - 1);
#pragma unroll
                for (int part = 0; part < 3; ++part) { const int ch = part * 512 + lane * 8;
                    w.zc[part] = *(const u32x4*)(z + ZDQ + ch); w.zp[part] = (u32x4){0u, 0u, 0u, 0u}; w.zn[part] = (u32x4){0u, 0u, 0u, 0u};
                    if (has_prev) w.zp[part] = *(const u32x4*)(z - ZW + ZDQ + ch);
                    if (has_next) w.zn[part] = *(const u32x4*)(z + ZW + ZDQ + ch); }
                w.zab = 0; if (lane < 8) w.zab = z[ZWAB + 8 * (lane >> 2) + (lane & 3)];
                w.zbb = 0; if (lane < 8) w.zbb = z[ZWAB + 8 * (lane >> 2) + 4 + (lane & 3)]; },
            [&](int r, const PrepRawD& w) {
#pragma unroll
                for (int part = 0; part < 3; ++part) {
                    float v[8]; float ss = 0.f;
#pragma unroll
                    for (int e = 0; e < 4; ++e) {
                        const unsigned wp = e == 0 ? w.zp[part].x : e == 1 ? w.zp[part].y : e == 2 ? w.zp[part].z : w.zp[part].w, wc = e == 0 ? w.zc[part].x : e == 1 ? w.zc[part].y : e == 2 ? w.zc[part].z : w.zc[part].w,
                                       wn = e == 0 ? w.zn[part].x : e == 1 ? w.zn[part].y : e == 2 ? w.zn[part].z : w.zn[part].w;
                        const float a0 = bflo(wp) * cw[part][0][2 * e] + bflo(wc) * cw[part][1][2 * e] + bflo(wn) * cw[part][2][2 * e];
                        const float a1 = bfhi(wp) * cw[part][0][2 * e + 1] + bfhi(wc) * cw[part][1][2 * e + 1] + bfhi(wn) * cw[part][2][2 * e + 1];
                        v[2 * e] = silu_f(a0); v[2 * e + 1] = silu_f(a1); ss += v[2 * e] * v[2 * e] + v[2 * e + 1] * v[2 * e + 1];
                    }
                    float scale = 1.f;
                    if (part < 2) { ss += shx<1>(ss); ss += shx<2>(ss); ss += shx<4>(ss); ss += shx<8>(ss);
                        scale = rsqrt_f(ss + LN_EPS); if (part == 0) scale *= 0.08838834764831845f; }
                    u32x4 o; o.x = pk2(v[0] * scale, v[1] * scale); o.y = pk2(v[2] * scale, v[3] * scale); o.z = pk2(v[4] * scale, v[5] * scale); o.w = pk2(v[6] * scale, v[7] * scale);
                    bf16* dst = part == 0 ? DQ : part == 1 ? DK : DV;
                    *(u32x4*)(dst + (size_t)r * 512 + lane * 8) = o;
                }
                if (lane < 8) { const int d = lane >> 2, hh = lane & 3;
                    const float g = nal * softplus_f(bf2f(w.zab) + dtb);
                    const float beta = 1.0f / (1.0f + __expf(-bf2f(w.zbb)));
                    DG[((size_t)d * MROWS + r) * 4 + hh] = g; DBETA[((size_t)d * MROWS + r) * 4 + hh] = beta; } });
    }
    {
        const int l8 = lane & 7, quarter = l8 >> 1, i0 = (l8 & 1) * 16;
        const int l32 = lane & 31, kq = l32 >> 3, ki0 = (l32 & 7) * 4;
        float gq[16], gk[4];
#pragma unroll
        for (int e = 0; e < 16; ++e) gq[e] = GIN(P->q_norm_g)[(size_t)l * 128 + l8 * 16 + e];
#pragma unroll
        for (int e = 0; e < 4; ++e) gk[e] = GIN(P->k_norm_g)[(size_t)l * 128 + l32 * 4 + e];
        row_pipeline<PrepRawA>(rbeg, rstep,
            [&](int r, PrepRawA& w) { const int t = r % TT; const bool isctx = t < CTXL;
                const bf16* z = Z + (size_t)r * ZW;
                const int lt = t - CTXL, prow = lt >> 6, pcol = lt & 63;
                w.qa = *(const u32x4*)(z + ZAQ + lane * 16); w.qb = *(const u32x4*)(z + ZAQ + lane * 16 + 8);
                w.ka = *(const u32x2*)(z + ZAK + lane * 4); w.va = *(const u32x2*)(z + ZAV + lane * 4);
                const int pos = quarter < 2 ? prow : pcol; const float* rp = ROPE + ((size_t)(isctx ? 0 : pos) * 32 + i0) * 2;
                const int kpos = kq < 2 ? prow : pcol; const float* krp = ROPE + ((size_t)(isctx ? 0 : kpos) * 32 + ki0) * 2;
#pragma unroll
                for (int e = 0; e < 8; ++e) w.rq[e] = *(const f32x4*)(rp + 4 * e);
                w.rk[0] = *(const f32x4*)krp; w.rk[1] = *(const f32x4*)(krp + 4); },
            [&](int r, const PrepRawA& w) { const int t = r % TT; const bool isctx = t < CTXL;
                const u32x4 qa = w.qa, qb = w.qb; const u32x2 ka = w.ka, va = w.va;
                float v[16] = {bflo(qa.x), bfhi(qa.x), bflo(qa.y), bfhi(qa.y), bflo(qa.z), bfhi(qa.z), bflo(qa.w), bfhi(qa.w),
                               bflo(qb.x), bfhi(qb.x), bflo(qb.y), bfhi(qb.y), bflo(qb.z), bfhi(qb.z), bflo(qb.w), bfhi(qb.w)};
                float ss = 0.f;
#pragma unroll
                for (int e = 0; e < 16; ++e) ss += v[e] * v[e];
                ss += shx<1>(ss); ss += shx<2>(ss); ss += shx<4>(ss);
                const float rs = rsqrt_f(ss * (1.0f / 128.0f) + LN_EPS);
#pragma unroll
                for (int e = 0; e < 16; ++e) v[e] = v[e] * rs * gq[e];
                unsigned ow[8];
#pragma unroll
                for (int e = 0; e < 16; e += 2) {
                    const float p0 = shx<2>(v[e]), p1 = shx<2>(v[e + 1]);
                    float o0 = v[e], o1 = v[e + 1];
                    if (!isctx) { const f32x4 cs = w.rq[e >> 1]; const float c0 = cs.x, s0 = cs.y, c1 = cs.z, s1 = cs.w;
                        if ((quarter & 1) == 0) { o0 = v[e] * c0 - p0 * s0; o1 = v[e + 1] * c1 - p1 * s1; } else { o0 = v[e] * c0 + p0 * s0; o1 = v[e + 1] * c1 + p1 * s1; } }
                    ow[e >> 1] = pk2(o0, o1);
                }
                u32x4 o0 = {ow[0], ow[1], ow[2], ow[3]}, o1 = {ow[4], ow[5], ow[6], ow[7]};
                *(u32x4*)(AQ + (size_t)r * 1024 + lane * 16) = o0; *(u32x4*)(AQ + (size_t)r * 1024 + lane * 16 + 8) = o1;
                float kv[4] = {bflo(ka.x), bfhi(ka.x), bflo(ka.y), bfhi(ka.y)};
                float ks = kv[0] * kv[0] + kv[1] * kv[1] + kv[2] * kv[2] + kv[3] * kv[3];
                ks += shx<1>(ks); ks += shx<2>(ks); ks += shx<4>(ks); ks += shx<8>(ks); ks += shx<16>(ks);
                const float krs = rsqrt_f(ks * (1.0f / 128.0f) + LN_EPS);
#pragma unroll
                for (int e = 0; e < 4; ++e) kv[e] = kv[e] * krs * gk[e];
                const float kcs[8] = {w.rk[0].x, w.rk[0].y, w.rk[0].z, w.rk[0].w, w.rk[1].x, w.rk[1].y, w.rk[1].z, w.rk[1].w};
                float ko[4];
#pragma unroll
                for (int e = 0; e < 4; ++e) { const float pp = shx<8>(kv[e]); ko[e] = kv[e];
                    if (!isctx) { const float cc = kcs[2 * e], sn = kcs[2 * e + 1]; ko[e] = (kq & 1) == 0 ? kv[e] * cc - pp * sn : kv[e] * cc + pp * sn; } }
                u32x2 kw; kw.x = pk2(ko[0], ko[1]); kw.y = pk2(ko[2], ko[3]);
                *(u32x2*)(AKV + (size_t)r * 512 + lane * 4) = kw;
                *(u32x2*)(AKV + (size_t)r * 512 + 256 + lane * 4) = va; });
    }
}

DI int scan_tok(int dir, int p) { return dir == 0 ? p : (p < CTXL ? CTXL - 1 - p : TT + CTXL - 1 - p); }

typedef short bf16x8v __attribute__((ext_vector_type(8)));
typedef short v4i16_t __attribute__((ext_vector_type(4)));
#define LDSP __attribute__((address_space(3)))
#define MFMA16(a, b, c) __builtin_amdgcn_mfma_f32_16x16x32_bf16((a), (b), (c), 0, 0, 0)
DI bf16x8v ld_row(const LDSP char* tile, int stride, int row0, int col0, int lane) {
    return *(const LDSP bf16x8v*)(tile + (row0 + (lane & 15)) * stride + (col0 + 8 * (lane >> 4)) * 2);
}
DI bf16x8v ld_tr(const LDSP char* tile, int stride, int k0, int n0, int lane) {
    const int g = lane >> 4, i = lane & 15;
    const LDSP char* a = tile + (k0 + 8 * g + (i >> 2)) * stride + (n0 + 4 * (i & 3)) * 2;
    const v4i16_t lo = __builtin_amdgcn_ds_read_tr16_b64_v4i16((LDSP v4i16_t*)a);
    const v4i16_t hi = __builtin_amdgcn_ds_read_tr16_b64_v4i16((LDSP v4i16_t*)(a + 4 * stride));
    return (bf16x8v){lo[0], lo[1], lo[2], lo[3], hi[0], hi[1], hi[2], hi[3]};
}
constexpr int NCHUNK = TT / 64;
constexpr int GL_VS = 272, GL_DS = 144;
DI int chunk_of(int dir, int j) { return dir == 0 ? j : (j < 4 ? 3 - j : 71 - j); }
constexpr size_t WS_GKV = WS_GLAO;
constexpr size_t WS_GST = 991 * MiB;
constexpr size_t WS_GDEC = 1025 * MiB;
constexpr size_t WS_GOS = 1026 * MiB;
constexpr size_t WS_END2 = 1124 * MiB;


DI void phase_gla_local(KP P, char* lds_, int bid, int nb, int wv_) {
    const gptr_t ws_ = lptr(P->ws);
    const int tid = ltid(), lane = tid & 63, wave = tid >> 6;
    LDSP char* L = (LDSP char*)lds_;
    LDSP char* Vt = L;
    LDSP char* KE = L + 64 * GL_VS;
    LDSP float* tot = (LDSP float*)(L + 64 * GL_VS + 2 * 64 * GL_DS);
    const bf16* Z = (const bf16*)(ws_ + WS_ACT); const float* LA = (const float*)(ws_ + WS_LA);
    float* KVT = (float*)(ws_ + WS_GKV); float* DEC = (float*)(ws_ + WS_GDEC);
    const int dir = tid >> 8, qt = (tid >> 6) & 3, d = tid & 63;
    u32x4 vreg[2]; unsigned short kraw[16]; float lar[16];
#define GLL_FETCH(uu) do { const int u_ = (uu); const int j_ = u_ % NCHUNK, h_ = (u_ / NCHUNK) & 3, b_ = u_ / (4 * NCHUNK); const size_t row0_ = (size_t)b_ * TT + (size_t)j_ * 64; \
        _Pragma("unroll") for (int i = 0; i < 2; ++i) { const int q = tid + 512 * i, t = q >> 4, ch = q & 15; vreg[i] = *(const u32x4*)(Z + (row0_ + t) * ZW + ZGV + h_ * 128 + ch * 8); } \
        _Pragma("unroll") for (int tt = 0; tt < 16; ++tt) { const int i = 16 * qt + tt, t = dir ? 63 - i : i; kraw[tt] = Z[(row0_ + t) * ZW + ZGK + h_ * 64 + d]; lar[tt] = LA[((size_t)dir * MROWS + row0_ + t) * 256 + h_ * 64 + d]; } } while (0)
    if (bid < NBATCH * 4 * NCHUNK) GLL_FETCH(bid);
    for (int u = bid; u < NBATCH * 4 * NCHUNK; u += nb) {
        const int j = u % NCHUNK, h = (u / NCHUNK) & 3, b = u / (4 * NCHUNK);
        const size_t row0 = (size_t)b * TT + (size_t)j * 64;
        __builtin_amdgcn_sched_barrier(0);
#pragma unroll
        for (int i = 0; i < 2; ++i) { const int q = tid + 512 * i, t = q >> 4, ch = q & 15; *(LDSP u32x4*)(Vt + t * GL_VS + ch * 16) = vreg[i]; }
        float c[16], offs = 0.f, blast = 0.f; float kcur[16];
        { float sacc = 0.f;
#pragma unroll
          for (int tt = 0; tt < 16; ++tt) { sacc += lar[tt]; c[tt] = sacc; kcur[tt] = bf2f(kraw[tt]); }
          if (u + nb < NBATCH * 4 * NCHUNK) GLL_FETCH(u + nb);
          tot[(dir * 4 + qt) * 64 + d] = sacc;
          __syncthreads();
#pragma unroll
          for (int q2 = 0; q2 < 4; ++q2) { const float v = tot[(dir * 4 + q2) * 64 + d]; if (q2 < qt) offs += v; blast += v; } }
#pragma unroll
        for (int tt = 0; tt < 16; ++tt) { const int i = 16 * qt + tt, t = dir ? 63 - i : i;
            *(LDSP unsigned short*)(KE + (dir * 64 + t) * GL_DS + d * 2) = (unsigned short)f2bf(kcur[tt] * __expf(blast - (offs + c[tt]))); }
        const int n = chunk_of(dir, j); const size_t cidx = ((size_t)((b * 4 + h) * 2 + dir)) * NCHUNK + n;
        if (qt == 0) DEC[cidx * 64 + d] = __expf(blast);
        __syncthreads();
        const int wd = wave >> 2;
        f32x4 acc[2][4];
#pragma unroll
        for (int a = 0; a < 2; ++a)
#pragma unroll
            for (int n4 = 0; n4 < 4; ++n4) acc[a][n4] = (f32x4){0.f, 0.f, 0.f, 0.f};
#pragma unroll
        for (int s = 0; s < 2; ++s) {
            bf16x8v af[2], bfr[4];
#pragma unroll
            for (int a = 0; a < 2; ++a) af[a] = ld_tr(Vt, GL_VS, 32 * s, 16 * ((wave & 3) * 2 + a), lane);
#pragma unroll
            for (int n4 = 0; n4 < 4; ++n4) bfr[n4] = ld_tr(KE + wd * 64 * GL_DS, GL_DS, 32 * s, 16 * n4, lane);
#pragma unroll
            for (int a = 0; a < 2; ++a)
#pragma unroll
                for (int n4 = 0; n4 < 4; ++n4) acc[a][n4] = MFMA16(af[a], bfr[n4], acc[a][n4]);
        }
        const size_t cw = ((size_t)((b * 4 + h) * 2 + wd)) * NCHUNK + chunk_of(wd, j);
        float* out = KVT + cw * 8192;
#pragma unroll
        for (int a = 0; a < 2; ++a)
#pragma unroll
            for (int n4 = 0; n4 < 4; ++n4)
#pragma unroll
                for (int r = 0; r < 4; ++r) out[(size_t)(16 * ((wave & 3) * 2 + a) + 4 * (lane >> 4) + r) * 64 + 16 * n4 + (lane & 15)] = acc[a][n4][r];
        __syncthreads();
    }
}

DI void phase_gla_scan(KP P, int bid, int nb, int wv_) {
    const gptr_t ws_ = lptr(P->ws);
    const int tid = ltid();
    const float* KVT = (const float*)(ws_ + WS_GKV); const float* DEC = (const float*)(ws_ + WS_GDEC); bf16* ST = (bf16*)(ws_ + WS_GST);
    const int nitem = ((32 * 16 - bid + nb - 1) / nb) * 4;
    float ka[17], da[17], kb[17], db[17];
    auto issue = [&](int it, float (&kv)[17], float (&dc)[17]) { const int u = bid + (it >> 2) * nb, n0 = (it & 3) * 17; const int sc = u >> 4, e = (u & 15) * 512 + tid, d = e & 63;
        const float* kvp = KVT + (size_t)sc * NCHUNK * 8192 + e; const float* dcp = DEC + (size_t)sc * NCHUNK * 64 + d;
#pragma unroll
        for (int q = 0; q < 17; ++q) { kv[q] = kvp[(size_t)(n0 + q) * 8192]; dc[q] = dcp[(n0 + q) * 64]; } };
    float S = 0.f;
    auto run = [&](int it, const float (&kv)[17], const float (&dc)[17]) { const int u = bid + (it >> 2) * nb, n0 = (it & 3) * 17; const int sc = u >> 4, e = (u & 15) * 512 + tid;
        bf16* st = ST + (size_t)sc * NCHUNK * 8192 + e;
        if ((it & 3) == 0) S = 0.f;
#pragma unroll
        for (int q = 0; q < 17; ++q) { st[(size_t)(n0 + q) * 8192] = (bf16)f2bf(S); S = S * dc[q] + kv[q]; } };
    if (nitem <= 0) return;
    issue(0, ka, da);
#pragma unroll 1
    for (int it = 0; it < nitem; it += 2) {
        issue(it + 1, kb, db);
        run(it, ka, da);
        if (it + 2 < nitem) issue(it + 2, ka, da);
        run(it + 1, kb, db);
    }
}

DI void gla_out_unit(KP P, char* lds_, int u, int l, int wv_) {
    const gptr_t ws_ = lptr(P->ws);
    const int tid = ltid(), lane = tid & 63, wave = tid >> 6;
    LDSP char* L = (LDSP char*)lds_;
    LDSP char* Vt = L;
    LDSP char* QI = Vt + 64 * GL_VS;
    LDSP char* KI = QI + 2 * 64 * GL_DS;
    LDSP char* STt = KI + 2 * 64 * GL_DS;
    LDSP char* PT = STt + 2 * 128 * GL_DS;
    LDSP float* tot = (LDSP float*)(PT + 2 * 64 * GL_DS);
    LDSP float* nred = tot + 512;
    const bf16* Z = (const bf16*)(ws_ + WS_ACT); const float* LA = (const float*)(ws_ + WS_LA);
    const bf16* ST = (const bf16*)(ws_ + WS_GST); bf16* MIX = (bf16*)(ws_ + WS_H);
    {
        const int j = u % NCHUNK, h = (u / NCHUNK) & 3, b = u / (4 * NCHUNK);
        const size_t row0 = (size_t)b * TT + (size_t)j * 64;
        const int dir = tid >> 8, qt = (tid >> 6) & 3, d = tid & 63;
        u32x4 vreg[2], streg[4]; float lar[16]; unsigned short qraw[16], kraw[16];
#pragma unroll
        for (int i = 0; i < 2; ++i) { const int q = tid + 512 * i, t = q >> 4, ch = q & 15; vreg[i] = *(const u32x4*)(Z + (row0 + t) * ZW + ZGV + h * 128 + ch * 8); }
#pragma unroll
        for (int i = 0; i < 4; ++i) { const int q = tid + 512 * i, dd = q >> 10, rem = q & 1023, v = rem >> 3, ch = rem & 7;
            const size_t cidx = ((size_t)((b * 4 + h) * 2 + dd)) * NCHUNK + chunk_of(dd, j);
            streg[i] = *(const u32x4*)(ST + cidx * 8192 + v * 64 + ch * 8); }
#pragma unroll
        for (int tt = 0; tt < 16; ++tt) { const int i = 16 * qt + tt, t = dir ? 63 - i : i;
            lar[tt] = LA[((size_t)dir * MROWS + row0 + t) * 256 + h * 64 + d];
            qraw[tt] = Z[(row0 + t) * ZW + ZGQ + h * 64 + d]; kraw[tt] = Z[(row0 + t) * ZW + ZGK + h * 64 + d]; }
        unsigned short gtr[4][4]; float gnr[4];
#pragma unroll
        for (int n4 = 0; n4 < 4; ++n4) { const int v = 16 * ((wave >> 2) * 4 + n4) + (lane & 15); gnr[n4] = GIN(P->gla_norm_g)[(size_t)l * 128 + v];
#pragma unroll
            for (int r = 0; r < 4; ++r) gtr[n4][r] = Z[(row0 + 16 * (wave & 3) + 4 * (lane >> 4) + r) * ZW + ZGR + h * 128 + v]; }
        __builtin_amdgcn_sched_barrier(0);
#pragma unroll
        for (int i = 0; i < 2; ++i) { const int q = tid + 512 * i, t = q >> 4, ch = q & 15; *(LDSP u32x4*)(Vt + t * GL_VS + ch * 16) = vreg[i]; }
#pragma unroll
        for (int i = 0; i < 4; ++i) { const int q = tid + 512 * i, dd = q >> 10, rem = q & 1023, v = rem >> 3, ch = rem & 7; *(LDSP u32x4*)(STt + (dd * 128 + v) * GL_DS + ch * 16) = streg[i]; }
        float c[16], offs = 0.f, blast = 0.f;
        { float sacc = 0.f;
#pragma unroll
          for (int tt = 0; tt < 16; ++tt) { sacc += lar[tt]; c[tt] = sacc; }
          tot[(dir * 4 + qt) * 64 + d] = sacc;
          __syncthreads();
#pragma unroll
          for (int q2 = 0; q2 < 4; ++q2) { const float v = tot[(dir * 4 + q2) * 64 + d]; if (q2 < qt) offs += v; blast += v; } }
#pragma unroll
        for (int tt = 0; tt < 16; ++tt) { const int i = 16 * qt + tt, t = dir ? 63 - i : i; const float bc = offs + c[tt];
            *(LDSP unsigned short*)(QI + (dir * 64 + t) * GL_DS + d * 2) = (unsigned short)f2bf(bf2f(qraw[tt]) * 0.125f * __expf(bc));
            *(LDSP unsigned short*)(KI + (dir * 64 + t) * GL_DS + d * 2) = (unsigned short)f2bf(bf2f(kraw[tt]) * __expf(-bc)); }
        __syncthreads();
        {
            const int wd = wave >> 2, mt = wave & 3, g = lane >> 4, i16 = lane & 15;
            f32x4 pacc[4];
#pragma unroll
            for (int n4 = 0; n4 < 4; ++n4) pacc[n4] = (f32x4){0.f, 0.f, 0.f, 0.f};
#pragma unroll
            for (int s = 0; s < 2; ++s) {
                const bf16x8v af = ld_row(QI + wd * 64 * GL_DS, GL_DS, 16 * mt, 32 * s, lane);
#pragma unroll
                for (int n4 = 0; n4 < 4; ++n4) pacc[n4] = MFMA16(af, ld_row(KI + wd * 64 * GL_DS, GL_DS, 16 * n4, 32 * s, lane), pacc[n4]);
            }
#pragma unroll
            for (int n4 = 0; n4 < 4; ++n4) { const int tp = 16 * n4 + i16; float pv[4];
#pragma unroll
                for (int r = 0; r < 4; ++r) { const int t = 16 * mt + 4 * g + r; const bool keep = wd == 0 ? (tp <= t) : (tp >= t); pv[r] = keep ? pacc[n4][r] : 0.f; }
                u32x2 w; w.x = pk2(pv[0], pv[1]); w.y = pk2(pv[2], pv[3]);
                *(LDSP u32x2*)(PT + (wd * 64 + tp) * GL_DS + (16 * mt + 4 * g) * 2) = w; }
        }
        __syncthreads();
        {
            const int mt = wave & 3, nh = wave >> 2;
            f32x4 oacc[4];
#pragma unroll
            for (int n4 = 0; n4 < 4; ++n4) oacc[n4] = (f32x4){0.f, 0.f, 0.f, 0.f};
#pragma unroll
            for (int dd = 0; dd < 2; ++dd)
#pragma unroll
                for (int s = 0; s < 2; ++s) {
                    const bf16x8v ap = ld_tr(PT + dd * 64 * GL_DS, GL_DS, 32 * s, 16 * mt, lane);
                    const bf16x8v aq = ld_row(QI + dd * 64 * GL_DS, GL_DS, 16 * mt, 32 * s, lane);
#pragma unroll
                    for (int n4 = 0; n4 < 4; ++n4) { const int nt = nh * 4 + n4;
                        oacc[n4] = MFMA16(ap, ld_tr(Vt, GL_VS, 32 * s, 16 * nt, lane), oacc[n4]);
                        oacc[n4] = MFMA16(aq, ld_row(STt + dd * 128 * GL_DS, GL_DS, 16 * nt, 32 * s, lane), oacc[n4]); }
                }
            const int g = lane >> 4, i16 = lane & 15;
            float ps[4];
#pragma unroll
            for (int r = 0; r < 4; ++r) { float q = 0.f;
#pragma unroll
                for (int n4 = 0; n4 < 4; ++n4) q += oacc[n4][r] * oacc[n4][r];
                q += shx<1>(q); q += shx<2>(q); q += shx<4>(q); q += shx<8>(q); ps[r] = q; }
            if (i16 == 0) {
#pragma unroll
                for (int r = 0; r < 4; ++r) nred[nh * 64 + 16 * mt + 4 * g + r] = ps[r]; }
            __syncthreads();
            float rs[4];
#pragma unroll
            for (int r = 0; r < 4; ++r) { const int t = 16 * mt + 4 * g + r; rs[r] = rsqrt_f((nred[t] + nred[64 + t]) * (1.0f / 128.0f) + LN_EPS); }
#pragma unroll
            for (int n4 = 0; n4 < 4; ++n4) { const int v = 16 * (nh * 4 + n4) + i16; const float gn = gnr[n4];
#pragma unroll
                for (int r = 0; r < 4; ++r) { const size_t row = row0 + 16 * mt + 4 * g + r;
                    const float gt = bf2f(gtr[n4][r]);
                    MIX[row * 2048 + h * 128 + v] = (bf16)f2bf(oacc[n4][r] * rs[r] * gn * silu_f(gt)); } }
        }
        __syncthreads();
    }
}


constexpr size_t DN_REC = 41984;
constexpr size_t DO_REC = 0, DO_U = 88 * MiB;
constexpr int RO_W = 0, RO_A = 16384, RO_K = 24576, RO_G = 40960;
constexpr int NDNC = NBATCH * 4 * 2 * NCHUNK;
static_assert(DO_REC + (size_t)NDNC * DN_REC <= DO_U && DO_U + (size_t)NDNC * 16384 <= (size_t)NBATCH * SEQL * DM * 4, "DN chunk buffers fit d_out");
constexpr int DN_TS = 272;
constexpr int DN_AS = 272;
constexpr int DN_PS = 144;
DI unsigned pk2t(float lo, float hi) { return pk2(lo, hi); }

DI void phase_dn_local(KP P, char* lds_, int bid, int nb, int wv_) {
    const gptr_t ws_ = lptr(P->ws);
    const gptr_t dob = lptr((unsigned char*)P->out);
    const int tid = ltid(), lane = tid & 63, wave = tid >> 6, g = lane >> 4, i16 = lane & 15;
    LDSP char* L = (LDSP char*)lds_;
    LDSP char* Kt = L;
    LDSP char* Qt = Kt + 64 * DN_TS;
    LDSP char* Vt = Qt + 64 * DN_TS;
    LDSP char* As = Vt + 64 * DN_TS;
    LDSP char* TB = As + 64 * DN_AS;
    LDSP char* TG = TB + 64 * DN_PS;
    LDSP float* gcl = (LDSP float*)(TG + 64 * DN_PS);
    LDSP float* btl = gcl + 64;
    LDSP char* Ts = (LDSP char*)(btl + 64);
    LDSP char* Xw = Ts + 64 * DN_AS;
    const bf16* DQ = (const bf16*)(ws_ + WS_DQ); const bf16* DK = (const bf16*)(ws_ + WS_DK); const bf16* DV = (const bf16*)(ws_ + WS_DV);
    const float* DBETA = (const float*)(ws_ + WS_DBG); const float* DG = DBETA + (size_t)2 * MROWS * 4;
    u32x4 tr6[6]; float gs0 = 0.f, bt0 = 0.f; bool first = true;
#define DNL_FETCH(uu) do { const int u_ = (uu); const int dir_ = u_ & 1, j_ = (u_ >> 1) % NCHUNK, h_ = ((u_ >> 1) / NCHUNK) & 3, b_ = (u_ >> 1) / (4 * NCHUNK); const size_t row0_ = (size_t)b_ * TT + (size_t)j_ * 64; \
        _Pragma("unroll") for (int i = 0; i < 6; ++i) { const int q = tid + 512 * i, which = q >> 10, rem = q & 1023, t = rem >> 4, ch = rem & 15; \
            tr6[i] = *(const u32x4*)((which == 0 ? DK : which == 1 ? DQ : DV) + (row0_ + t) * 512 + h_ * 128 + ch * 8); } \
        if (wave == 0) { const int t = dir_ ? 63 - lane : lane; gs0 = DG[((size_t)dir_ * MROWS + row0_ + t) * 4 + h_]; bt0 = DBETA[((size_t)dir_ * MROWS + row0_ + t) * 4 + h_]; } } while (0)
    for (int u = (bid + 128) & 255; u < NDNC; u += nb) {
        const int dir = u & 1, j = (u >> 1) % NCHUNK, h = ((u >> 1) / NCHUNK) & 3, b = (u >> 1) / (4 * NCHUNK);
        const size_t row0 = (size_t)b * TT + (size_t)j * 64;
        const size_t c = ((size_t)((b * 4 + h) * 2 + dir)) * NCHUNK + chunk_of(dir, j);
        if (first) { first = false; DNL_FETCH(u); }
        __builtin_amdgcn_sched_barrier(0);
#pragma unroll
        for (int i = 0; i < 6; ++i) { const int q = tid + 512 * i, which = q >> 10, rem = q & 1023, t = rem >> 4, ch = rem & 15;
            *(LDSP u32x4*)(L + which * 64 * DN_TS + t * DN_TS + ch * 16) = tr6[i]; }
        const float gs_cur = gs0, bt_cur = bt0;
        if (u + nb < NDNC) DNL_FETCH(u + nb);
        if (wave == 0) {
            const int t = dir ? 63 - lane : lane;
            float gs = gs_cur;
#pragma unroll
            for (int o = 1; o < 64; o <<= 1) { const float up = __builtin_bit_cast(float, __builtin_amdgcn_ds_bpermute((int)(((unsigned)(lane - o) & 63u) << 2), __builtin_bit_cast(int, gs))); if (lane >= o) gs += up; }
            const float glast = __builtin_bit_cast(float, __builtin_amdgcn_readlane(__builtin_bit_cast(int, gs), 63));
            gcl[t] = gs; btl[t] = bt_cur;
            float* G = (float*)(dob + DO_REC + c * DN_REC + RO_G);
            G[t] = __expf(gs); G[64 + t] = __expf(glast - gs); if (lane == 0) G[128] = __expf(glast);
        }
        __syncthreads();
        if (wave < 4) {
            const int mt = wave;
            f32x4 acc[4];
#pragma unroll
            for (int n4 = 0; n4 < 4; ++n4) acc[n4] = (f32x4){0.f, 0.f, 0.f, 0.f};
            bf16x8v kfr[4][4], afr[4]; float gtpv[4];
#pragma unroll
            for (int s = 0; s < 4; ++s) { afr[s] = ld_row(Kt, DN_TS, 16 * mt, 32 * s, lane);
#pragma unroll
                for (int n4 = 0; n4 < 4; ++n4) kfr[s][n4] = ld_row(Kt, DN_TS, 16 * n4, 32 * s, lane); }
#pragma unroll
            for (int n4 = 0; n4 < 4; ++n4) gtpv[n4] = gcl[16 * n4 + i16];
            const f32x4 btv = *(const LDSP f32x4*)(btl + 16 * mt + 4 * g), gtv = *(const LDSP f32x4*)(gcl + 16 * mt + 4 * g);
            __builtin_amdgcn_sched_barrier(0);
#pragma unroll
            for (int s = 0; s < 4; ++s)
#pragma unroll
                for (int n4 = 0; n4 < 4; ++n4) acc[n4] = MFMA16(afr[s], kfr[s][n4], acc[n4]);
#pragma unroll
            for (int n4 = 0; n4 < 4; ++n4) { const int tp = 16 * n4 + i16; const float gtp = gtpv[n4];
#pragma unroll
                for (int r = 0; r < 4; ++r) { const int t = 16 * mt + 4 * g + r; const bool strict = dir == 0 ? (tp < t) : (tp > t);
                    const float val = strict ? btv[r] * acc[n4][r] * __expf(gtv[r] - gtp) : 0.f;
                    const int si = dir ? 63 - t : t, sj = dir ? 63 - tp : tp;
                    *(LDSP float*)(As + si * DN_AS + sj * 4) = val; } }
        } else {
            const int tt = wave - 4;
            f32x4 acc[4];
#pragma unroll
            for (int n4 = 0; n4 < 4; ++n4) acc[n4] = (f32x4){0.f, 0.f, 0.f, 0.f};
            bf16x8v kfr[4][4], bqf[4]; f32x4 gtpv[4];
#pragma unroll
            for (int s = 0; s < 4; ++s) { bqf[s] = ld_row(Qt, DN_TS, 16 * tt, 32 * s, lane);
#pragma unroll
                for (int n4 = 0; n4 < 4; ++n4) kfr[s][n4] = ld_row(Kt, DN_TS, 16 * n4, 32 * s, lane); }
            const int t = 16 * tt + i16; const float gt = gcl[t];
#pragma unroll
            for (int n4 = 0; n4 < 4; ++n4) gtpv[n4] = *(const LDSP f32x4*)(gcl + 16 * n4 + 4 * g);
            __builtin_amdgcn_sched_barrier(0);
#pragma unroll
            for (int s = 0; s < 4; ++s)
#pragma unroll
                for (int n4 = 0; n4 < 4; ++n4) acc[n4] = MFMA16(kfr[s][n4], bqf[s], acc[n4]);
            unsigned pk[4][2];
#pragma unroll
            for (int n4 = 0; n4 < 4; ++n4) { float v4[4];
#pragma unroll
                for (int r = 0; r < 4; ++r) { const int tp = 16 * n4 + 4 * g + r; const bool incl = dir == 0 ? (tp <= t) : (tp >= t);
                    v4[r] = incl ? acc[n4][r] * __expf(gt - gtpv[n4][r]) : 0.f; }
                pk[n4][0] = pk2(v4[0], v4[1]); pk[n4][1] = pk2(v4[2], v4[3]); }
            u32x4* AF = (u32x4*)(dob + DO_REC + c * DN_REC + RO_A);
#pragma unroll
            for (int s = 0; s < 2; ++s) { u32x4 w; w.x = pk[2 * s][0]; w.y = pk[2 * s][1]; w.z = pk[2 * s + 1][0]; w.w = pk[2 * s + 1][1]; AF[(tt * 2 + s) * 64 + lane] = w; }
        }
        __syncthreads();
        {
            for (int e = tid; e < 6 * 256; e += 512) { const int blk = e >> 8, r = (e >> 4) & 15, cc = e & 15;
                const int bi = blk < 3 ? 0 : (blk < 5 ? 1 : 2), bj = blk < 3 ? blk + 1 : (blk < 5 ? blk - 1 : 3);
                *(LDSP float*)(Ts + (16 * bi + r) * DN_AS + (16 * bj + cc) * 4) = 0.f; }
            if (wave == 0) {
                const int blk = lane >> 4, cc = lane & 15;
                float T[16];
#pragma unroll
                for (int q4 = 0; q4 < 4; ++q4) {
                    f32x4 avr[4][4];
#pragma unroll
                    for (int rr = 0; rr < 4; ++rr)
#pragma unroll
                        for (int i4 = 0; i4 <= q4; ++i4) avr[rr][i4] = *(const LDSP f32x4*)(As + (16 * blk + 4 * q4 + rr) * DN_AS + (16 * blk + 4 * i4) * 4);
                    __builtin_amdgcn_sched_barrier(0);
#pragma unroll
                    for (int rr = 0; rr < 4; ++rr) { const int i = 4 * q4 + rr;
                        float a0 = (i == cc) ? 1.f : 0.f, a1 = 0.f;
#pragma unroll
                        for (int i4 = 0; i4 < (i + 3) / 4; ++i4) { const f32x4 av = avr[rr][i4];
#pragma unroll
                            for (int e = 0; e < 4; ++e) if (4 * i4 + e < i) { if (e & 1) a1 -= av[e] * T[4 * i4 + e]; else a0 -= av[e] * T[4 * i4 + e]; } }
                        T[i] = a0 + a1; }
                }
#pragma unroll
                for (int i = 0; i < 16; ++i) *(LDSP float*)(Ts + (16 * blk + i) * DN_AS + (16 * blk + cc) * 4) = T[i];
            } else {
                u32x4* KF = (u32x4*)(dob + DO_REC + c * DN_REC + RO_K);
                for (int f = wave - 1; f < 16; f += 7) { const int md = f >> 1, s = f & 1;
                    const LDSP char* a = Kt + (32 * s + 4 * g + (i16 >> 2)) * DN_TS + (16 * md + 4 * (i16 & 3)) * 2;
                    const v4i16_t lo = __builtin_amdgcn_ds_read_tr16_b64_v4i16((LDSP v4i16_t*)a);
                    const v4i16_t hi = __builtin_amdgcn_ds_read_tr16_b64_v4i16((LDSP v4i16_t*)(a + 16 * DN_TS));
                    const bf16x8v fr = (bf16x8v){lo[0], lo[1], lo[2], lo[3], hi[0], hi[1], hi[2], hi[3]};
                    *(bf16x8v*)(KF + f * 64 + lane) = fr; }
            }
            __syncthreads();
#pragma unroll
            for (int dlev = 1; dlev < 4; ++dlev) {
                if (wave < 4 - dlev) {
                    const int bi = wave + dlev, bj = wave;
                    f32x4 x = (f32x4){0.f, 0.f, 0.f, 0.f};
                    f32x4 avs[3]; float bvs[3][4];
#pragma unroll
                    for (int kk = 0; kk < dlev; ++kk) { const int bk = bj + kk;
                        avs[kk] = *(const LDSP f32x4*)(As + (16 * bi + i16) * DN_AS + (16 * bk + 4 * g) * 4);
#pragma unroll
                        for (int sp = 0; sp < 4; ++sp) bvs[kk][sp] = *(const LDSP float*)(Ts + (16 * bk + 4 * g + sp) * DN_AS + (16 * bj + i16) * 4); }
                    const f32x4 tv = *(const LDSP f32x4*)(Ts + (16 * bi + i16) * DN_AS + (16 * bi + 4 * g) * 4);
                    __builtin_amdgcn_sched_barrier(0);
#pragma unroll
                    for (int kk = 0; kk < dlev; ++kk)
#pragma unroll
                        for (int sp = 0; sp < 4; ++sp) x = __builtin_amdgcn_mfma_f32_16x16x4f32(avs[kk][sp], bvs[kk][sp], x, 0, 0, 0);
                    LDSP float* Xs = (LDSP float*)(Xw + wave * 1280);
#pragma unroll
                    for (int r = 0; r < 4; ++r) Xs[(4 * g + r) * 20 + i16] = x[r];
                    asm volatile("s_waitcnt lgkmcnt(0)" ::: "memory");
                    float xsv[4];
#pragma unroll
                    for (int sp = 0; sp < 4; ++sp) xsv[sp] = Xs[(4 * g + sp) * 20 + i16];
                    __builtin_amdgcn_sched_barrier(0);
                    f32x4 y = (f32x4){0.f, 0.f, 0.f, 0.f};
#pragma unroll
                    for (int sp = 0; sp < 4; ++sp) y = __builtin_amdgcn_mfma_f32_16x16x4f32(tv[sp], xsv[sp], y, 0, 0, 0);
#pragma unroll
                    for (int r = 0; r < 4; ++r) *(LDSP float*)(Ts + (16 * bi + 4 * g + r) * DN_AS + (16 * bj + i16) * 4) = -y[r];
                }
                __syncthreads();
            }
            {
                const int i = tid >> 3, c0 = (tid & 7) * 8, tr = dir ? 63 - i : i;
                const f32x4 t0 = *(const LDSP f32x4*)(Ts + i * DN_AS + c0 * 4), t1 = *(const LDSP f32x4*)(Ts + i * DN_AS + c0 * 4 + 16);
                const float tv[8] = {t0[0], t0[1], t0[2], t0[3], t1[0], t1[1], t1[2], t1[3]};
                float vb[8], vg[8];
                const int tb0 = dir ? 63 - (c0 + 7) : c0;
                const f32x4 bl0 = *(const LDSP f32x4*)(btl + tb0), bl1 = *(const LDSP f32x4*)(btl + tb0 + 4), gl0 = *(const LDSP f32x4*)(gcl + tb0), gl1 = *(const LDSP f32x4*)(gcl + tb0 + 4);
                const float blv[8] = {bl0[0], bl0[1], bl0[2], bl0[3], bl1[0], bl1[1], bl1[2], bl1[3]}, glv[8] = {gl0[0], gl0[1], gl0[2], gl0[3], gl1[0], gl1[1], gl1[2], gl1[3]};
#pragma unroll
                for (int e = 0; e < 8; ++e) { const float bc = dir ? blv[7 - e] : blv[e], gc = dir ? glv[7 - e] : glv[e]; vb[e] = tv[e] * bc; vg[e] = vb[e] * __expf(gc); }
                u32x4 wb, wg;
                if (dir == 0) { wb = (u32x4){pk2(vb[0], vb[1]), pk2(vb[2], vb[3]), pk2(vb[4], vb[5]), pk2(vb[6], vb[7])}; wg = (u32x4){pk2(vg[0], vg[1]), pk2(vg[2], vg[3]), pk2(vg[4], vg[5]), pk2(vg[6], vg[7])}; }
                else          { wb = (u32x4){pk2(vb[7], vb[6]), pk2(vb[5], vb[4]), pk2(vb[3], vb[2]), pk2(vb[1], vb[0])}; wg = (u32x4){pk2(vg[7], vg[6]), pk2(vg[5], vg[4]), pk2(vg[3], vg[2]), pk2(vg[1], vg[0])}; }
                const int tcol = dir ? 63 - (c0 + 7) : c0;
                *(LDSP u32x4*)(TB + tr * DN_PS + tcol * 2) = wb; *(LDSP u32x4*)(TG + tr * DN_PS + tcol * 2) = wg;
            }
        }
        __syncthreads();
        {
            const int mt = wave & 3, nh = wave >> 2;
            f32x4 ua[4], wa[4];
#pragma unroll
            for (int n4 = 0; n4 < 4; ++n4) { ua[n4] = (f32x4){0.f, 0.f, 0.f, 0.f}; wa[n4] = (f32x4){0.f, 0.f, 0.f, 0.f}; }
            bf16x8v tbf[2], tgf[2], vfr[2][4], kfr[2][4];
#pragma unroll
            for (int s = 0; s < 2; ++s) {
                tbf[s] = ld_row(TB, DN_PS, 16 * mt, 32 * s, lane);
                tgf[s] = ld_row(TG, DN_PS, 16 * mt, 32 * s, lane);
#pragma unroll
                for (int n4 = 0; n4 < 4; ++n4) { const int nt = nh * 4 + n4; vfr[s][n4] = ld_tr(Vt, DN_TS, 32 * s, 16 * nt, lane); kfr[s][n4] = ld_tr(Kt, DN_TS, 32 * s, 16 * nt, lane); }
            }
            __builtin_amdgcn_sched_barrier(0);
#pragma unroll
            for (int s = 0; s < 2; ++s)
#pragma unroll
                for (int n4 = 0; n4 < 4; ++n4) {
                    ua[n4] = MFMA16(tbf[s], vfr[s][n4], ua[n4]);
                    wa[n4] = MFMA16(kfr[s][n4], tgf[s], wa[n4]); }
            u32x2* UF = (u32x2*)(dob + DO_U) + c * 2048;
#pragma unroll
            for (int n4 = 0; n4 < 4; ++n4) { u32x2 w; w.x = pk2(ua[n4][0], ua[n4][1]); w.y = pk2(ua[n4][2], ua[n4][3]); UF[((nh * 4 + n4) * 4 + mt) * 64 + lane] = w; }
            u32x4* WF = (u32x4*)(dob + DO_REC + c * DN_REC + RO_W);
#pragma unroll
            for (int s2 = 0; s2 < 2; ++s2) { u32x4 w; w.x = pk2(-wa[2 * s2][0], -wa[2 * s2][1]); w.y = pk2(-wa[2 * s2][2], -wa[2 * s2][3]);
                w.z = pk2(-wa[2 * s2 + 1][0], -wa[2 * s2 + 1][1]); w.w = pk2(-wa[2 * s2 + 1][2], -wa[2 * s2 + 1][3]);
                WF[(mt * 4 + nh * 2 + s2) * 64 + lane] = w; }
        }
        __syncthreads();
    }
}

constexpr int DNS_Q = 41984, DNS_U = 58368, DNS_BUF = 62464;
DI void phase_dn_scan(KP P, char* lds_, int bid, int nb, int wv_) {
    const gptr_t ws_ = lptr(P->ws);
    const gptr_t dob = lptr((unsigned char*)P->out);
    const int tid = ltid(), lane = tid & 63, wave = tid >> 6, g = lane >> 4, i16 = lane & 15;
    LDSP char* L = (LDSP char*)lds_;
    const bf16* DQ = (const bf16*)(ws_ + WS_DQ); float* DO = (float*)(ws_ + WS_DNO);
    for (int uu = bid; uu < 128; uu += nb) {
        const int u = (uu & 7) + 8 * (uu >> 5), sp = (uu >> 3) & 3, vs = 2 * sp + (wave & 1);
        const int dir = u & 1, h = (u >> 1) & 3, b = u >> 3;
        const size_t c0 = (size_t)u * NCHUNK;
        if (wave >= 2) {
            const int lt = tid - 128;
            u32x4 sr[3][7], sq[3][3], sU[3];
#define DNL_LOAD(stage, n) do { const size_t c = c0 + (n); const int jn = dir == 0 ? (n) : ((n) < 4 ? 3 - (n) : 71 - (n)); const size_t rw = (size_t)b * TT + (size_t)jn * 64; \
                const u32x4* Rg = (const u32x4*)(dob + DO_REC + c * DN_REC) + lt; \
                _Pragma("unroll") for (int k_ = 0; k_ < 7; ++k_) if (k_ < 6 || lt < 320) sr[stage][k_] = Rg[384 * k_]; \
                _Pragma("unroll") for (int k_ = 0; k_ < 3; ++k_) if (k_ < 2 || lt < 256) { const int id = lt + 384 * k_, f_ = id >> 6, ln_ = id & 63, mt_ = f_ >> 2, s_ = f_ & 3; \
                    const bf16* qp_ = DQ + (rw + 16 * mt_ + (ln_ & 15)) * 512 + h * 128 + 32 * s_ + 4 * (ln_ >> 4); const u32x2 lo_ = *(const u32x2*)qp_, hi_ = *(const u32x2*)(qp_ + 16); \
                    sq[stage][k_] = (u32x4){lo_.x, lo_.y, hi_.x, hi_.y}; } \
                if (lt < 256) sU[stage] = *((const u32x4*)(dob + DO_U + c * 16384 + (size_t)sp * 4096) + lt); } while (0)
#define DNL_STORE(stage, bufp) do { LDSP u32x4* B_ = (LDSP u32x4*)(bufp) + lt; \
                _Pragma("unroll") for (int k_ = 0; k_ < 7; ++k_) if (k_ < 6 || lt < 320) B_[384 * k_] = sr[stage][k_]; \
                _Pragma("unroll") for (int k_ = 0; k_ < 3; ++k_) if (k_ < 2 || lt < 256) B_[DNS_Q / 16 + 384 * k_] = sq[stage][k_]; \
                if (lt < 256) B_[DNS_U / 16] = sU[stage]; } while (0)
            DNL_LOAD(0, 0); DNL_LOAD(1, 1); DNL_LOAD(2, 2);
            DNL_STORE(0, L);
            DNL_LOAD(0, 3);
            __syncthreads();
#pragma unroll 1
            for (int n0 = 0; n0 < 69; n0 += 3) {
#pragma unroll
                for (int k = 0; k < 3; ++k) { const int n = n0 + k;
                    if (n + 1 < NCHUNK) DNL_STORE((k + 1) % 3, L + ((n + 1) & 1) * DNS_BUF);
                    if (n + 4 < NCHUNK) DNL_LOAD((k + 1) % 3, n + 4);
                    __syncthreads(); }
            }
#undef DNL_LOAD
#undef DNL_STORE
        } else {
            f32x4 S[8];
#pragma unroll
            for (int m = 0; m < 8; ++m) S[m] = (f32x4){0.f, 0.f, 0.f, 0.f};
            const unsigned lane_off = (unsigned)((4 * g * 512 + h * 128 + 16 * vs + i16) * 4);
            auto flush = [&](int np, const f32x4 (&os)[4]) { const int jp = dir == 0 ? np : (np < 4 ? 3 - np : 71 - np); const size_t rwp = (size_t)b * TT + (size_t)jp * 64;
#pragma unroll
                for (int m = 0; m < 4; ++m)
#pragma unroll
                    for (int r = 0; r < 4; ++r) { char* pb = (char*)(DO + ((size_t)dir * MROWS + rwp + 16 * m + r) * 512); *(float*)(pb + lane_off) = os[m][r]; } };
            auto step = [&](int n, f32x4 (&ow)[4], const f32x4 (&os)[4]) {
                if (n > 0) flush(n - 1, os);
                const LDSP char* B = L + (n & 1) * DNS_BUF;
                const LDSP bf16x8v* BW = (const LDSP bf16x8v*)(B + RO_W); const LDSP bf16x8v* BQ = (const LDSP bf16x8v*)(B + DNS_Q);
                const LDSP bf16x8v* BA = (const LDSP bf16x8v*)(B + RO_A); const LDSP bf16x8v* BK = (const LDSP bf16x8v*)(B + RO_K);
                const LDSP float* BG = (const LDSP float*)(B + RO_G); const LDSP u32x2* BU = (const LDSP u32x2*)(B + DNS_U + (wave & 1) * 2048);
#define SB() __builtin_amdgcn_sched_barrier(0)
#define LD4(dst, src, off) do { _Pragma("unroll") for (int f_ = 0; f_ < 4; ++f_) dst[f_] = (src)[((off) + f_) * 64 + lane]; } while (0)
                bf16x8v fa[4], fb[4];
                LD4(fa, BW, 0);
                f32x4 vn[4], oa[4];
#pragma unroll
                for (int m = 0; m < 4; ++m) { const u32x2 w = BU[m * 64 + lane]; vn[m] = (f32x4){bflo(w.x), bfhi(w.x), bflo(w.y), bfhi(w.y)}; }
                bf16x8v Sb[4];
#pragma unroll
                for (int s = 0; s < 4; ++s) { u32x4 w; w.x = pk2(S[2 * s][0], S[2 * s][1]); w.y = pk2(S[2 * s][2], S[2 * s][3]); w.z = pk2(S[2 * s + 1][0], S[2 * s + 1][1]); w.w = pk2(S[2 * s + 1][2], S[2 * s + 1][3]);
                    Sb[s] = __builtin_bit_cast(bf16x8v, w); }
#define GRP(acc, buf) do { _Pragma("unroll") for (int s_ = 0; s_ < 4; ++s_) acc = MFMA16(buf[s_], Sb[s_], acc); } while (0)
                SB(); LD4(fb, BW, 4); SB(); GRP(vn[0], fa);
                SB(); LD4(fa, BW, 8); SB(); GRP(vn[1], fb);
                SB(); LD4(fb, BW, 12); SB(); GRP(vn[2], fa);
                SB(); LD4(fa, BQ, 0); SB(); GRP(vn[3], fb);
#pragma unroll
                for (int m = 0; m < 4; ++m) oa[m] = (f32x4){0.f, 0.f, 0.f, 0.f};
                SB(); LD4(fb, BQ, 4); SB(); GRP(oa[0], fa);
                SB(); LD4(fa, BQ, 8); SB(); GRP(oa[1], fb);
                SB(); LD4(fb, BQ, 12);
                f32x4 eb4[4];
#pragma unroll
                for (int m = 0; m < 4; ++m) eb4[m] = *(const LDSP f32x4*)(BG + 64 + 16 * m + 4 * g);
                SB(); GRP(oa[2], fa);
                SB(); LD4(fa, BA, 0); SB(); GRP(oa[3], fb);
#undef GRP
                bf16x8v Vb[2], Vs[2];
#pragma unroll
                for (int s2 = 0; s2 < 2; ++s2) { unsigned wv[4], ws2[4];
#pragma unroll
                    for (int hh = 0; hh < 2; ++hh) { const int m = 2 * s2 + hh; const f32x4 eb = eb4[m];
                        wv[2 * hh] = pk2(vn[m][0], vn[m][1]); wv[2 * hh + 1] = pk2(vn[m][2], vn[m][3]);
                        ws2[2 * hh] = pk2(vn[m][0] * eb[0], vn[m][1] * eb[1]); ws2[2 * hh + 1] = pk2(vn[m][2] * eb[2], vn[m][3] * eb[3]); }
                    Vb[s2] = __builtin_bit_cast(bf16x8v, (u32x4){wv[0], wv[1], wv[2], wv[3]}); Vs[s2] = __builtin_bit_cast(bf16x8v, (u32x4){ws2[0], ws2[1], ws2[2], ws2[3]}); }
                SB(); LD4(fb, BA, 4);
                f32x4 ea4[4];
#pragma unroll
                for (int m = 0; m < 4; ++m) ea4[m] = *(const LDSP f32x4*)(BG + 16 * m + 4 * g);
                const float egl = BG[128];
                SB();
#define OGRP(m, buf, o0) do { f32x4 o = oa[m] * ea4[m]; o = MFMA16(buf[o0], Vb[0], o); o = MFMA16(buf[o0 + 1], Vb[1], o); ow[m] = o; } while (0)
                OGRP(0, fa, 0); OGRP(1, fa, 2);
                SB(); LD4(fa, BK, 0); SB();
                OGRP(2, fb, 0); OGRP(3, fb, 2);
#undef OGRP
#define SGRP(md, buf) do { S[md] = S[md] * egl; S[md] = MFMA16(buf[0], Vs[0], S[md]); S[md] = MFMA16(buf[1], Vs[1], S[md]); \
                    S[md + 1] = S[md + 1] * egl; S[md + 1] = MFMA16(buf[2], Vs[0], S[md + 1]); S[md + 1] = MFMA16(buf[3], Vs[1], S[md + 1]); } while (0)
                SB(); LD4(fb, BK, 4); SB(); SGRP(0, fa);
                SB(); LD4(fa, BK, 8); SB(); SGRP(2, fb);
                SB(); LD4(fb, BK, 12); SB(); SGRP(4, fa);
                SB(); SGRP(6, fb);
#undef SGRP
#undef LD4
#undef SB
            };
            f32x4 oA[4], oB[4];
#pragma unroll
            for (int m = 0; m < 4; ++m) { oA[m] = (f32x4){0.f, 0.f, 0.f, 0.f}; oB[m] = (f32x4){0.f, 0.f, 0.f, 0.f}; }
            __syncthreads();
#pragma unroll 1
            for (int n = 0; n < NCHUNK; n += 2) {
                step(n, oA, oB);
                __syncthreads();
                step(n + 1, oB, oA);
                __syncthreads();
            }
            flush(NCHUNK - 1, oB);
            __syncthreads();
        }
        __syncthreads();
    }
}

DI void dn_post_rows(KP P, int l, int rbeg, int rstep, int rend, bool skip_ctx, int wv_) {
    const gptr_t ws_ = lptr(P->ws);
    const int lane = ltid() & 63, wave = ltid() >> 6;
    const bf16* Z = (const bf16*)(ws_ + WS_ACT); bf16* MIX = (bf16*)(ws_ + WS_H);
    const float* gp = GIN(P->dn_norm_g) + (size_t)l * 128 + (lane & 15) * 8;
    const f32x4 g0 = *(const f32x4*)gp, g1 = *(const f32x4*)(gp + 4);
    auto nextr = [&](int r) { while (r < rend && skip_ctx && (r % TT) < CTXL) r += rstep; return r; };
    f32x4 o00, o01, o10, o11; u32x4 gw;
    auto fetch = [&](int r) { const float* O0 = (const float*)(ws_ + WS_DNO) + (size_t)r * 512 + lane * 8; const float* O1 = O0 + (size_t)MROWS * 512;
        o00 = *(const f32x4*)O0; o01 = *(const f32x4*)(O0 + 4); o10 = *(const f32x4*)O1; o11 = *(const f32x4*)(O1 + 4); gw = *(const u32x4*)(Z + (size_t)r * ZW + ZDG + lane * 8); };
    int r = nextr(rbeg + wave);
    if (r >= rend) return;
    fetch(r);
    f32x4 a0 = o00 + o10, a1 = o01 + o11; u32x4 gc = gw;
#pragma unroll 1
    while (true) {
        const int rn = nextr(r + rstep);
        if (rn < rend) fetch(rn);
        const float v[8] = {a0.x, a0.y, a0.z, a0.w, a1.x, a1.y, a1.z, a1.w};
        float ss = 0.f;
#pragma unroll
        for (int e = 0; e < 8; ++e) ss += v[e] * v[e];
        ss += shx<1>(ss); ss += shx<2>(ss); ss += shx<4>(ss); ss += shx<8>(ss);
        const float rs = rsqrt_f(ss * (1.0f / 128.0f) + LN_EPS);
        const float g[8] = {g0.x, g0.y, g0.z, g0.w, g1.x, g1.y, g1.z, g1.w};
        const float gt[8] = {bflo(gc.x), bfhi(gc.x), bflo(gc.y), bfhi(gc.y), bflo(gc.z), bfhi(gc.z), bflo(gc.w), bfhi(gc.w)};
        float o[8];
#pragma unroll
        for (int e = 0; e < 8; ++e) o[e] = v[e] * rs * g[e] * silu_f(gt[e]);
        u32x4 w; w.x = pk2(o[0], o[1]); w.y = pk2(o[2], o[3]); w.z = pk2(o[4], o[5]); w.w = pk2(o[6], o[7]);
        *(u32x4*)(MIX + (size_t)r * 2048 + 512 + lane * 8) = w;
        if (rn >= rend) break;
        a0 = o00 + o10; a1 = o01 + o11; gc = gw; r = rn;
    }
}

struct RowOrder { pg8::StaticOrder base; int nN, nkt, parts; bool lat_only;
    DI void init(bool lat_only_, int N, int K, int parts_, int G, int c) { lat_only = lat_only_; nN = N / 256; nkt = K / 64; parts = parts_; base.init(NBATCH * SEQL, N, G, c); }
    DI bool next(int i, pg8::Unit& u) const {
        if (base.next(i, u)) { u.pm = 17 * (u.pm >> 4) + 1 + (u.pm & 15); u.kt0 = 0; u.nkt = nkt; return true; }
        if (lat_only) return false;
        const int q = i * base.G + base.c - base.nwg;
        if (q >= NBATCH * nN * parts) return false;
        const int unit = q / parts, part = q - unit * parts;
        u.pm = 17 * (unit / nN); u.pn = unit % nN; u.part = part;
        const int sz = nkt / parts;
        if (sz & 1) { const int base = (part >> 1) * 2 * sz; if (part & 1) { u.kt0 = base + sz + 1; u.nkt = sz - 1; } else { u.kt0 = base; u.nkt = sz + 1; } }
        else { u.nkt = sz; u.kt0 = part * sz; }
        return true; }
    DI void a_ready(const pg8::Unit&) const {}
    DI void done(const pg8::Unit&) const {} };
DI void phase_gemm_gu(KP P, int l, int sub, bool lat, char* lds, int bid, int nb, int wv_) {
    const gptr_t ws_ = lptr(P->ws);
    pg8::Gemm g{(const bf16*)(ws_ + WS_H), (const bf16*)(ws_ + WS_WGU) + (size_t)(l * 2 + sub) * WGU_ELEMS, MROWS, 2 * FF, DM};
    RowOrder S; S.init(lat, 2 * FF, DM, 1, nb, bid);
    pg8::EpiSwiglu E{(bf16*)(ws_ + WS_ACT), FF};
    pg8::gemm_phase<pg8::EpiSwiglu, RowOrder, PG8_ALIGN, PG8_SP2>((PG8_LAS unsigned char*)lds, g, S, E, wv_);
}
DI void phase_gemm_down(KP P, int l, int sub, bool lat, char* lds, int bid, int nb, int wv_) {
    const gptr_t ws_ = lptr(P->ws);
    pg8::Gemm g{(const bf16*)(ws_ + WS_ACT), (const bf16*)(ws_ + WS_WD) + (size_t)(l * 2 + sub) * WD_ELEMS, MROWS, DM, FF};
    RowOrder S; S.init(lat, DM, FF, 8, nb, bid);
    pg8::EpiDelta E{(bf16*)(ws_ + WS_DELTA), (bf16*)(ws_ + WS_PART), (const float*)(ws_ + WS_MOD) + (size_t)l * 5 * NMODV, sub == 0 ? 2 : 8, 0.5f, FF / 64};
    pg8::gemm_phase<pg8::EpiDelta, RowOrder, PG8_ALIGN, PG8_SP2>((PG8_LAS unsigned char*)lds, g, S, E, wv_);
}
DI void phase_gemm_in(KP P, int l, char* lds, int bid, int nb, int wv_) {
    const gptr_t ws_ = lptr(P->ws);
    pg8::Gemm g{(const bf16*)(ws_ + WS_H), (const bf16*)(ws_ + WS_WIN) + (size_t)l * WIN_ELEMS, MROWS, ZW, DM};
    RowOrder S; S.init(false, ZW, DM, 1, nb, bid);
    pg8::EpiStoreBf16 E{(bf16*)(ws_ + WS_ACT), ZW};
    pg8::gemm_phase<pg8::EpiStoreBf16, RowOrder, PG8_ALIGN, PG8_SP2>((PG8_LAS unsigned char*)lds, g, S, E, wv_);
}
DI void phase_gemm_out(KP P, int l, bool lat, char* lds, int bid, int nb, int wv_) {
    const gptr_t ws_ = lptr(P->ws);
    pg8::Gemm g{(const bf16*)(ws_ + WS_H), (const bf16*)(ws_ + WS_WOUT) + (size_t)l * WOUT_ELEMS, MROWS, DM, DM};
    RowOrder S; S.init(lat, DM, DM, 8, nb, bid);
    pg8::EpiDelta E{(bf16*)(ws_ + WS_DELTA), (bf16*)(ws_ + WS_PART), (const float*)(ws_ + WS_MOD) + (size_t)l * 5 * NMODV, 5, 1.0f, DM / 64};
    pg8::gemm_phase<pg8::EpiDelta, RowOrder, PG8_ALIGN, PG8_SP2>((PG8_LAS unsigned char*)lds, g, S, E, wv_);
}

#define LAS __attribute__((address_space(3)))
#define XB_TMO      128
#define XB_XCNT(j)  (256  + 64 * (j))
#define XB_XSUB(j)  (1280 + 64 * (j))
#define XB_XGEN(j)  (2304 + 64 * (j))
#define XB_TOP      3328
#define XB_TOPGEN   3392
#define XCD_BAR_WORDS 3456
#define XB_SPIN_CAP (1u << 18)

__device__ __forceinline__ unsigned xb_ld(unsigned* p)              { return __hip_atomic_load(p, __ATOMIC_RELAXED, __HIP_MEMORY_SCOPE_AGENT); }
__device__ __forceinline__ unsigned xb_add(unsigned* p, unsigned v) { return __hip_atomic_fetch_add(p, v, __ATOMIC_RELAXED, __HIP_MEMORY_SCOPE_AGENT); }
__device__ __forceinline__ unsigned xb_xcc_id() { return (unsigned)__builtin_amdgcn_s_getreg((3 << 11) | 20) & 0xFu; }
#define XB_SPIN(cond, bar) do { unsigned _sp = 0; while (cond) { __builtin_amdgcn_s_sleep(1); \
    if ((++_sp & 255u) == 0u) { if (xb_ld(&(bar)[XB_TMO])) break; if (_sp > XB_SPIN_CAP) { atomicAdd(&(bar)[XB_TMO], 1u); break; } } } } while (0)

struct XcdBarrier {
    unsigned* bar; unsigned x;
    volatile LAS unsigned* st;
};

__device__ __forceinline__ XcdBarrier xcd_barrier_post(unsigned* bar, volatile LAS unsigned* st) {
    XcdBarrier b; b.bar = bar; b.x = xb_xcc_id(); b.st = st;
    if (threadIdx.x == 0) (void)xb_add(&bar[XB_XCNT(b.x)], 1u);
    return b;
}
__device__ __forceinline__ void xcd_barrier_complete(unsigned* bar, unsigned x, unsigned& nloc, unsigned& nx) {
    const unsigned G = gridDim.x * gridDim.y * gridDim.z;
    unsigned sum, cnt, mine, sp = 0u;
    for (;;) {
        sum = 0u; cnt = 0u; mine = 0u;
#pragma unroll
        for (unsigned j = 0; j < 16; ++j) { const unsigned c = xb_ld(&bar[XB_XCNT(j)]); sum += c; cnt += (c > 0u) ? 1u : 0u; mine = (j == x) ? c : mine; }
        if (sum == G) break;
        __builtin_amdgcn_s_sleep(1);
        if ((++sp & 255u) == 0u) { if (xb_ld(&bar[XB_TMO])) break; if (sp > XB_SPIN_CAP) { atomicAdd(&bar[XB_TMO], 1u); break; } }
    }
    nloc = mine > 0u ? mine : 1u; nx = cnt > 0u ? cnt : 1u;
}

__device__ __forceinline__ void xcd_barrier(const XcdBarrier& b) {
    asm volatile("s_waitcnt vmcnt(0)" ::: "memory");
    __syncthreads();
    if (threadIdx.x == 0) {
        unsigned* bar = b.bar;
        __builtin_amdgcn_s_waitcnt(0);
        unsigned nloc = b.st[0], nx = b.st[1];
        if (nloc == 0u) { xcd_barrier_complete(bar, b.x, nloc, nx); b.st[0] = nloc; b.st[1] = nx; }
        const unsigned old = xb_add(&bar[XB_XSUB(b.x)], 1u);
        const unsigned gen = old / nloc;
        if (old + 1u == (gen + 1u) * nloc) {
            __builtin_amdgcn_fence(__ATOMIC_RELEASE, "agent");
            asm volatile("s_waitcnt vmcnt(0)" ::: "memory");
            const unsigned og = xb_add(&bar[XB_TOP], 1u);
            const unsigned tg = og / nx;
            if (og + 1u == (tg + 1u) * nx) xb_add(&bar[XB_TOPGEN], 1u);
            else XB_SPIN(xb_ld(&bar[XB_TOPGEN]) == tg, bar);
            __builtin_amdgcn_fence(__ATOMIC_ACQUIRE, "agent");
            xb_add(&bar[XB_XGEN(b.x)], 1u);
            asm volatile("s_waitcnt vmcnt(0)" ::: "memory");
        } else {
            XB_SPIN(xb_ld(&bar[XB_XGEN(b.x)]) == gen, bar);
            __builtin_amdgcn_fence(__ATOMIC_ACQUIRE, "agent");
            asm volatile("s_waitcnt vmcnt(0)" ::: "memory");
        }
    }
    __syncthreads();
}


constexpr int CW_QATT = 1024;
constexpr int CW_BAR = 4096;
constexpr int RING_BYTES = 131072, MISC_OFF = RING_BYTES + 320;
constexpr int LDS_BYTES = 147456;
static_assert((CW_BAR + XCD_BAR_WORDS) * 4 <= (int)CTL_ZERO_BYTES, "barrier words inside the memset region");

DI void dep_signal(unsigned* ctr, int wv_) {
    asm volatile("s_waitcnt vmcnt(0)" ::: "memory");
    __syncthreads();
    if (ltid() == 0) { __builtin_amdgcn_fence(__ATOMIC_RELEASE, "agent"); asm volatile("s_waitcnt vmcnt(0)" ::: "memory"); (void)xb_add(ctr, 1u); }
}
DI void dep_wait(unsigned* ctr, unsigned need, unsigned* bar, int wv_) {
    if (ltid() == 0) { XB_SPIN(xb_ld(ctr) < need, bar); __builtin_amdgcn_fence(__ATOMIC_ACQUIRE, "agent"); asm volatile("s_waitcnt vmcnt(0)" ::: "memory"); }
    __syncthreads();
}
constexpr int CW_DEP = 1536;
DI void phase_scanmix(KP P, char* lds, unsigned* ctl, int l, bool lastl, int bid, int wv_) {
    const gptr_t ws_ = lptr(P->ws);
    unsigned* done_dn = ctl + CW_DEP + 64 * (2 * l), * done_gla = ctl + CW_DEP + 64 * (2 * l + 1);
    if (bid < 128) { phase_dn_scan(P, lds, bid, 128, wv_); dep_signal(done_dn, wv_); }
    else { phase_gla_scan(P, bid - 128, 128, wv_); dep_signal(done_gla, wv_); }
    __syncthreads();
    const bf16* AQ = (const bf16*)(ws_ + WS_AQ); const bf16* AKV = (const bf16*)(ws_ + WS_AKV); bf16* MIX = (bf16*)(ws_ + WS_H);
    const int natt = NBATCH * 8 * 16 + (lastl ? 0 : NBATCH * 8), ngla = NBATCH * 4 * NCHUNK;
    for (int k = 0; k < 3; ++k) {
        const int u = k < 2 ? bid + 256 * k : (bid >= 224 ? 512 + (bid - 224) : natt);
        if (u >= natt) break;
        int qb, bh;
        if (u < NBATCH * 8 * 16) { qb = 1 + (u & 15); bh = u >> 4; } else { qb = 0; bh = u - NBATCH * 8 * 16; }
        const int hq = bh & 3, kvh = (bh >> 2) & 1, b = bh >> 3, h = kvh * 4 + hq;
        const size_t row0 = (size_t)b * TT + (size_t)qb * 256;
        att::attn_dense_body<att::bf16>(AQ + row0 * 1024 + h * 128, AKV + (size_t)b * TT * 512 + kvh * 128, AKV + (size_t)b * TT * 512 + 256 + kvh * 128,
                                        MIX + row0 * 2048 + 1024 + h * 128, qb == 0 ? CTXL : TT, lds, wv_);
        __syncthreads();
    }
    constexpr int R1 = 0;
    if (bid >= 128) { dep_wait(done_gla, 128u, ctl + CW_BAR, wv_);
        for (int u = bid - 128; u < ngla; u += 128) gla_out_unit(P, lds, u, l, wv_); }
    dep_wait(done_dn, 128u, ctl + CW_BAR, wv_);
    if (bid < 128) dn_post_rows(P, l, bid * NWAVE, 128 * NWAVE, R1, lastl, wv_);
    else dn_post_rows(P, l, R1 + (bid - 128) * NWAVE, 128 * NWAVE, MROWS, lastl, wv_);
}

__global__ void __launch_bounds__(NTHR, 2) mega_fwd(Params Pv) {
    extern __shared__ __attribute__((aligned(16))) char lds[];
    const int tid = threadIdx.x, bid = blockIdx.x; constexpr int nb = 256;
    const int wv0_ = __builtin_amdgcn_readfirstlane(tid >> 6);
    for (int u = tid; u < (LDS_BYTES - RING_BYTES) / 4; u += NTHR) ((unsigned*)(lds + RING_BYTES))[u] = 0u;
    __syncthreads();
    unsigned* ctl = (unsigned*)(Pv.ws + WS_CTL);
    const XcdBarrier bar = xcd_barrier_post(ctl + CW_BAR, (volatile LAS unsigned*)(lds + MISC_OFF + 32));
#define WV() ({ int w_ = wv0_; asm volatile("" : "+s"(w_)); w_; })
#define PKA() ({ KP kp_ = (KP)__builtin_amdgcn_kernarg_segment_ptr(); asm volatile("" : "+s"(kp_)); kp_; })
#define GRID_BAR() do { XcdBarrier b2_ = bar; asm volatile("" : "+s"(b2_.x), "+s"(b2_.bar)); xcd_barrier(b2_); } while (0)

    phase_mod(PKA(), lds, bid, nb, WV());
    phase_wcvt(PKA(), lds, bid, nb, WV());
    GRID_BAR();
    phase_init(PKA(), lds, bid, WV());
    GRID_BAR();

    for (int s = 0; s < 2 * NLAYER; ++s) {
        const int l = s >> 1, sub = s & 1; const bool last = (s == 2 * NLAYER - 1);
        const bool lastl = (l == NLAYER - 1);
        phase_gemm_gu(PKA(), l, sub, last, lds, bid, nb, WV());
        GRID_BAR();
        phase_gemm_down(PKA(), l, sub, last, lds, bid, nb, WV());
        GRID_BAR();
        if (sub == 0) phase_ln<false>(PKA(), lds, l, 0, l, 3, false, 8, bid, WV());
        else if (last) phase_ln<true>(PKA(), lds, l, 2, 0, -1, false, 0, bid, WV());
        else          phase_ln<false>(PKA(), lds, l, 2, l + 1, 0, false, 8, bid, WV());
        if (last) break;
        GRID_BAR();
        if (sub == 0) {
            phase_gemm_in(PKA(), l, lds, bid, nb, WV());
            GRID_BAR();
            phase_prep(PKA(), l, bid, nb, WV());
            GRID_BAR();
            phase_gla_local(PKA(), lds, bid, nb, WV());
            phase_dn_local(PKA(), lds, bid, nb, WV());
            GRID_BAR();
            phase_scanmix(PKA(), lds, ctl, l, lastl, bid, WV());
            GRID_BAR();
            phase_gemm_out(PKA(), l, lastl, lds, bid, nb, WV());
            GRID_BAR();
            phase_ln<false>(PKA(), lds, l, 1, l, 6, lastl, lastl ? 0 : 8, bid, WV());
            GRID_BAR();
        }
    }
#undef GRID_BAR
}

extern "C" void kernel_launch(void* const* d_in, const int* in_sizes, int n_in, void* d_out, int out_size, void* d_ws, size_t ws_size, hipStream_t stream) {
    static int grid = 0;
    if (grid == 0) {
        if (n_in != 24 || ws_size < WS_END2 || out_size != NBATCH * SEQL * DM) { fprintf(stderr, "kernel_launch: unexpected shapes (n_in %d, out %d, ws %zu)\n", n_in, out_size, ws_size); grid = -1; return; }
        int dev = 0, cus = 0, per_cu = 0;
        if (hipGetDevice(&dev) != hipSuccess || hipDeviceGetAttribute(&cus, hipDeviceAttributeMultiprocessorCount, dev) != hipSuccess) { grid = -1; return; }
        if (hipFuncSetAttribute((const void*)mega_fwd, hipFuncAttributeMaxDynamicSharedMemorySize, LDS_BYTES) != hipSuccess) { fprintf(stderr, "kernel_launch: hipFuncSetAttribute failed\n"); grid = -1; return; }
        if (hipOccupancyMaxActiveBlocksPerMultiprocessor(&per_cu, (const void*)mega_fwd, NTHR, LDS_BYTES) != hipSuccess || per_cu < 1) fprintf(stderr, "kernel_launch: occupancy query says %d\n", per_cu);
        (void)hipGetLastError();
        if (cus != 256) { fprintf(stderr, "kernel_launch: built for a 256-CU device (one workgroup per CU), found %d CUs; nothing launched\n", cus); grid = -1; return; }
        grid = cus;
    }
    if (grid < 0) return;
    if (hipMemsetAsync((char*)d_ws + WS_CTL, 0, CTL_ZERO_BYTES, stream) != hipSuccess) return;
    Params P{};
    const float** pp = (const float**)&P;
    for (int i = 0; i < 24; ++i) pp[i] = (const float*)d_in[i];
    P.out = (float*)d_out; P.ws = (unsigned char*)d_ws;
    hipLaunchKernelGGL(mega_fwd, dim3(grid), dim3(NTHR), LDS_BYTES, stream, P);
    const hipError_t le = hipPeekAtLastError();
    if (le != hipSuccess) fprintf(stderr, "kernel_launch: launch failed: %s\n", hipGetErrorName(le));
}
```
